# Optimizing an MI355X kernel written in HIP

```python
import math
import jax, jax.numpy as jnp
from jax import lax
import numpy as np

D_MODEL = 1024
BATCH = 16
SEQ = 2048
DEPTH = 4

SSD_HEAD_DIM = 64
SSD_WIDTH = D_MODEL
SSD_HEADS = SSD_WIDTH // SSD_HEAD_DIM
SSD_GROUPS = 4
SSD_STATE = 128
SSD_CONV = 4
SSD_CHUNK = 128
SSD_CONV_CH = SSD_WIDTH + 2 * SSD_GROUPS * SSD_STATE

DA_QK_DIM = 64
DA_V_DIM = 128
DA_HEADS = D_MODEL // DA_V_DIM
DA_QK_WIDTH = DA_HEADS * 2 * DA_QK_DIM
DA_WIDTH = DA_HEADS * DA_V_DIM
Q_BLOCK = 128
REL_BUCKETS = 32
REL_MAX_DIST = 128

EVEN_SPLITS = (SSD_WIDTH, SSD_CONV_CH, SSD_HEADS, DA_QK_WIDTH, DA_QK_WIDTH, DA_WIDTH, DA_WIDTH)
EVEN_IN = sum(EVEN_SPLITS)
EVEN_MIX = SSD_WIDTH + DA_WIDTH

HG_HEAD_DIM = 128
HG_WIDTH = 2 * D_MODEL
HG_HEADS = HG_WIDTH // HG_HEAD_DIM
HG_CHUNK = 16
ODD_IN = 4 * HG_WIDTH

N_EVEN = (DEPTH + 1) // 2
N_ODD = DEPTH // 2
EPS = 1e-6

kernel_name = "ssd_diffattn_hgrn2_hybrid"


def rmsnorm(x, w):
    xf = x.astype(jnp.float32)
    y = xf * lax.rsqrt(jnp.mean(xf * xf, axis=-1, keepdims=True) + EPS)
    return (y * w.astype(jnp.float32)).astype(x.dtype)


def causal_dwconv(x, w, b):
    K, C = w.shape
    y = lax.conv_general_dilated(x, w[:, None, :].astype(x.dtype), window_strides=(1,),
                                 padding=[(K - 1, 0)], dimension_numbers=("NWC", "WIO", "NWC"),
                                 feature_group_count=C)
    return y + b.astype(x.dtype)


def segsum(a):
    T = a.shape[-1]
    cs = jnp.cumsum(a, axis=-1)
    diff = cs[..., :, None] - cs[..., None, :]
    return jnp.where(jnp.tril(jnp.ones((T, T), bool)), diff, -jnp.inf)


def ssd_scan(x, dt, A, Bm, Cm):
    b, L, H, P = x.shape
    G, N = Bm.shape[2], Bm.shape[3]
    R = H // G
    c, l = L // SSD_CHUNK, SSD_CHUNK
    X = (x.astype(jnp.float32) * dt[..., None]).reshape(b, c, l, G, R, P)
    a = (dt * A).reshape(b, c, l, G, R).transpose(0, 1, 3, 4, 2)
    Bc = Bm.reshape(b, c, l, G, N)
    Cc = Cm.reshape(b, c, l, G, N)
    a_cs = jnp.cumsum(a, axis=-1)
    CB = jnp.einsum("bclgn,bcsgn->bcgls", Cc, Bc)
    scores = CB[:, :, :, None] * jnp.exp(segsum(a))
    y_diag = jnp.einsum("bcgrls,bcsgrp->bclgrp", scores, X)
    decay_states = jnp.exp(a_cs[..., -1:] - a_cs)
    states = jnp.einsum("bclgn,bcgrl,bclgrp->bcgrpn", Bc, decay_states, X)
    chunk_a = jnp.pad(a_cs[..., -1].transpose(0, 2, 3, 1), ((0, 0), (0, 0), (0, 0), (1, 0)))
    decay_chunk = jnp.exp(segsum(chunk_a))
    states = jnp.concatenate([jnp.zeros_like(states[:, :1]), states], axis=1)
    new_states = jnp.einsum("bgrzc,bcgrpn->bzgrpn", decay_chunk, states)
    prev = new_states[:, :-1]
    y_off = jnp.einsum("bclgn,bcgrpn,bcgrl->bclgrp", Cc, prev, jnp.exp(a_cs))
    return (y_diag + y_off).reshape(b, L, H, P)


def t5_bucket(rel):
    n = jnp.maximum(rel, 0)
    max_exact = REL_BUCKETS // 2
    large = max_exact + (jnp.log(jnp.maximum(n, 1).astype(jnp.float32) / max_exact)
                         / math.log(REL_MAX_DIST / max_exact) * (REL_BUCKETS - max_exact)).astype(jnp.int32)
    large = jnp.minimum(large, REL_BUCKETS - 1)
    return jnp.where(n < max_exact, n, large)


def diff_attention(q, k, v, lam, rel_table):
    b, L, H, _, d = q.shape
    nb = L // Q_BLOCK
    scale = d ** -0.5
    kpos = jnp.arange(L)
    qb = q.reshape(b, nb, Q_BLOCK, H, 2, d).transpose(1, 0, 2, 3, 4, 5)

    def block(args):
        qi, i = args
        qpos = i * Q_BLOCK + jnp.arange(Q_BLOCK)
        rel = qpos[:, None] - kpos[None, :]
        bias = rel_table[t5_bucket(rel)].transpose(2, 0, 1).astype(jnp.float32)
        s = jnp.einsum("bqhcd,bkhcd->bhcqk", qi, k).astype(jnp.float32) * scale + bias[None, :, None]
        s = jnp.where(rel >= 0, s, -jnp.inf)
        p = jax.nn.softmax(s, axis=-1)
        w = p[:, :, 0] - lam * p[:, :, 1]
        return jnp.einsum("bhqk,bkhv->bqhv", w.astype(v.dtype), v)

    out = lax.map(block, (qb, jnp.arange(nb)))
    return out.transpose(1, 0, 2, 3, 4).reshape(b, L, H, v.shape[-1])


def ssd_diffattn_mixer(u, w_in, w_out, conv_w, conv_b, dt_bias, A_log, D_skip, ssd_norm_w,
                       lq1, lk1, lq2, lk2, subln_w, rel_table, layer_idx):
    b, L, _ = u.shape
    idx = [int(s) for s in np.cumsum(EVEN_SPLITS)[:-1]]
    z, xBC, dt, q, k, v, g = jnp.split(u @ w_in, idx, axis=-1)
    xBC = jax.nn.silu(causal_dwconv(xBC, conv_w, conv_b))
    xs, Bm, Cm = jnp.split(xBC, [SSD_WIDTH, SSD_WIDTH + SSD_GROUPS * SSD_STATE], axis=-1)
    xs = xs.reshape(b, L, SSD_HEADS, SSD_HEAD_DIM)
    Bm = Bm.reshape(b, L, SSD_GROUPS, SSD_STATE)
    Cm = Cm.reshape(b, L, SSD_GROUPS, SSD_STATE)
    dt = jax.nn.softplus(dt.astype(jnp.float32) + dt_bias.astype(jnp.float32))
    A = -jnp.exp(A_log.astype(jnp.float32))
    y = ssd_scan(xs, dt, A, Bm, Cm) + xs * D_skip[:, None]
    y = y.astype(u.dtype).reshape(b, L, SSD_WIDTH)
    y_a = rmsnorm(y * jax.nn.silu(z), ssd_norm_w)
    q = q.reshape(b, L, DA_HEADS, 2, DA_QK_DIM)
    k = k.reshape(b, L, DA_HEADS, 2, DA_QK_DIM)
    v = v.reshape(b, L, DA_HEADS, DA_V_DIM)
    lam_init = 0.8 - 0.6 * math.exp(-0.3 * layer_idx)
    lam = (jnp.exp(jnp.sum(lq1.astype(jnp.float32) * lk1.astype(jnp.float32)))
           - jnp.exp(jnp.sum(lq2.astype(jnp.float32) * lk2.astype(jnp.float32))) + lam_init)
    o = diff_attention(q, k, v, lam, rel_table)
    o = rmsnorm(o, subln_w) * (1.0 - lam_init)
    y_b = o.reshape(b, L, DA_WIDTH) * jax.nn.silu(g)
    return jnp.concatenate([y_a, y_b], axis=-1) @ w_out


def gated_linear_recurrence(q, k, v, log_f):
    b, L, H, dk = q.shape
    dv = v.shape[-1]
    C = HG_CHUNK
    nc = L // C

    def to_chunks(t):
        return t.reshape(b, nc, C, H, t.shape[-1]).transpose(1, 0, 3, 2, 4)

    causal = jnp.tril(jnp.ones((C, C), bool))

    def step(S, inp):
        qi, ki, vi, gi = inp
        bcum = jnp.cumsum(gi.astype(jnp.float32), axis=2)
        diff = bcum[:, :, :, None, :] - bcum[:, :, None, :, :]
        decay = jnp.exp(jnp.where(causal[:, :, None], diff, -jnp.inf))
        att = jnp.sum(qi[:, :, :, None, :] * ki[:, :, None, :, :] * decay, axis=-1)
        o = (jnp.einsum("bhts,bhsv->bhtv", att, vi)
             + jnp.einsum("bhtd,bhdv->bhtv", qi * jnp.exp(bcum), S))
        blast = bcum[:, :, -1:, :]
        S = (jnp.exp(blast[:, :, 0, :, None]) * S
             + jnp.einsum("bhsd,bhsv->bhdv", ki * jnp.exp(blast - bcum), vi))
        return S, o

    S0 = jnp.zeros((b, H, dk, dv), jnp.float32)
    _, o = lax.scan(step, S0, (to_chunks(q), to_chunks(k), to_chunks(v), to_chunks(log_f)))
    return o.transpose(1, 0, 3, 2, 4).reshape(b, L, H, dv).astype(v.dtype)


def hgrn2_mixer(u, w_in, w_out, lower_bounds, norm_w, layer_idx):
    b, L, _ = u.shape
    q, f, i, g = jnp.split(u @ w_in, 4, axis=-1)
    lb_all = jax.nn.softmax(lower_bounds.astype(jnp.float32), axis=0)
    lb_all = jnp.cumsum(lb_all, axis=0) - lb_all[0]
    lb = lb_all[layer_idx]
    f = lb + (1.0 - lb) * jax.nn.sigmoid(f.astype(jnp.float32))
    log_f = jnp.log(f)
    k = (1.0 - f).astype(u.dtype)
    q = jax.nn.silu(q)
    hs = lambda t: t.reshape(b, L, HG_HEADS, HG_HEAD_DIM)
    o = gated_linear_recurrence(hs(q), hs(k), hs(i), hs(log_f))
    o = rmsnorm(o, norm_w).reshape(b, L, HG_WIDTH) * jax.nn.silu(g)
    return o @ w_out


def setup_inputs(seed: int = 0) -> dict:
    key = jax.random.key(seed)
    ks = jax.random.split(key, 24)
    nrm = lambda k, shape, s: jax.random.normal(k, shape, jnp.float32) * s
    dt = jnp.exp(jax.random.uniform(ks[7], (N_EVEN, SSD_HEADS), jnp.float32)
                 * (math.log(0.1) - math.log(1e-3)) + math.log(1e-3))
    dt = jnp.maximum(dt, 1e-4)
    return {
        "x": jax.random.normal(ks[0], (BATCH, SEQ, D_MODEL), jnp.float32),
        "norm_w": 1.0 + nrm(ks[1], (DEPTH, D_MODEL), 0.02),
        "final_norm_w": 1.0 + nrm(ks[2], (D_MODEL,), 0.02),
        "rel_bias": nrm(ks[3], (REL_BUCKETS, DA_HEADS), 0.1),
        "even_w_in": nrm(ks[4], (N_EVEN, D_MODEL, EVEN_IN), D_MODEL ** -0.5),
        "even_w_out": nrm(ks[5], (N_EVEN, EVEN_MIX, D_MODEL), EVEN_MIX ** -0.5),
        "conv_w": nrm(ks[6], (N_EVEN, SSD_CONV, SSD_CONV_CH), SSD_CONV ** -0.5),
        "conv_b": nrm(ks[8], (N_EVEN, SSD_CONV_CH), 0.02),
        "dt_bias": dt + jnp.log(-jnp.expm1(-dt)),
        "A_log": jnp.log(jax.random.uniform(ks[9], (N_EVEN, SSD_HEADS), jnp.float32, 1.0, 16.0)),
        "D_skip": 1.0 + nrm(ks[10], (N_EVEN, SSD_HEADS), 0.02),
        "ssd_norm_w": 1.0 + nrm(ks[11], (N_EVEN, SSD_WIDTH), 0.02),
        "lambda_q1": nrm(ks[12], (N_EVEN, DA_QK_DIM), 0.1),
        "lambda_k1": nrm(ks[13], (N_EVEN, DA_QK_DIM), 0.1),
        "lambda_q2": nrm(ks[14], (N_EVEN, DA_QK_DIM), 0.1),
        "lambda_k2": nrm(ks[15], (N_EVEN, DA_QK_DIM), 0.1),
        "subln_w": 1.0 + nrm(ks[16], (N_EVEN, DA_V_DIM), 0.02),
        "odd_w_in": nrm(ks[17], (N_ODD, D_MODEL, ODD_IN), D_MODEL ** -0.5),
        "odd_w_out": nrm(ks[18], (N_ODD, HG_WIDTH, D_MODEL), HG_WIDTH ** -0.5),
        "hgrn_lower_bounds": nrm(ks[19], (DEPTH, HG_WIDTH), 0.1),
        "hgrn_norm_w": 1.0 + nrm(ks[20], (N_ODD, HG_HEAD_DIM), 0.02),
    }


def reference(x, norm_w, final_norm_w, rel_bias, even_w_in, even_w_out, conv_w, conv_b, dt_bias,
              A_log, D_skip, ssd_norm_w, lambda_q1, lambda_k1, lambda_q2, lambda_k2, subln_w,
              odd_w_in, odd_w_out, hgrn_lower_bounds, hgrn_norm_w):
    h = x
    for layer in range(DEPTH):
        u = rmsnorm(h, norm_w[layer])
        if layer % 2 == 0:
            e = layer // 2
            h = h + ssd_diffattn_mixer(u, even_w_in[e], even_w_out[e], conv_w[e], conv_b[e],
                                       dt_bias[e], A_log[e], D_skip[e], ssd_norm_w[e],
                                       lambda_q1[e], lambda_k1[e], lambda_q2[e], lambda_k2[e],
                                       subln_w[e], rel_bias, layer)
        else:
            o = layer // 2
            h = h + hgrn2_mixer(u, odd_w_in[o], odd_w_out[o], hgrn_lower_bounds,
                                hgrn_norm_w[o], layer)
    return rmsnorm(h, final_norm_w)
```

```cpp
#include <hip/hip_runtime.h>
#include <hip/hip_cooperative_groups.h>
#include <cstdio>
#include <cstdint>
#include <cmath>
namespace cg = cooperative_groups;

#define LAS __attribute__((address_space(3)))
typedef unsigned short bf16_t;
typedef short bf16x8 __attribute__((ext_vector_type(8)));
typedef short s16x4 __attribute__((ext_vector_type(4)));
typedef float f32x4 __attribute__((ext_vector_type(4)));
typedef unsigned u32x4 __attribute__((ext_vector_type(4)));
typedef unsigned u32x2 __attribute__((ext_vector_type(2)));
typedef float f32x2_t __attribute__((ext_vector_type(2)));
typedef __bf16 bf16x2_t __attribute__((ext_vector_type(2)));

constexpr int T_TOK = 32768, DM = 1024, SEQ = 2048, NBATCH = 16, PP = 6144;
constexpr float EPS = 1e-6f;
constexpr float LOG2E = 1.4426950408889634f;

__device__ __forceinline__ unsigned cvtpk(float lo, float hi) { f32x2_t v = {lo, hi}; bf16x2_t b = __builtin_convertvector(v, bf16x2_t); return __builtin_bit_cast(unsigned, b); }
__device__ __forceinline__ float bflo(unsigned w) { return __uint_as_float(w << 16); }
__device__ __forceinline__ float bfhi(unsigned w) { return __uint_as_float(w & 0xffff0000u); }
__device__ __forceinline__ float silu_f(float x) { return x / (1.f + __expf(-x)); }
__device__ __forceinline__ float wave_sum(float v) {
#pragma unroll
    for (int o = 1; o < 64; o <<= 1) v += __shfl_xor(v, o);
    return v;
}
__device__ __forceinline__ float row_rs(const float* ssq, int row) {
    const f32x4* p = (const f32x4*)(ssq + (size_t)row * 16);
    const f32x4 a = p[0], b = p[1], c = p[2], d = p[3];
    const float s = ((a[0] + a[1]) + (a[2] + a[3])) + ((b[0] + b[1]) + (b[2] + b[3])) + ((c[0] + c[1]) + (c[2] + c[3])) + ((d[0] + d[1]) + (d[2] + d[3]));
    return rsqrtf(s * (1.f / 1024.f) + EPS);
}

__device__ __forceinline__ void row_rs8(const float* ssq, int row0, int fq, float (&rsv)[8]) {
#pragma unroll
    for (int i = 0; i < 8; ++i) {
        const int row = row0 + (i >> 2) * 128 + (i & 3) * 16;
        const f32x4 a = *(const f32x4*)(ssq + (size_t)row * 16 + fq * 4);
        float s = (a[0] + a[1]) + (a[2] + a[3]);
        s += __shfl_xor(s, 16); s += __shfl_xor(s, 32);
        rsv[i] = rsqrtf(s * (1.f / 1024.f) + EPS);
    }
    asm volatile("" ::: "memory");
}
__device__ __forceinline__ float lb_val(const float* lbp, int cf, int li) {
    const float a0 = lbp[cf], a1 = lbp[2048 + cf], a2 = lbp[4096 + cf], a3 = lbp[6144 + cf];
    const float m = fmaxf(fmaxf(a0, a1), fmaxf(a2, a3));
    const float e0 = __expf(a0 - m), e1 = __expf(a1 - m), e2 = __expf(a2 - m), e3 = __expf(a3 - m);
    const float s = (e0 + e1) + (e2 + e3);
    const float num = (li == 1) ? e1 : (e1 + e2 + e3);
    return num / s;
}
namespace pg8 {
#define PG8_LAS __attribute__((address_space(3)))
typedef unsigned short bf16_t;
typedef short bf16x8 __attribute__((ext_vector_type(8)));
typedef float f32x4 __attribute__((ext_vector_type(4)));
typedef unsigned u32x4 __attribute__((ext_vector_type(4)));
constexpr int BM = 256, BK = 64, HALF = 128, HTB = HALF * BK * 2  , STAGE_BYTES = 8 * HTB, NXCD = 8, WGM = 8;

__host__ __device__ __forceinline__ int lds_byte(int r, int c) { const int st = (r >> 4) * 2 + (c >> 5), rr = r & 15, cc = c & 31, ob = rr * 64 + cc * 2; return st * 1024 + (ob ^ (((ob >> 9) & 1) << 5)); }
__host__ __device__ __forceinline__ void stage_rc(int b, int& R, int& C) { const int st = b / 1024, sb = b % 1024, swz = sb ^ (((sb >> 9) & 1) << 5); R = (st >> 1) * 16 + swz / 64; C = (st & 1) * 32 + (swz % 64) / 2; }
__host__ __device__ __forceinline__ int perm32(int rho) { const int n = rho >> 4, i = rho & 15; return 8 * (i >> 2) + 4 * n + (i & 3); }

struct Unit { int pm, pn; };
struct Gemm { const bf16_t* A; const bf16_t* Bt; int M, N, K, lda; };

struct StaticOrder {
    int nM, nN, nwg, G, c;
    __host__ __device__ void init(int M, int N, int G_, int c_) { nM = M / BM; nN = N / BM; nwg = nM * nN; G = G_; c = c_; }
    __host__ __device__ bool next(int i, Unit& u) const {
        const long L = (long)i * G + c; if (L >= nwg) return false;
        int wgid = (int)L; { const int q = nwg / NXCD, r = nwg % NXCD, xcd = wgid % NXCD, off = wgid / NXCD; wgid = (xcd < r ? xcd * (q + 1) : r * (q + 1) + (xcd - r) * q) + off; }
        const int nig = WGM * nN, gid = wgid / nig, fm = gid * WGM, gsz = (nM - fm) < WGM ? (nM - fm) : WGM;
        u.pm = fm + ((wgid % nig) % gsz); u.pn = (wgid % nig) / gsz; return true;
    }
    __device__ __forceinline__ void a_ready(const Unit&) const {}
    __device__ __forceinline__ void done(const Unit&) const {}
};

struct EpiIn {
    static constexpr bool PERM = true, AFTER_DRAIN = false;
    bf16_t* P; const float* ssq; int mode; float qscale; const float* lbp; int li;
    __device__ __forceinline__ void operator()(const f32x4 (&acc)[2][2][4][2], const Unit& u, int wr, int wc, int fr, int fq) const {
        const int row0 = u.pm * BM + wr * 64 + fr; const int col0 = u.pn * BM + wc * 32 + 8 * fq;
        int act = 0; float sc = 1.f;
#ifndef TRIVIAL_EPI
        if (mode == 0) { if (u.pn >= 4 && u.pn < 8) sc = qscale; }
        else { act = (u.pn < 8) ? 1 : ((u.pn < 16) ? 2 : 0); }
#endif
        float lb[2][8];
#pragma unroll
        for (int bj = 0; bj < 2; ++bj)
#pragma unroll
            for (int i = 0; i < 8; ++i) lb[bj][i] = 0.f;
        if (act == 2) {
#pragma unroll
            for (int bj = 0; bj < 2; ++bj)
#pragma unroll
                for (int i = 0; i < 8; ++i) lb[bj][i] = lb_val(lbp, col0 + bj * HALF + i - 2048, li);
        }
        float rsv[8]; row_rs8(ssq, row0, fq, rsv);
#pragma unroll
        for (int ai = 0; ai < 2; ++ai)
#pragma unroll
            for (int m = 0; m < 4; ++m) {
                const int row = row0 + ai * HALF + m * 16;
                const float r = rsv[ai * 4 + m] * sc;
                bf16_t* rowp = P + (size_t)row * PP + col0;
#pragma unroll
                for (int bj = 0; bj < 2; ++bj) {
                    float v[8];
#pragma unroll
                    for (int i = 0; i < 4; ++i) { v[i] = acc[ai][bj][m][0][i] * r; v[4 + i] = acc[ai][bj][m][1][i] * r; }
                    if (act == 1) {
#pragma unroll
                        for (int i = 0; i < 8; ++i) v[i] = silu_f(v[i]);
                    } else if (act == 2) {
#pragma unroll
                        for (int i = 0; i < 8; ++i) { const float sg = 1.f / (1.f + __expf(-v[i])); v[i] = __logf(lb[bj][i] + (1.f - lb[bj][i]) * sg); }
                    }
                    u32x4 w; w.x = cvtpk(v[0], v[1]); w.y = cvtpk(v[2], v[3]); w.z = cvtpk(v[4], v[5]); w.w = cvtpk(v[6], v[7]);
                    *(u32x4*)(rowp + bj * HALF) = w;
                }
                asm volatile("" ::: "memory");
            }
    }
};
struct EpiGate {
    static constexpr bool PERM = true, AFTER_DRAIN = false;
    bf16_t* Y; const float* ssq;
    __device__ __forceinline__ void operator()(const f32x4 (&acc)[2][2][4][2], const Unit& u, int wr, int wc, int fr, int fq) const {
        const int row0 = u.pm * BM + wr * 64 + fr; const int col0 = u.pn * BM + wc * 32 + 8 * fq;
        float rsv[8]; row_rs8(ssq, row0, fq, rsv);
#pragma unroll
        for (int ai = 0; ai < 2; ++ai)
#pragma unroll
            for (int m = 0; m < 4; ++m) {
                const int row = row0 + ai * HALF + m * 16;
                const float r = rsv[ai * 4 + m];
                bf16_t* rowp = Y + (size_t)row * PP + col0;
#pragma unroll
                for (int bj = 0; bj < 2; ++bj) {
                    const u32x4 o = *(const u32x4*)(rowp + bj * HALF);
                    float v[8];
#pragma unroll
                    for (int i = 0; i < 4; ++i) { v[i] = silu_f(acc[ai][bj][m][0][i] * r); v[4 + i] = silu_f(acc[ai][bj][m][1][i] * r); }
                    u32x4 w;
                    w.x = cvtpk(v[0] * bflo(o.x), v[1] * bfhi(o.x)); w.y = cvtpk(v[2] * bflo(o.y), v[3] * bfhi(o.y));
                    w.z = cvtpk(v[4] * bflo(o.z), v[5] * bfhi(o.z)); w.w = cvtpk(v[6] * bflo(o.w), v[7] * bfhi(o.w));
                    *(u32x4*)(rowp + bj * HALF) = w;
                }
                asm volatile("" ::: "memory");
            }
    }
};
struct EpiOut {
    static constexpr bool PERM = false, AFTER_DRAIN = false;
    const float* hin; float* hout; bf16_t* U; float* ssq;
    __device__ __forceinline__ void operator()(const f32x4 (&acc)[2][2][4][2], const Unit& u, int wr, int wc, int fr, int fq) const {
        const int row0 = u.pm * BM + wr * 64 + fr; const int col0 = u.pn * BM + wc * 32 + 4 * fq;
#pragma unroll
        for (int ai = 0; ai < 2; ++ai)
#pragma unroll
            for (int m = 0; m < 4; ++m) {
                const int row = row0 + ai * HALF + m * 16;
                const size_t off = (size_t)row * DM + col0;
                float s = 0.f;
#pragma unroll
                for (int bj = 0; bj < 2; ++bj)
#pragma unroll
                    for (int n = 0; n < 2; ++n) {
                        const f32x4 hv = *(const f32x4*)(hin + off + bj * HALF + n * 16) + acc[ai][bj][m][n];
                        *(f32x4*)(hout + off + bj * HALF + n * 16) = hv;
                        u32x2 w; w.x = cvtpk(hv[0], hv[1]); w.y = cvtpk(hv[2], hv[3]);
                        *(u32x2*)(U + off + bj * HALF + n * 16) = w;
                        s += (hv[0] * hv[0] + hv[1] * hv[1]) + (hv[2] * hv[2] + hv[3] * hv[3]);
                    }
                s += __shfl_xor(s, 16); s += __shfl_xor(s, 32);
                if (fq == 0) ssq[(size_t)row * 16 + u.pn * 4 + wc] = s;
                asm volatile("" ::: "memory");
            }
    }
};
template <class Epi, class Sched, bool ALIGN_EPI, bool SP2, int KK, int LDA>
__device__ __forceinline__ void gemm_phase(PG8_LAS unsigned char* lds, const Gemm g, const Sched& S, const Epi& E, int tid_arg) {
    int tid = tid_arg; asm volatile("" : "+v"(tid));
    const int wid = __builtin_amdgcn_readfirstlane(tid >> 6), lane = tid & 63, wr = wid >> 2, wc = wid & 3, fr = lane & 15, fq = lane >> 4;
    constexpr int K = KK, nt = K / BK;
    unsigned voffA[2], voffB[2];
#pragma unroll
    for (int i = 0; i < 2; ++i) { int R, C; stage_rc(tid * 16 + i * 8192, R, C); const int Rb = Epi::PERM ? ((R & ~31) + perm32(R & 31)) : R;
        voffA[i] = (unsigned)(R * LDA + C) * 2u; voffB[i] = (unsigned)(Rb * K + C) * 2u; }
    constexpr size_t kstep = (size_t)(BK * 2);
    constexpr size_t hstepA = (size_t)HALF * LDA * 2, hstepB = (size_t)HALF * K * 2;
    constexpr size_t tstepA = 2 * hstepA, tstepB = 2 * hstepB;
    const unsigned ldsw = (unsigned)wid * 1024u;
    const int aoff = lds_byte(wr * 64 + fr, fq * 8), boff = lds_byte(wc * 32 + fr, fq * 8);
#define PG8_SA(b, h) (((b) * 2 + (h)) * HTB)
#define PG8_SB(b, h) ((4 + (b) * 2 + (h)) * HTB)
#define PG8_STAGE(bufoff, gbase, voff) do { _Pragma("unroll") for (int _i = 0; _i < 2; ++_i) \
        __builtin_amdgcn_global_load_lds((const unsigned*)((const char*)(gbase) + (voff)[_i]), (PG8_LAS unsigned*)(lds + (bufoff) + ldsw + _i * 8192), 16, 0, 0); } while (0)
#define PG8_LDA(dst, b, h) do { _Pragma("unroll") for (int m = 0; m < 4; ++m) _Pragma("unroll") for (int k = 0; k < 2; ++k) dst[m][k] = *(const PG8_LAS bf16x8*)(lds + PG8_SA(b, h) + aoff + m * 2048 + k * 1024); } while (0)
#define PG8_LDB(dst, b, h) do { _Pragma("unroll") for (int n = 0; n < 2; ++n) _Pragma("unroll") for (int k = 0; k < 2; ++k) dst[n][k] = *(const PG8_LAS bf16x8*)(lds + PG8_SB(b, h) + boff + n * 2048 + k * 1024); } while (0)
#define PG8_MMA(ai, bj, At, Bt) do { __builtin_amdgcn_s_setprio(1); _Pragma("unroll") for (int m = 0; m < 4; ++m) _Pragma("unroll") for (int n = 0; n < 2; ++n) _Pragma("unroll") for (int k = 0; k < 2; ++k) \
        acc[ai][bj][m][n] = __builtin_amdgcn_mfma_f32_16x16x32_bf16(Bt[n][k], At[m][k], acc[ai][bj][m][n], 0, 0, 0); __builtin_amdgcn_s_setprio(0); } while (0)
#define PG8_WAIT_V(n) asm volatile("s_waitcnt vmcnt(" #n ")" ::: "memory")
#define PG8_WAIT_L(n) asm volatile("s_waitcnt lgkmcnt(" #n ")" ::: "memory")
#define PG8_BAR __builtin_amdgcn_s_barrier()
#define PG8_SCHED __builtin_amdgcn_sched_barrier(0)
    Unit cur, nxt; int ui = 0;
    if (!S.next(0, cur)) return;
    f32x4 acc[2][2][4][2];
#pragma unroll
    for (int a = 0; a < 2; ++a)
#pragma unroll
        for (int b = 0; b < 2; ++b)
#pragma unroll
            for (int m = 0; m < 4; ++m)
#pragma unroll
                for (int n = 0; n < 2; ++n) acc[a][b][m][n] = (f32x4){0.f, 0.f, 0.f, 0.f};
    bf16x8 At[4][2], B0[2][2], B1[2][2];
    const char* cA = (const char*)g.A + (size_t)cur.pm * tstepA; const char* cB = (const char*)g.Bt + (size_t)cur.pn * tstepB;
    S.a_ready(cur);
    if constexpr (SP2) {
        PG8_STAGE(PG8_SB(0, 0), cB, voffB); PG8_STAGE(PG8_SB(0, 1), cB + hstepB, voffB); PG8_STAGE(PG8_SA(0, 0), cA, voffA); PG8_STAGE(PG8_SA(0, 1), cA + hstepA, voffA);
        if (wr == 1) PG8_BAR;
        PG8_WAIT_V(2); PG8_BAR;
        PG8_STAGE(PG8_SB(1, 0), cB + kstep, voffB); PG8_STAGE(PG8_SA(1, 0), cA + kstep, voffA); PG8_STAGE(PG8_SB(1, 1), cB + hstepB + kstep, voffB);
        PG8_WAIT_V(6); PG8_BAR;
    } else {
        PG8_STAGE(PG8_SB(0, 0), cB, voffB); PG8_STAGE(PG8_SA(0, 0), cA, voffA); PG8_STAGE(PG8_SB(0, 1), cB + hstepB, voffB); PG8_STAGE(PG8_SA(0, 1), cA + hstepA, voffA);
        if (wr == 1) PG8_BAR;
        PG8_WAIT_V(4); PG8_BAR;
        PG8_STAGE(PG8_SB(1, 0), cB + kstep, voffB); PG8_STAGE(PG8_SA(1, 0), cA + kstep, voffA); PG8_STAGE(PG8_SB(1, 1), cB + hstepB + kstep, voffB);
        PG8_WAIT_V(6); PG8_BAR;
    }
    for (;;) {
        const bool has_next = S.next(ui + 1, nxt);
        const char* nA = has_next ? (const char*)g.A + (size_t)nxt.pm * tstepA : cA; const char* nB = has_next ? (const char*)g.Bt + (size_t)nxt.pn * tstepB : cB;
        for (int t = 0; t < nt; t += 2) {
            const bool last = (t == nt - 2);
            const char* a1 = cA + (size_t)(t + 1) * kstep;
            const char* a2 = last ? nA : cA + (size_t)(t + 2) * kstep; const char* b2 = last ? nB : cB + (size_t)(t + 2) * kstep;
            const char* a3 = a2 + kstep; const char* b3 = b2 + kstep;
            if (last && has_next) S.a_ready(nxt);
            if constexpr (SP2) {
            PG8_LDB(B0, 0, 0); PG8_LDB(B1, 0, 1); PG8_SCHED; PG8_LDA(At, 0, 0); PG8_STAGE(PG8_SA(1, 1), a1 + hstepA, voffA);
            PG8_WAIT_V(8); PG8_WAIT_L(0); PG8_BAR; PG8_MMA(0, 0, At, B0); PG8_MMA(0, 1, At, B1); PG8_BAR; PG8_SCHED;
            PG8_LDA(At, 0, 1); PG8_STAGE(PG8_SB(0, 0), b2, voffB); PG8_STAGE(PG8_SB(0, 1), b2 + hstepB, voffB); PG8_STAGE(PG8_SA(0, 0), a2, voffA);
            PG8_WAIT_V(8); PG8_WAIT_L(0); PG8_BAR; PG8_MMA(1, 0, At, B0); PG8_MMA(1, 1, At, B1); PG8_BAR; PG8_SCHED;
            PG8_LDB(B0, 1, 0); PG8_LDB(B1, 1, 1); PG8_SCHED; PG8_LDA(At, 1, 0); PG8_STAGE(PG8_SA(0, 1), a2 + hstepA, voffA);
            PG8_WAIT_V(8); PG8_WAIT_L(0); PG8_BAR; PG8_MMA(0, 0, At, B0); PG8_MMA(0, 1, At, B1); PG8_BAR; PG8_SCHED;
            PG8_LDA(At, 1, 1); PG8_STAGE(PG8_SB(1, 0), b3, voffB); PG8_STAGE(PG8_SB(1, 1), b3 + hstepB, voffB); PG8_STAGE(PG8_SA(1, 0), a3, voffA);
            PG8_WAIT_V(8); PG8_WAIT_L(0); PG8_BAR; PG8_MMA(1, 0, At, B0); PG8_MMA(1, 1, At, B1); PG8_BAR; PG8_SCHED;
            } else {
            PG8_LDB(B0, 0, 0); PG8_SCHED; PG8_LDA(At, 0, 0); PG8_STAGE(PG8_SA(1, 1), a1 + hstepA, voffA);
            PG8_WAIT_L(8); PG8_BAR; PG8_WAIT_L(0); PG8_MMA(0, 0, At, B0); PG8_BAR; PG8_SCHED;
            PG8_LDB(B1, 0, 1); PG8_STAGE(PG8_SB(0, 0), b2, voffB);
            PG8_BAR; PG8_WAIT_L(0); PG8_MMA(0, 1, At, B1); PG8_BAR;
            PG8_LDA(At, 0, 1); PG8_STAGE(PG8_SA(0, 0), a2, voffA);
            PG8_BAR; PG8_WAIT_L(0); PG8_MMA(1, 0, At, B0); PG8_BAR; PG8_SCHED;
            PG8_STAGE(PG8_SB(0, 1), b2 + hstepB, voffB);
            PG8_WAIT_V(6); PG8_BAR; PG8_MMA(1, 1, At, B1); PG8_BAR;
            PG8_LDB(B0, 1, 0); PG8_SCHED; PG8_LDA(At, 1, 0); PG8_STAGE(PG8_SA(0, 1), a2 + hstepA, voffA);
            PG8_WAIT_L(8); PG8_BAR; PG8_WAIT_L(0); PG8_MMA(0, 0, At, B0); PG8_BAR; PG8_SCHED;
            PG8_LDB(B1, 1, 1); PG8_STAGE(PG8_SB(1, 0), b3, voffB);
            PG8_BAR; PG8_WAIT_L(0); PG8_MMA(0, 1, At, B1); PG8_BAR;
            PG8_LDA(At, 1, 1); PG8_STAGE(PG8_SA(1, 0), a3, voffA);
            PG8_BAR; PG8_WAIT_L(0); PG8_MMA(1, 0, At, B0); PG8_BAR; PG8_SCHED;
            PG8_STAGE(PG8_SB(1, 1), b3 + hstepB, voffB);
            PG8_WAIT_V(6); PG8_BAR; PG8_MMA(1, 1, At, B1); PG8_BAR;
            }
        }
        if constexpr (ALIGN_EPI) { if (wr == 0) PG8_BAR; }
        if constexpr (!Epi::AFTER_DRAIN) { E(acc, cur, wr, wc, fr, fq); S.done(cur); }
        if (!has_next) break;
#pragma unroll
        for (int a = 0; a < 2; ++a)
#pragma unroll
            for (int b = 0; b < 2; ++b)
#pragma unroll
                for (int m = 0; m < 4; ++m)
#pragma unroll
                    for (int n = 0; n < 2; ++n) acc[a][b][m][n] = (f32x4){0.f, 0.f, 0.f, 0.f};
        cur = nxt; cA = nA; cB = nB; ++ui;
        if constexpr (ALIGN_EPI) { if (wr == 1) PG8_BAR; }
    }
    PG8_WAIT_V(0);
    if constexpr (!ALIGN_EPI) { if (wr == 0) PG8_BAR; }
    PG8_BAR;
    if constexpr (Epi::AFTER_DRAIN) { E.fused(acc, cur, wr, wc, fr, fq, lds, wid, lane); S.done(cur); }
#undef PG8_SA
#undef PG8_SB
#undef PG8_STAGE
#undef PG8_LDA
#undef PG8_LDB
#undef PG8_MMA
#undef PG8_WAIT_V
#undef PG8_WAIT_L
#undef PG8_BAR
#undef PG8_SCHED
}
}

constexpr size_t MiB = 1u << 20;
constexpr size_t WS_P = 0;
constexpr size_t WS_U = 384 * MiB;
constexpr size_t WS_WE_IN = 448 * MiB, WS_WE_G = 460 * MiB, WS_WE_OUT = 462 * MiB, WS_WE_DT = 466 * MiB;
constexpr size_t WS_WO_IN = 468 * MiB, WS_WO_G = 480 * MiB, WS_WO_OUT = 484 * MiB;
constexpr size_t WS_DT = 488 * MiB;
constexpr size_t WS_SSQ = 490 * MiB;
constexpr size_t WS_SSD = 492 * MiB;
constexpr size_t WS_END = 494 * MiB;
constexpr int LDS_BYTES = 147456;
#ifndef PG8SP2
#define PG8SP2 true
#endif

struct Params {
    const float *x, *norm_w, *final_norm_w, *rel_bias, *even_w_in, *even_w_out, *conv_w, *conv_b, *dt_bias, *A_log, *D_skip, *ssd_norm_w,
        *lq1, *lk1, *lq2, *lk2, *subln_w, *odd_w_in, *odd_w_out, *hgrn_lb, *hgrn_norm_w;
    float* out; unsigned char* ws;
};

typedef const __attribute__((address_space(4))) Params* PPtr;
__device__ __forceinline__ PPtr get_params() { const __attribute__((address_space(4))) void* k = (const __attribute__((address_space(4))) void*)__builtin_amdgcn_kernarg_segment_ptr(); asm volatile("" : "+s"(k)); return (PPtr)k; }
struct Seg { const float* W; int ldw, col0, ncols, K; bf16_t* WT; int row0; const float* scale; };
__device__ __forceinline__ void convert_seg(const Seg s, float* scr, int gw, int NGW, int lane) {
    const int nblk = (s.ncols + 31) / 32, nitems = (s.K / 64) * nblk;
    for (int it = gw; it < nitems; it += NGW) {
        const int kb = it / nblk, nb = it % nblk, k0 = 64 * kb, n0 = 32 * nb;
        const int nc = lane & 31; const bool okc = (n0 + nc) < s.ncols;
#pragma unroll 8
        for (int i = 0; i < 32; ++i) {
            const int kk = 2 * i + (lane >> 5);
            float v = okc ? s.W[(size_t)(k0 + kk) * s.ldw + s.col0 + n0 + nc] : 0.f;
            if (s.scale) v *= s.scale[k0 + kk];
            scr[kk * 33 + nc] = v;
        }
        __builtin_amdgcn_fence(__ATOMIC_RELEASE, "workgroup"); __builtin_amdgcn_wave_barrier();
        const int c = lane & 7;
#pragma unroll
        for (int j = 0; j < 4; ++j) {
            const int n = (lane >> 3) + 8 * j; const float* sp = scr + (8 * c) * 33 + n;
            u32x4 o; o.x = cvtpk(sp[0 * 33], sp[1 * 33]); o.y = cvtpk(sp[2 * 33], sp[3 * 33]); o.z = cvtpk(sp[4 * 33], sp[5 * 33]); o.w = cvtpk(sp[6 * 33], sp[7 * 33]);
            if (n0 + n < s.ncols) *(u32x4*)(s.WT + (size_t)(s.row0 + n0 + n) * s.K + k0 + 8 * c) = o;
        }
        __builtin_amdgcn_fence(__ATOMIC_RELEASE, "workgroup"); __builtin_amdgcn_wave_barrier();
    }
}
__device__ __forceinline__ void convert_layer(PPtr p, int layer, float* scr, int gw, int NGW, int lane) {
    const float* nw = p->norm_w + (size_t)layer * DM;
    if ((layer & 1) == 0) {
        const int e = layer >> 1;
        const float* Wi = p->even_w_in + (size_t)e * DM * 7184; const float* Wo = p->even_w_out + (size_t)e * 2048 * DM;
        bf16_t* WIN = (bf16_t*)(p->ws + WS_WE_IN);
        convert_seg(Seg{Wi, 7184, 0, 1024, DM, WIN, 0, nw}, scr, gw, NGW, lane);
        convert_seg(Seg{Wi, 7184, 3088, 1024, DM, WIN, 1024, nw}, scr, gw, NGW, lane);
        convert_seg(Seg{Wi, 7184, 1024, 2048, DM, WIN, 2048, nw}, scr, gw, NGW, lane);
        convert_seg(Seg{Wi, 7184, 4112, 2048, DM, WIN, 4096, nw}, scr, gw, NGW, lane);
        convert_seg(Seg{Wi, 7184, 6160, 1024, DM, (bf16_t*)(p->ws + WS_WE_G), 0, nw}, scr, gw, NGW, lane);
        convert_seg(Seg{Wi, 7184, 3072, 16, DM, (bf16_t*)(p->ws + WS_WE_DT), 0, nw}, scr, gw, NGW, lane);
        convert_seg(Seg{Wo, DM, 0, 1024, 2048, (bf16_t*)(p->ws + WS_WE_OUT), 0, nullptr}, scr, gw, NGW, lane);
    } else {
        const int o = layer >> 1;
        const float* Wi = p->odd_w_in + (size_t)o * DM * 8192; const float* Wo = p->odd_w_out + (size_t)o * 2048 * DM;
        convert_seg(Seg{Wi, 8192, 0, 6144, DM, (bf16_t*)(p->ws + WS_WO_IN), 0, nw}, scr, gw, NGW, lane);
        convert_seg(Seg{Wi, 8192, 6144, 2048, DM, (bf16_t*)(p->ws + WS_WO_G), 0, nw}, scr, gw, NGW, lane);
        convert_seg(Seg{Wo, DM, 0, 1024, 2048, (bf16_t*)(p->ws + WS_WO_OUT), 0, nullptr}, scr, gw, NGW, lane);
    }
}

__device__ __forceinline__ void dt_items(PPtr p, int e, int gw, int NGW, int lane) {
    const bf16_t* U = (const bf16_t*)(p->ws + WS_U); const bf16_t* Wdt = (const bf16_t*)(p->ws + WS_WE_DT);
    const float* ssq = (const float*)(p->ws + WS_SSQ); float* dt = (float*)(p->ws + WS_DT);
    const int fr = lane & 15, fq = lane >> 4;
    for (int item = gw; item < T_TOK / 16; item += NGW) {
        const int row0 = item * 16;
        f32x4 acc = {0.f, 0.f, 0.f, 0.f};
        const bf16x8* ap = (const bf16x8*)(U + (size_t)(row0 + fr) * DM + fq * 8);
        const bf16x8* bp = (const bf16x8*)(Wdt + (size_t)fr * DM + fq * 8);
#pragma unroll 8
        for (int s = 0; s < 32; ++s) acc = __builtin_amdgcn_mfma_f32_16x16x32_bf16(ap[s * 4], bp[s * 4], acc, 0, 0, 0);
        const float bias = p->dt_bias[e * 16 + fr];
#pragma unroll
        for (int i = 0; i < 4; ++i) {
            const int row = row0 + 4 * fq + i;
            const float v = acc[i] * row_rs(ssq, row) + bias;
            dt[(size_t)row * 16 + fr] = (v > 20.f) ? v : log1pf(__expf(v));
        }
    }
}

__device__ __forceinline__ void ssd_unit(PPtr p, int e, int b, int h, unsigned char* lds, int tid) {
    float* sx = (float*)lds;
    float* sB = sx + 16 * 64;
    float* sC = sB + 16 * 128;
    float* sy = sC + 16 * 128;
    float* sdt = sy + 16 * 64;
    float* sda = sdt + 16;
    bf16_t* P = (bf16_t*)(p->ws + WS_P);
    const float* dt = (const float*)(p->ws + WS_DT); float* ssd = (float*)(p->ws + WS_SSD);
    const float* cw = p->conv_w + (size_t)e * 4 * 2048; const float* cb = p->conv_b + (size_t)e * 2048;
    const float Ah = -__expf(p->A_log[e * 16 + h]), Dh = p->D_skip[e * 16 + h];
    const int g = h >> 2, pp = tid >> 3, nq = tid & 7;
    const size_t rowb = (size_t)b * SEQ;
    float st[16];
#pragma unroll
    for (int i = 0; i < 16; ++i) st[i] = 0.f;
    for (int c = 0; c < SEQ / 16; ++c) {
        const int t0 = c * 16;
        for (int it = tid; it < 1280; it += 512) {
            const int t = it / 80, q4 = it % 80;
            int ch; float* dst;
            if (q4 < 16) { ch = h * 64 + q4 * 4; dst = sx + t * 64 + q4 * 4; }
            else if (q4 < 48) { ch = 1024 + g * 128 + (q4 - 16) * 4; dst = sB + t * 128 + (q4 - 16) * 4; }
            else { ch = 1536 + g * 128 + (q4 - 48) * 4; dst = sC + t * 128 + (q4 - 48) * 4; }
            f32x4 a = *(const f32x4*)(cb + ch);
#pragma unroll
            for (int j = 0; j < 4; ++j) {
                const int tt = t0 + t - 3 + j;
                if (tt >= 0) {
                    const u32x2 raw = *(const u32x2*)(P + (rowb + tt) * PP + 2048 + ch);
                    const f32x4 w = *(const f32x4*)(cw + j * 2048 + ch);
                    a[0] += w[0] * bflo(raw.x); a[1] += w[1] * bfhi(raw.x); a[2] += w[2] * bflo(raw.y); a[3] += w[3] * bfhi(raw.y);
                }
            }
            f32x4 o; o[0] = silu_f(a[0]); o[1] = silu_f(a[1]); o[2] = silu_f(a[2]); o[3] = silu_f(a[3]);
            *(f32x4*)dst = o;
        }
        if (tid < 16) { const float d = dt[(rowb + t0 + tid) * 16 + h]; sdt[tid] = d; sda[tid] = __expf(d * Ah); }
        __syncthreads();
        for (int t = 0; t < 16; ++t) {
            const float xv = sx[t * 64 + pp]; const float X = xv * sdt[t], da = sda[t];
            float y = 0.f;
#pragma unroll
            for (int i4 = 0; i4 < 4; ++i4) {
                const f32x4 bv = *(const f32x4*)(sB + t * 128 + nq * 16 + i4 * 4), cv = *(const f32x4*)(sC + t * 128 + nq * 16 + i4 * 4);
#pragma unroll
                for (int i = 0; i < 4; ++i) { st[i4 * 4 + i] = da * st[i4 * 4 + i] + X * bv[i]; y += cv[i] * st[i4 * 4 + i]; }
            }
            y += __shfl_xor(y, 1); y += __shfl_xor(y, 2); y += __shfl_xor(y, 4);
            if (nq == 0) sy[t * 64 + pp] = y + Dh * xv;
        }
        __syncthreads();
        {
            const int t = tid >> 5, p2 = (tid & 31) * 2;
            bf16_t* zp = P + (rowb + t0 + t) * PP + h * 64 + p2;
            const unsigned zw = *(const unsigned*)zp;
            const float g0 = sy[t * 64 + p2] * silu_f(bflo(zw)), g1 = sy[t * 64 + p2 + 1] * silu_f(bfhi(zw));
            float ss = g0 * g0 + g1 * g1;
#pragma unroll
            for (int o = 1; o < 32; o <<= 1) ss += __shfl_xor(ss, o);
            *(unsigned*)zp = cvtpk(g0, g1);
            if ((tid & 31) == 0) ssd[(rowb + t0 + t) * 16 + h] = ss;
        }
    }
    __syncthreads();
}

__device__ __forceinline__ void hgrn_unit(PPtr p, int oi, int b, int h, unsigned char* lds, int tid) {
    float* sq = (float*)lds;
    float* sf = sq + 2048; float* sk = sf + 2048; float* sv = sk + 2048;
    float* so = sv + 2048;
    bf16_t* P = (bf16_t*)(p->ws + WS_P);
    const size_t rowb = (size_t)b * SEQ;
    const int v = tid & 127, dq = tid >> 7;
    const int st_t = tid >> 5, st_d = (tid & 31) * 4;
    const f32x4 nw = *(const f32x4*)(p->hgrn_norm_w + oi * 128 + st_d);
    float S[32];
#pragma unroll
    for (int i = 0; i < 32; ++i) S[i] = 0.f;
    const bf16_t* src = P + (rowb + st_t) * PP + h * 128 + st_d;
    u32x2 rq = *(const u32x2*)(src), rf = *(const u32x2*)(src + 2048), rv = *(const u32x2*)(src + 4096);
    for (int c = 0; c < SEQ / 16; ++c) {
        {
            f32x4 q4 = {bflo(rq.x), bfhi(rq.x), bflo(rq.y), bfhi(rq.y)};
            f32x4 f4 = {__expf(bflo(rf.x)), __expf(bfhi(rf.x)), __expf(bflo(rf.y)), __expf(bfhi(rf.y))};
            f32x4 k4 = {1.f - f4[0], 1.f - f4[1], 1.f - f4[2], 1.f - f4[3]};
            f32x4 v4 = {bflo(rv.x), bfhi(rv.x), bflo(rv.y), bfhi(rv.y)};
            *(f32x4*)(sq + st_t * 128 + st_d) = q4; *(f32x4*)(sf + st_t * 128 + st_d) = f4; *(f32x4*)(sk + st_t * 128 + st_d) = k4; *(f32x4*)(sv + st_t * 128 + st_d) = v4;
        }
        __syncthreads();
        if (c + 1 < SEQ / 16) { const bf16_t* s2 = src + (size_t)(c + 1) * 16 * PP; rq = *(const u32x2*)(s2); rf = *(const u32x2*)(s2 + 2048); rv = *(const u32x2*)(s2 + 4096); }
        for (int t = 0; t < 16; ++t) {
            const float vt = sv[t * 128 + v]; float a = 0.f;
#pragma unroll
            for (int i4 = 0; i4 < 8; ++i4) {
                const f32x4 f4 = *(const f32x4*)(sf + t * 128 + dq * 32 + i4 * 4), k4 = *(const f32x4*)(sk + t * 128 + dq * 32 + i4 * 4), q4 = *(const f32x4*)(sq + t * 128 + dq * 32 + i4 * 4);
#pragma unroll
                for (int i = 0; i < 4; ++i) { S[i4 * 4 + i] = f4[i] * S[i4 * 4 + i] + k4[i] * vt; a += q4[i] * S[i4 * 4 + i]; }
            }
            so[(dq * 16 + t) * 128 + v] = a;
        }
        __syncthreads();
        {
            f32x4 o = *(const f32x4*)(so + (0 * 16 + st_t) * 128 + st_d);
            o += *(const f32x4*)(so + (1 * 16 + st_t) * 128 + st_d); o += *(const f32x4*)(so + (2 * 16 + st_t) * 128 + st_d); o += *(const f32x4*)(so + (3 * 16 + st_t) * 128 + st_d);
            float ss = (o[0] * o[0] + o[1] * o[1]) + (o[2] * o[2] + o[3] * o[3]);
#pragma unroll
            for (int x = 1; x < 32; x <<= 1) ss += __shfl_xor(ss, x);
            const float r = rsqrtf(ss * (1.f / 128.f) + EPS);
            u32x2 w; w.x = cvtpk(o[0] * r * nw[0], o[1] * r * nw[1]); w.y = cvtpk(o[2] * r * nw[2], o[3] * r * nw[3]);
            *(u32x2*)(P + (rowb + c * 16 + st_t) * PP + h * 128 + st_d) = w;
        }
    }
    __syncthreads();
}

constexpr int KSTR = 136, VSTR = 144;
typedef short v4i16_t __attribute__((ext_vector_type(4)));
__device__ __forceinline__ s16x4 vtr(const bf16_t* ptr) { return __builtin_bit_cast(s16x4, __builtin_amdgcn_ds_read_tr16_b64_v4i16((LAS v4i16_t*)ptr)); }

__device__ __forceinline__ void attn_unit(PPtr p, int e, int b, int h, int qb, float lam, float oscale, unsigned char* lds, int tid) {
    bf16_t* sK = (bf16_t*)lds;
    bf16_t* sV = sK + 64 * KSTR;
    float* sbias = (float*)(sV + 64 * VSTR);
    bf16_t* P = (bf16_t*)(p->ws + WS_P);
    const int lane = tid & 63, w = __builtin_amdgcn_readfirstlane(tid >> 6), c16 = lane & 15, g = lane >> 4;
    const size_t rowb = (size_t)b * SEQ;
    const int q0 = qb * 128, qw0 = q0 + 16 * w, qpos = qw0 + c16;
    __syncthreads();
    if (tid < 129) {
        int bucket;
        if (tid < 16) bucket = tid;
        else { int lg = 16 + (int)(__logf((float)tid * (1.f / 16.f)) / 2.0794415416798357f * 16.f); bucket = lg < 31 ? lg : 31; }
        sbias[tid] = p->rel_bias[bucket * 8 + h] * LOG2E;
    }
    bf16x8 qf[2][2];
#pragma unroll
    for (int mp = 0; mp < 2; ++mp)
#pragma unroll
        for (int ds = 0; ds < 2; ++ds) qf[mp][ds] = *(const bf16x8*)(P + (rowb + qpos) * PP + 1024 + h * 128 + mp * 64 + ds * 32 + 8 * g);
    f32x4 O[2][8];
#pragma unroll
    for (int mp = 0; mp < 2; ++mp)
#pragma unroll
        for (int vt = 0; vt < 8; ++vt) O[mp][vt] = (f32x4){0.f, 0.f, 0.f, 0.f};
    float mrun[2] = {-1e30f, -1e30f}, lrun[2] = {0.f, 0.f};
    const int NT = (q0 + 128) / 64;
    const bf16_t* Kg = P + rowb * PP + 4096 + h * 128; const bf16_t* Vg = P + rowb * PP + 5120 + h * 128;
    const int ld_row0 = tid >> 4, ld_ch = tid & 15;
    u32x4 kr[2], vr[2];
#pragma unroll
    for (int i = 0; i < 2; ++i) { kr[i] = *(const u32x4*)(Kg + (size_t)(ld_row0 + 32 * i) * PP + ld_ch * 8); vr[i] = *(const u32x4*)(Vg + (size_t)(ld_row0 + 32 * i) * PP + ld_ch * 8); }
    for (int t = 0; t < NT; ++t) {
        __syncthreads();
#pragma unroll
        for (int i = 0; i < 2; ++i) { *(u32x4*)(sK + (ld_row0 + 32 * i) * KSTR + ld_ch * 8) = kr[i]; *(u32x4*)(sV + (ld_row0 + 32 * i) * VSTR + ld_ch * 8) = vr[i]; }
        __syncthreads();
        if (t + 1 < NT) {
#pragma unroll
            for (int i = 0; i < 2; ++i) { kr[i] = *(const u32x4*)(Kg + (size_t)((t + 1) * 64 + ld_row0 + 32 * i) * PP + ld_ch * 8); vr[i] = *(const u32x4*)(Vg + (size_t)((t + 1) * 64 + ld_row0 + 32 * i) * PP + ld_ch * 8); }
        }
        const int k0 = t * 64;
        if (k0 <= qw0 + 15) {
            const bool far = (qw0 - (k0 + 63)) >= 128;
            const float bfar = sbias[128];
            bf16x8 pa[2][2];
            float alpha[2];
#pragma unroll
            for (int mp = 0; mp < 2; ++mp) {
                f32x4 sc[4];
#pragma unroll
                for (int s = 0; s < 4; ++s) {
                    f32x4 a = {0.f, 0.f, 0.f, 0.f};
#pragma unroll
                    for (int ds = 0; ds < 2; ++ds) {
                        const bf16x8 kf = *(const bf16x8*)(sK + (16 * s + c16) * KSTR + mp * 64 + ds * 32 + 8 * g);
                        a = __builtin_amdgcn_mfma_f32_16x16x32_bf16(kf, qf[mp][ds], a, 0, 0, 0);
                    }
                    sc[s] = a;
                }
                float mx = -1e30f;
#pragma unroll
                for (int s = 0; s < 4; ++s)
#pragma unroll
                    for (int j = 0; j < 4; ++j) {
                        const int rel = qpos - (k0 + 16 * s + 4 * g + j);
                        float bv = bfar;
                        if (!far) { const int idx = rel < 0 ? 0 : (rel > 128 ? 128 : rel); bv = sbias[idx]; }
                        sc[s][j] = (rel >= 0) ? sc[s][j] + bv : -1e30f;
                        mx = fmaxf(mx, sc[s][j]);
                    }
                mx = fmaxf(mx, __shfl_xor(mx, 16)); mx = fmaxf(mx, __shfl_xor(mx, 32));
                const float mnew = fmaxf(mrun[mp], mx);
                alpha[mp] = exp2f(mrun[mp] - mnew); mrun[mp] = mnew;
                float rs = 0.f;
#pragma unroll
                for (int s = 0; s < 4; ++s)
#pragma unroll
                    for (int j = 0; j < 4; ++j) { const float pv = exp2f(sc[s][j] - mnew); sc[s][j] = pv; rs += pv; }
                rs += __shfl_xor(rs, 16); rs += __shfl_xor(rs, 32);
                lrun[mp] = lrun[mp] * alpha[mp] + rs;
#pragma unroll
                for (int ks = 0; ks < 2; ++ks) {
                    u32x4 pk;
                    pk.x = cvtpk(sc[2 * ks][0], sc[2 * ks][1]); pk.y = cvtpk(sc[2 * ks][2], sc[2 * ks][3]);
                    pk.z = cvtpk(sc[2 * ks + 1][0], sc[2 * ks + 1][1]); pk.w = cvtpk(sc[2 * ks + 1][2], sc[2 * ks + 1][3]);
                    pa[mp][ks] = __builtin_bit_cast(bf16x8, pk);
                }
                asm volatile("" ::: "memory");
            }
#pragma unroll
            for (int mp = 0; mp < 2; ++mp)
#pragma unroll
                for (int j = 0; j < 4; ++j) {
                    const float aj = __shfl(alpha[mp], 4 * g + j);
#pragma unroll
                    for (int vt = 0; vt < 8; ++vt) O[mp][vt][j] *= aj;
                }
            const int tq = c16 >> 2, tp = c16 & 3;
#pragma unroll
            for (int ks = 0; ks < 2; ++ks)
#pragma unroll
                for (int vt = 0; vt < 8; ++vt) {
                    const s16x4 lo = vtr(sV + (32 * ks + 4 * g + tq) * VSTR + 16 * vt + 4 * tp);
                    const s16x4 hi = vtr(sV + (32 * ks + 16 + 4 * g + tq) * VSTR + 16 * vt + 4 * tp);
                    const bf16x8 vf = {lo[0], lo[1], lo[2], lo[3], hi[0], hi[1], hi[2], hi[3]};
                    O[0][vt] = __builtin_amdgcn_mfma_f32_16x16x32_bf16(pa[0][ks], vf, O[0][vt], 0, 0, 0);
                    O[1][vt] = __builtin_amdgcn_mfma_f32_16x16x32_bf16(pa[1][ks], vf, O[1][vt], 0, 0, 0);
                    if (vt & 1) asm volatile("" ::: "memory");
                }
        }
    }
    const float il0 = 1.f / lrun[0], il1 = lam / lrun[1];
    float sw[8];
#pragma unroll
    for (int vt = 0; vt < 8; ++vt) sw[vt] = p->subln_w[e * 128 + 16 * vt + c16] * oscale;
#pragma unroll
    for (int j = 0; j < 4; ++j) {
        const float a0 = __shfl(il0, 4 * g + j), a1 = __shfl(il1, 4 * g + j);
        float o[8]; float ss = 0.f;
#pragma unroll
        for (int vt = 0; vt < 8; ++vt) { o[vt] = O[0][vt][j] * a0 - O[1][vt][j] * a1; ss += o[vt] * o[vt]; }
        ss += __shfl_xor(ss, 1); ss += __shfl_xor(ss, 2); ss += __shfl_xor(ss, 4); ss += __shfl_xor(ss, 8);
        const float r = rsqrtf(ss * (1.f / 128.f) + EPS);
        bf16_t* op = P + (rowb + qw0 + 4 * g + j) * PP + 1024 + h * 128 + c16;
#pragma unroll
        for (int vt = 0; vt < 8; ++vt) op[16 * vt] = (bf16_t)(cvtpk(o[vt] * r * sw[vt], 0.f) & 0xffffu);
    }
}

#define p get_params()
__global__ void __launch_bounds__(512, 2) fwd_kernel(Params p_unused) {
    extern __shared__ __attribute__((aligned(16))) unsigned char lds[];
    cg::grid_group grid = cg::this_grid();
    int tid = threadIdx.x, lane = tid & 63; const int wave = __builtin_amdgcn_readfirstlane(tid >> 6);
#define FRESH_LANES() do { lane = (int)__builtin_amdgcn_mbcnt_hi(~0u, __builtin_amdgcn_mbcnt_lo(~0u, 0u)); asm volatile("" : "+v"(lane)); tid = wave * 64 + lane; } while (0)
    const int G = gridDim.x, blk = blockIdx.x;
    const int gw = blk * 8 + wave, NGW = G * 8;
    bf16_t* P = (bf16_t*)(p->ws + WS_P); bf16_t* U = (bf16_t*)(p->ws + WS_U);
    float* ssq = (float*)(p->ws + WS_SSQ);
    float* scr = (float*)(lds + wave * 8704);
    PG8_LAS unsigned char* ring = (PG8_LAS unsigned char*)lds;

    for (int row = gw; row < T_TOK; row += NGW) {
        const f32x4* xr = (const f32x4*)(p->x + (size_t)row * DM) + lane;
        f32x4 v[4]; float s = 0.f;
#pragma unroll
        for (int j = 0; j < 4; ++j) { v[j] = xr[64 * j]; s += (v[j][0] * v[j][0] + v[j][1] * v[j][1]) + (v[j][2] * v[j][2] + v[j][3] * v[j][3]); }
        s = wave_sum(s);
        u32x2* up = (u32x2*)(U + (size_t)row * DM) + lane;
#pragma unroll
        for (int j = 0; j < 4; ++j) { u32x2 w; w.x = cvtpk(v[j][0], v[j][1]); w.y = cvtpk(v[j][2], v[j][3]); up[64 * j] = w; }
        if (lane < 16) ssq[(size_t)row * 16 + lane] = (lane == 0) ? s : 0.f;
    }
    convert_layer(p, 0, scr, gw, NGW, lane);
    grid.sync();

#pragma unroll 1
    for (int layer = 0; layer < 4; ++layer) {
        const bool even = (layer & 1) == 0; const int e = layer >> 1;
        FRESH_LANES();
        if (even) {
            dt_items(p, e, gw, NGW, lane);
            pg8::Gemm gm{U, (const bf16_t*)(p->ws + WS_WE_IN), T_TOK, 6144, DM, DM}; pg8::StaticOrder S; S.init(T_TOK, 6144, G, blk);
            pg8::EpiIn E{P, ssq, 0, 0.125f * LOG2E, nullptr, 0};
#ifndef SKIP_IN
            pg8::gemm_phase<pg8::EpiIn, pg8::StaticOrder, true, PG8SP2, 1024, 1024>(ring, gm, S, E, tid);
#endif
        } else {
            pg8::Gemm gm{U, (const bf16_t*)(p->ws + WS_WO_IN), T_TOK, 6144, DM, DM}; pg8::StaticOrder S; S.init(T_TOK, 6144, G, blk);
            pg8::EpiIn E{P, ssq, 1, 1.f, p->hgrn_lb, layer};
#ifndef SKIP_IN
            pg8::gemm_phase<pg8::EpiIn, pg8::StaticOrder, true, PG8SP2, 1024, 1024>(ring, gm, S, E, tid);
#endif
        }
        grid.sync();
        FRESH_LANES();
        if (even) {
            const float lam_init = 0.8f - 0.6f * __expf(-0.3f * (float)layer);
            float d1 = p->lq1[e * 64 + lane] * p->lk1[e * 64 + lane], d2 = p->lq2[e * 64 + lane] * p->lk2[e * 64 + lane];
            d1 = wave_sum(d1); d2 = wave_sum(d2);
            const float lam = __expf(d1) - __expf(d2) + lam_init;
            for (int pi = blk; pi < 1024; pi += G) {
                const int bh = pi >> 3, s = pi & 7;
#ifndef SKIP_ATTN
#pragma unroll 1
                for (int half = 0; half < 2; ++half) { FRESH_LANES(); attn_unit(p, e, bh >> 3, bh & 7, half ? s : 15 - s, lam, 1.f - lam_init, lds, tid); }
#endif
            }
            __syncthreads();
            FRESH_LANES();
#ifndef SKIP_SSD
            for (int ui = blk; ui < 256; ui += G) ssd_unit(p, e, ui >> 4, ui & 15, lds, tid);
#endif
        } else {
#ifndef SKIP_HGRN
            for (int ui = blk; ui < 256; ui += G) hgrn_unit(p, e, ui >> 4, ui & 15, lds, tid);
#endif
        }
        grid.sync();
        FRESH_LANES();
        if (even) {
            pg8::Gemm gm{U, (const bf16_t*)(p->ws + WS_WE_G), T_TOK, 1024, DM, DM}; pg8::StaticOrder S; S.init(T_TOK, 1024, G, blk);
            pg8::EpiGate E{P + 1024, ssq};
#ifndef SKIP_GATE
            pg8::gemm_phase<pg8::EpiGate, pg8::StaticOrder, true, PG8SP2, 1024, 1024>(ring, gm, S, E, tid);
#endif
            const float* ssd = (const float*)(p->ws + WS_SSD);
            FRESH_LANES();
            for (int row = gw; row < T_TOK; row += NGW) {
                const float r = row_rs(ssd, row);
                u32x4* yp = (u32x4*)(P + (size_t)row * PP) + lane;
                const f32x4* wp = (const f32x4*)(p->ssd_norm_w + e * 1024) + lane * 2;
#pragma unroll
                for (int j = 0; j < 2; ++j) {
                    u32x4 y = yp[64 * j]; const f32x4 w0 = wp[128 * j], w1 = wp[128 * j + 1];
                    y.x = cvtpk(bflo(y.x) * r * w0[0], bfhi(y.x) * r * w0[1]); y.y = cvtpk(bflo(y.y) * r * w0[2], bfhi(y.y) * r * w0[3]);
                    y.z = cvtpk(bflo(y.z) * r * w1[0], bfhi(y.z) * r * w1[1]); y.w = cvtpk(bflo(y.w) * r * w1[2], bfhi(y.w) * r * w1[3]);
                    yp[64 * j] = y;
                }
            }
        } else {
            pg8::Gemm gm{U, (const bf16_t*)(p->ws + WS_WO_G), T_TOK, 2048, DM, DM}; pg8::StaticOrder S; S.init(T_TOK, 2048, G, blk);
            pg8::EpiGate E{P, ssq};
#ifndef SKIP_GATE
            pg8::gemm_phase<pg8::EpiGate, pg8::StaticOrder, true, PG8SP2, 1024, 1024>(ring, gm, S, E, tid);
#endif
        }
        grid.sync();
        FRESH_LANES();
        {
            pg8::Gemm gm{P, (const bf16_t*)(p->ws + (even ? WS_WE_OUT : WS_WO_OUT)), T_TOK, 1024, 2048, PP}; pg8::StaticOrder S; S.init(T_TOK, 1024, G, blk);
            pg8::EpiOut E{layer == 0 ? p->x : p->out, p->out, U, ssq};
#ifndef SKIP_OUT
            pg8::gemm_phase<pg8::EpiOut, pg8::StaticOrder, true, PG8SP2, 2048, 6144>(ring, gm, S, E, tid);
#endif
            FRESH_LANES();
            if (layer < 3) convert_layer(p, layer + 1, scr, gw, NGW, lane);
        }
        grid.sync();
    }
    FRESH_LANES();
    for (int row = gw; row < T_TOK; row += NGW) {
        const float r = row_rs(ssq, row);
        f32x4* hp = (f32x4*)(p->out + (size_t)row * DM) + lane; const f32x4* wp = (const f32x4*)p->final_norm_w + lane;
#pragma unroll
        for (int j = 0; j < 4; ++j) { f32x4 v = hp[64 * j]; const f32x4 w = wp[64 * j]; v[0] *= r * w[0]; v[1] *= r * w[1]; v[2] *= r * w[2]; v[3] *= r * w[3]; hp[64 * j] = v; }
    }
}

#undef p
extern "C" void kernel_launch(void* const* d_in, const int* in_sizes, int n_in, void* d_out, int out_size, void* d_ws, size_t ws_size, hipStream_t stream) {
    static int grid = 0;
    if (grid == 0) {
        if (n_in != 21 || out_size != T_TOK * DM || ws_size < WS_END) { fprintf(stderr, "kernel_launch: unexpected shapes: n_in %d out %d ws %zu (need %zu)\n", n_in, out_size, ws_size, (size_t)WS_END); grid = -1; return; }
        int dev = 0, cus = 0, per_cu = 0;
        hipGetDevice(&dev); hipDeviceGetAttribute(&cus, hipDeviceAttributeMultiprocessorCount, dev);
        hipFuncSetAttribute((const void*)fwd_kernel, hipFuncAttributeMaxDynamicSharedMemorySize, LDS_BYTES);
        hipOccupancyMaxActiveBlocksPerMultiprocessor(&per_cu, (const void*)fwd_kernel, 512, LDS_BYTES);
        if (per_cu < 1) { fprintf(stderr, "kernel_launch: occupancy query says %d blocks per CU\n", per_cu); per_cu = 1; }
        (void)hipGetLastError();
        grid = cus * per_cu;
        if (grid > 256) grid = 256;
    }
    if (grid < 0) return;
    Params p{};
    const float** f = (const float**)&p;
    for (int i = 0; i < 21; ++i) f[i] = (const float*)d_in[i];
    p.out = (float*)d_out; p.ws = (unsigned char*)d_ws;
    void* args[] = {&p};
    hipError_t err = hipLaunchCooperativeKernel((const void*)fwd_kernel, dim3(grid), dim3(512), args, LDS_BYTES, stream);
    if (err != hipSuccess) fprintf(stderr, "kernel_launch: cooperative launch failed: %s (grid %d)\n", hipGetErrorString(err), grid);
}
```

```cpp
#include <hip/hip_runtime.h>
#include <hip/hip_cooperative_groups.h>
#include <cstdio>
#include <cstdint>
#include <cmath>
namespace cg = cooperative_groups;

#ifdef PROBE_SEC
#define PROBE_SECV PROBE_SEC
#define PSEC_B(id) unsigned long long _pt##id = 0ull; if ((id) == PROBE_SEC && blockIdx.x == 0 && __builtin_amdgcn_readfirstlane(tid >> 6) == 0) _pt##id = __builtin_amdgcn_s_memrealtime();
#define PSEC_E(id, ldsbase) if ((id) == PROBE_SEC && blockIdx.x == 0 && __builtin_amdgcn_readfirstlane(tid >> 6) == 0) { volatile unsigned long long* _a = (volatile unsigned long long*)((unsigned char*)(ldsbase) + 147456 - 128); *_a = *_a + (__builtin_amdgcn_s_memrealtime() - _pt##id); }
#else
#define PROBE_SECV (-1)
#define PSEC_B(id)
#define PSEC_E(id, ldsbase)
#endif

#define LAS __attribute__((address_space(3)))
typedef unsigned short bf16_t;
typedef short bf16x8 __attribute__((ext_vector_type(8)));
typedef short s16x4 __attribute__((ext_vector_type(4)));
typedef float f32x4 __attribute__((ext_vector_type(4)));
typedef unsigned u32x4 __attribute__((ext_vector_type(4)));
typedef unsigned u32x2 __attribute__((ext_vector_type(2)));
typedef float f32x2_t __attribute__((ext_vector_type(2)));
typedef __bf16 bf16x2_t __attribute__((ext_vector_type(2)));

constexpr int T_TOK = 32768, DM = 1024, SEQ = 2048, NBATCH = 16, PP = 6144;
constexpr float EPS = 1e-6f;
constexpr float LOG2E = 1.4426950408889634f;

__device__ __forceinline__ unsigned cvtpk(float lo, float hi) { f32x2_t v = {lo, hi}; bf16x2_t b = __builtin_convertvector(v, bf16x2_t); return __builtin_bit_cast(unsigned, b); }
__device__ __forceinline__ float bflo(unsigned w) { return __uint_as_float(w << 16); }
__device__ __forceinline__ float bfhi(unsigned w) { return __uint_as_float(w & 0xffff0000u); }
__device__ __forceinline__ float fast_exp2(float x) { return __builtin_amdgcn_exp2f(x); }
__device__ __forceinline__ float sigmoid_f(float x) { return __builtin_amdgcn_rcpf(1.f + fast_exp2(-LOG2E * x)); }
__device__ __forceinline__ float silu_f(float x) { return x * sigmoid_f(x); }

template <int M> __device__ __forceinline__ float shx(float v) { static_assert(M < 32, "shx: xor mask within a 32-lane half"); return __int_as_float(__builtin_amdgcn_ds_swizzle(__float_as_int(v), 0x1f | (M << 10))); }
__device__ __forceinline__ float sum_x32(float v) { auto rr = __builtin_amdgcn_permlane32_swap(__float_as_uint(v), __float_as_uint(v), false, false); return __uint_as_float(rr[0]) + __uint_as_float(rr[1]); }
__device__ __forceinline__ float max_x32(float v) { auto rr = __builtin_amdgcn_permlane32_swap(__float_as_uint(v), __float_as_uint(v), false, false); return fmaxf(__uint_as_float(rr[0]), __uint_as_float(rr[1])); }
__device__ __forceinline__ float bperm(int srclane, float v) { return __int_as_float(__builtin_amdgcn_ds_bpermute(srclane << 2, __float_as_int(v))); }
__device__ __forceinline__ float wave_sum(float v) { v += shx<1>(v); v += shx<2>(v); v += shx<4>(v); v += shx<8>(v); v += shx<16>(v); return sum_x32(v); }
__device__ __forceinline__ float row_rs(const float* ssq, int row) {
    const f32x4* p = (const f32x4*)(ssq + (size_t)row * 16);
    const f32x4 a = p[0], b = p[1], c = p[2], d = p[3];
    const float s = ((a[0] + a[1]) + (a[2] + a[3])) + ((b[0] + b[1]) + (b[2] + b[3])) + ((c[0] + c[1]) + (c[2] + c[3])) + ((d[0] + d[1]) + (d[2] + d[3]));
    return rsqrtf(s * (1.f / 1024.f) + EPS);
}

__device__ __forceinline__ void row_rs8(const float* ssq, int row0, int fq, float (&rsv)[8]) {
#pragma unroll
    for (int i = 0; i < 8; ++i) {
        const int row = row0 + (i >> 2) * 128 + (i & 3) * 16;
        const f32x4 a = *(const f32x4*)(ssq + (size_t)row * 16 + fq * 4);
        float s = (a[0] + a[1]) + (a[2] + a[3]);
        s += shx<16>(s); s = sum_x32(s);
        rsv[i] = rsqrtf(s * (1.f / 1024.f) + EPS);
    }
    asm volatile("" ::: "memory");
}
__device__ __forceinline__ float lb_val(const float* lbp, int cf, int li) {
    const float a0 = lbp[cf], a1 = lbp[2048 + cf], a2 = lbp[4096 + cf], a3 = lbp[6144 + cf];
    const float m = fmaxf(fmaxf(a0, a1), fmaxf(a2, a3));
    const float e0 = __expf(a0 - m), e1 = __expf(a1 - m), e2 = __expf(a2 - m), e3 = __expf(a3 - m);
    const float s = (e0 + e1) + (e2 + e3);
    const float num = (li == 1) ? e1 : (e1 + e2 + e3);
    return num / s;
}
namespace pg8 {
#define PG8_LAS __attribute__((address_space(3)))
typedef unsigned short bf16_t;
typedef short bf16x8 __attribute__((ext_vector_type(8)));
typedef float f32x4 __attribute__((ext_vector_type(4)));
typedef unsigned u32x4 __attribute__((ext_vector_type(4)));
constexpr int BM = 256, BK = 64, HALF = 128, HTB = HALF * BK * 2  , STAGE_BYTES = 8 * HTB, NXCD = 8, WGM = 8;

__host__ __device__ __forceinline__ int lds_byte(int r, int c) { const int st = (r >> 4) * 2 + (c >> 5), rr = r & 15, cc = c & 31, ob = rr * 64 + cc * 2; return st * 1024 + (ob ^ (((ob >> 9) & 1) << 5)); }
__host__ __device__ __forceinline__ void stage_rc(int b, int& R, int& C) { const int st = b / 1024, sb = b % 1024, swz = sb ^ (((sb >> 9) & 1) << 5); R = (st >> 1) * 16 + swz / 64; C = (st & 1) * 32 + (swz % 64) / 2; }
__host__ __device__ __forceinline__ int perm32(int rho) { const int n = rho >> 4, i = rho & 15; return 8 * (i >> 2) + 4 * n + (i & 3); }

struct Unit { int pm, pn; };
struct Gemm { const bf16_t* A; const bf16_t* Bt; int M, N, K, lda; };

struct StaticOrder {
    int nM, nN, nwg, G, c;
    __host__ __device__ void init(int M, int N, int G_, int c_) { nM = M / BM; nN = N / BM; nwg = nM * nN; G = G_; c = c_; }
    __host__ __device__ bool next(int i, Unit& u) const {
        const long L = (long)i * G + c; if (L >= nwg) return false;
        int wgid = (int)L; { const int q = nwg / NXCD, r = nwg % NXCD, xcd = wgid % NXCD, off = wgid / NXCD; wgid = (xcd < r ? xcd * (q + 1) : r * (q + 1) + (xcd - r) * q) + off; }
        const int nig = WGM * nN, gid = wgid / nig, fm = gid * WGM, gsz = (nM - fm) < WGM ? (nM - fm) : WGM;
        u.pm = fm + ((wgid % nig) % gsz); u.pn = (wgid % nig) / gsz; return true;
    }
    __device__ __forceinline__ void a_ready(const Unit&) const {}
    __device__ __forceinline__ void done(const Unit&) const {}
};

struct EpiIn {
    static constexpr bool PERM = true, AFTER_DRAIN = false; static constexpr int PID = 1;
    bf16_t* P; const float* ssq; int mode; float qscale; const float* lbp; int li;
    __device__ __forceinline__ void operator()(const f32x4 (&acc)[2][2][4][2], const Unit& u, int wr, int wc, int fr, int fq) const {
        const int row0 = u.pm * BM + wr * 64 + fr; const int col0 = u.pn * BM + wc * 32 + 8 * fq;
        int act = 0; float sc = 1.f;
#ifndef TRIVIAL_EPI
        if (mode == 0) { if (u.pn >= 4 && u.pn < 8) sc = qscale; }
        else { act = (u.pn < 8) ? 1 : ((u.pn < 16) ? 2 : 0); }
#endif
        float lb[2][8];
#pragma unroll
        for (int bj = 0; bj < 2; ++bj)
#pragma unroll
            for (int i = 0; i < 8; ++i) lb[bj][i] = 0.f;
        if (act == 2) {
#pragma unroll
            for (int bj = 0; bj < 2; ++bj)
#pragma unroll
                for (int i = 0; i < 8; ++i) lb[bj][i] = lbp[col0 + bj * HALF + i - 2048];
        }
        float rsv[8]; row_rs8(ssq, row0, fq, rsv);
#pragma unroll
        for (int ai = 0; ai < 2; ++ai)
#pragma unroll
            for (int m = 0; m < 4; ++m) {
                const int row = row0 + ai * HALF + m * 16;
                const float r = rsv[ai * 4 + m] * sc;
                bf16_t* rowp = P + (size_t)row * PP + col0;
#pragma unroll
                for (int bj = 0; bj < 2; ++bj) {
                    float v[8];
#pragma unroll
                    for (int i = 0; i < 4; ++i) { v[i] = acc[ai][bj][m][0][i] * r; v[4 + i] = acc[ai][bj][m][1][i] * r; }
                    if (act == 1) {
#pragma unroll
                        for (int i = 0; i < 8; ++i) v[i] = silu_f(v[i]);
                    } else if (act == 2) {
#pragma unroll
                        for (int i = 0; i < 8; ++i) { const float sg = sigmoid_f(v[i]); v[i] = 0.6931471805599453f * __builtin_amdgcn_logf(lb[bj][i] + (1.f - lb[bj][i]) * sg); }
                    }
                    u32x4 w; w.x = cvtpk(v[0], v[1]); w.y = cvtpk(v[2], v[3]); w.z = cvtpk(v[4], v[5]); w.w = cvtpk(v[6], v[7]);
                    *(u32x4*)(rowp + bj * HALF) = w;
                }
                asm volatile("" ::: "memory");
            }
    }
};
struct EpiGate {
    static constexpr bool PERM = true, AFTER_DRAIN = false; static constexpr int PID = 2;
    bf16_t* Y; const float* ssq; const float* ssd; const float* ssdw; bf16_t* YA;
    __device__ __forceinline__ void operator()(const f32x4 (&acc)[2][2][4][2], const Unit& u, int wr, int wc, int fr, int fq) const {
        const int row0 = u.pm * BM + wr * 64 + fr; const int col0 = u.pn * BM + wc * 32 + 8 * fq;
        float rsv[8]; row_rs8(ssq, row0, fq, rsv);
#pragma unroll
        for (int ai = 0; ai < 2; ++ai) {
            u32x4 ov[4][2];
#pragma unroll
            for (int m = 0; m < 4; ++m)
#pragma unroll
                for (int bj = 0; bj < 2; ++bj) ov[m][bj] = *(const u32x4*)(Y + (size_t)(row0 + ai * HALF + m * 16) * PP + col0 + bj * HALF);
#pragma unroll
            for (int m = 0; m < 4; ++m) {
                const float r = rsv[ai * 4 + m];
                bf16_t* rowp = Y + (size_t)(row0 + ai * HALF + m * 16) * PP + col0;
#pragma unroll
                for (int bj = 0; bj < 2; ++bj) {
                    const u32x4 o = ov[m][bj];
                    float v[8];
#pragma unroll
                    for (int i = 0; i < 4; ++i) { v[i] = silu_f(acc[ai][bj][m][0][i] * r); v[4 + i] = silu_f(acc[ai][bj][m][1][i] * r); }
                    u32x4 w;
                    w.x = cvtpk(v[0] * bflo(o.x), v[1] * bfhi(o.x)); w.y = cvtpk(v[2] * bflo(o.y), v[3] * bfhi(o.y));
                    w.z = cvtpk(v[4] * bflo(o.z), v[5] * bfhi(o.z)); w.w = cvtpk(v[6] * bflo(o.w), v[7] * bfhi(o.w));
                    *(u32x4*)(rowp + bj * HALF) = w;
                }
            }
            asm volatile("" ::: "memory");
        }
        if (ssd) {
            float rsd[8]; row_rs8(ssd, row0, fq, rsd);
#pragma unroll
            for (int bj = 0; bj < 2; ++bj) {
                const f32x4 w0 = *(const f32x4*)(ssdw + col0 + bj * HALF), w1 = *(const f32x4*)(ssdw + col0 + bj * HALF + 4);
                u32x4 yv[8];
#pragma unroll
                for (int i = 0; i < 8; ++i) yv[i] = *(const u32x4*)(YA + (size_t)(row0 + (i >> 2) * HALF + (i & 3) * 16) * PP + col0 + bj * HALF);
#pragma unroll
                for (int i = 0; i < 8; ++i) {
                    const float rr = rsd[i]; u32x4 y = yv[i];
                    y.x = cvtpk(bflo(y.x) * rr * w0[0], bfhi(y.x) * rr * w0[1]); y.y = cvtpk(bflo(y.y) * rr * w0[2], bfhi(y.y) * rr * w0[3]);
                    y.z = cvtpk(bflo(y.z) * rr * w1[0], bfhi(y.z) * rr * w1[1]); y.w = cvtpk(bflo(y.w) * rr * w1[2], bfhi(y.w) * rr * w1[3]);
                    *(u32x4*)(YA + (size_t)(row0 + (i >> 2) * HALF + (i & 3) * 16) * PP + col0 + bj * HALF) = y;
                }
                asm volatile("" ::: "memory");
            }
        }
    }
};
struct EpiOut {
    static constexpr bool PERM = false, AFTER_DRAIN = false; static constexpr int PID = 3;
    const float* hin; float* hout; bf16_t* U; float* ssq;
    __device__ __forceinline__ void operator()(const f32x4 (&acc)[2][2][4][2], const Unit& u, int wr, int wc, int fr, int fq) const {
        const int row0 = u.pm * BM + wr * 64 + fr; const int col0 = u.pn * BM + wc * 32 + 4 * fq;
#pragma unroll
        for (int ai = 0; ai < 2; ++ai)
#pragma unroll
            for (int m = 0; m < 4; ++m) {
                const int row = row0 + ai * HALF + m * 16;
                const size_t off = (size_t)row * DM + col0;
                float s = 0.f;
#pragma unroll
                for (int bj = 0; bj < 2; ++bj)
#pragma unroll
                    for (int n = 0; n < 2; ++n) {
                        const f32x4 hv = *(const f32x4*)(hin + off + bj * HALF + n * 16) + acc[ai][bj][m][n];
                        *(f32x4*)(hout + off + bj * HALF + n * 16) = hv;
                        if (U) { u32x2 w; w.x = cvtpk(hv[0], hv[1]); w.y = cvtpk(hv[2], hv[3]); *(u32x2*)(U + off + bj * HALF + n * 16) = w; }
                        s += (hv[0] * hv[0] + hv[1] * hv[1]) + (hv[2] * hv[2] + hv[3] * hv[3]);
                    }
                s += shx<16>(s); s = sum_x32(s);
                if (fq == 0) ssq[(size_t)row * 16 + u.pn * 4 + wc] = s;
                if (m == 3) asm volatile("" ::: "memory");
            }
    }
};
template <class Epi, class Sched, bool ALIGN_EPI, bool SP2, int KK, int LDA>
__device__ __forceinline__ void gemm_phase(PG8_LAS unsigned char* lds, const Gemm g, const Sched& S, const Epi& E, int tid_arg) {
    int tid = tid_arg; asm volatile("" : "+v"(tid));
    const int wid = __builtin_amdgcn_readfirstlane(tid >> 6), lane = tid & 63, wr = wid >> 2, wc = wid & 3, fr = lane & 15, fq = lane >> 4;
    constexpr int K = KK, nt = K / BK;
    unsigned voffA[2], voffB[2];
#pragma unroll
    for (int i = 0; i < 2; ++i) { int R, C; stage_rc(tid * 16 + i * 8192, R, C); const int Rb = Epi::PERM ? ((R & ~31) + perm32(R & 31)) : R;
        voffA[i] = (unsigned)(R * LDA + C) * 2u; voffB[i] = (unsigned)(Rb * K + C) * 2u; }
    constexpr size_t kstep = (size_t)(BK * 2);
    constexpr size_t hstepA = (size_t)HALF * LDA * 2, hstepB = (size_t)HALF * K * 2;
    constexpr size_t tstepA = 2 * hstepA, tstepB = 2 * hstepB;
    const unsigned ldsw = (unsigned)wid * 1024u;
    const int aoff = lds_byte(wr * 64 + fr, fq * 8), boff = lds_byte(wc * 32 + fr, fq * 8);
#define PG8_SA(b, h) (((b) * 2 + (h)) * HTB)
#define PG8_SB(b, h) ((4 + (b) * 2 + (h)) * HTB)
#define PG8_STAGE(bufoff, gbase, voff) do { _Pragma("unroll") for (int _i = 0; _i < 2; ++_i) \
        __builtin_amdgcn_global_load_lds((const unsigned*)((const char*)(gbase) + (voff)[_i]), (PG8_LAS unsigned*)(lds + (bufoff) + ldsw + _i * 8192), 16, 0, 0); } while (0)
#define PG8_LDA(dst, b, h) do { _Pragma("unroll") for (int m = 0; m < 4; ++m) _Pragma("unroll") for (int k = 0; k < 2; ++k) dst[m][k] = *(const PG8_LAS bf16x8*)(lds + PG8_SA(b, h) + aoff + m * 2048 + k * 1024); } while (0)
#define PG8_LDB(dst, b, h) do { _Pragma("unroll") for (int n = 0; n < 2; ++n) _Pragma("unroll") for (int k = 0; k < 2; ++k) dst[n][k] = *(const PG8_LAS bf16x8*)(lds + PG8_SB(b, h) + boff + n * 2048 + k * 1024); } while (0)
#define PG8_MMA(ai, bj, At, Bt) do { __builtin_amdgcn_s_setprio(1); _Pragma("unroll") for (int m = 0; m < 4; ++m) _Pragma("unroll") for (int n = 0; n < 2; ++n) _Pragma("unroll") for (int k = 0; k < 2; ++k) \
        acc[ai][bj][m][n] = __builtin_amdgcn_mfma_f32_16x16x32_bf16(Bt[n][k], At[m][k], acc[ai][bj][m][n], 0, 0, 0); __builtin_amdgcn_s_setprio(0); } while (0)
#define PG8_WAIT_V(n) asm volatile("s_waitcnt vmcnt(" #n ")" ::: "memory")
#define PG8_WAIT_L(n) asm volatile("s_waitcnt lgkmcnt(" #n ")" ::: "memory")
#define PG8_BAR __builtin_amdgcn_s_barrier()
#define PG8_SCHED __builtin_amdgcn_sched_barrier(0)
    Unit cur, nxt; int ui = 0;
    if (!S.next(0, cur)) return;
    f32x4 acc[2][2][4][2];
#pragma unroll
    for (int a = 0; a < 2; ++a)
#pragma unroll
        for (int b = 0; b < 2; ++b)
#pragma unroll
            for (int m = 0; m < 4; ++m)
#pragma unroll
                for (int n = 0; n < 2; ++n) acc[a][b][m][n] = (f32x4){0.f, 0.f, 0.f, 0.f};
    bf16x8 At[4][2], B0[2][2], B1[2][2];
    const char* cA = (const char*)g.A + (size_t)cur.pm * tstepA; const char* cB = (const char*)g.Bt + (size_t)cur.pn * tstepB;
    S.a_ready(cur);
    if constexpr (SP2) {
        PG8_STAGE(PG8_SB(0, 0), cB, voffB); PG8_STAGE(PG8_SB(0, 1), cB + hstepB, voffB); PG8_STAGE(PG8_SA(0, 0), cA, voffA); PG8_STAGE(PG8_SA(0, 1), cA + hstepA, voffA);
        if (wr == 1) PG8_BAR;
        PG8_WAIT_V(2); PG8_BAR;
        PG8_STAGE(PG8_SB(1, 0), cB + kstep, voffB); PG8_STAGE(PG8_SA(1, 0), cA + kstep, voffA); PG8_STAGE(PG8_SB(1, 1), cB + hstepB + kstep, voffB);
        PG8_WAIT_V(6); PG8_BAR;
    } else {
        PG8_STAGE(PG8_SB(0, 0), cB, voffB); PG8_STAGE(PG8_SA(0, 0), cA, voffA); PG8_STAGE(PG8_SB(0, 1), cB + hstepB, voffB); PG8_STAGE(PG8_SA(0, 1), cA + hstepA, voffA);
        if (wr == 1) PG8_BAR;
        PG8_WAIT_V(4); PG8_BAR;
        PG8_STAGE(PG8_SB(1, 0), cB + kstep, voffB); PG8_STAGE(PG8_SA(1, 0), cA + kstep, voffA); PG8_STAGE(PG8_SB(1, 1), cB + hstepB + kstep, voffB);
        PG8_WAIT_V(6); PG8_BAR;
    }
    for (;;) {
        const bool has_next = S.next(ui + 1, nxt);
        const char* nA = has_next ? (const char*)g.A + (size_t)nxt.pm * tstepA : cA; const char* nB = has_next ? (const char*)g.Bt + (size_t)nxt.pn * tstepB : cB;
        for (int t = 0; t < nt; t += 2) {
            const bool last = (t == nt - 2);
            const char* a1 = cA + (size_t)(t + 1) * kstep;
            const char* a2 = last ? nA : cA + (size_t)(t + 2) * kstep; const char* b2 = last ? nB : cB + (size_t)(t + 2) * kstep;
            const char* a3 = a2 + kstep; const char* b3 = b2 + kstep;
            if (last && has_next) S.a_ready(nxt);
            if constexpr (SP2) {
            PG8_LDB(B0, 0, 0); PG8_LDB(B1, 0, 1); PG8_SCHED; PG8_LDA(At, 0, 0); PG8_STAGE(PG8_SA(1, 1), a1 + hstepA, voffA);
            PG8_WAIT_V(8); PG8_WAIT_L(0); PG8_BAR; PG8_MMA(0, 0, At, B0); PG8_MMA(0, 1, At, B1); PG8_BAR; PG8_SCHED;
            PG8_LDA(At, 0, 1); PG8_STAGE(PG8_SB(0, 0), b2, voffB); PG8_STAGE(PG8_SB(0, 1), b2 + hstepB, voffB); PG8_STAGE(PG8_SA(0, 0), a2, voffA);
            PG8_WAIT_V(8); PG8_WAIT_L(0); PG8_BAR; PG8_MMA(1, 0, At, B0); PG8_MMA(1, 1, At, B1); PG8_BAR; PG8_SCHED;
            PG8_LDB(B0, 1, 0); PG8_LDB(B1, 1, 1); PG8_SCHED; PG8_LDA(At, 1, 0); PG8_STAGE(PG8_SA(0, 1), a2 + hstepA, voffA);
            PG8_WAIT_V(8); PG8_WAIT_L(0); PG8_BAR; PG8_MMA(0, 0, At, B0); PG8_MMA(0, 1, At, B1); PG8_BAR; PG8_SCHED;
            PG8_LDA(At, 1, 1); PG8_STAGE(PG8_SB(1, 0), b3, voffB); PG8_STAGE(PG8_SB(1, 1), b3 + hstepB, voffB); PG8_STAGE(PG8_SA(1, 0), a3, voffA);
            PG8_WAIT_V(8); PG8_WAIT_L(0); PG8_BAR; PG8_MMA(1, 0, At, B0); PG8_MMA(1, 1, At, B1); PG8_BAR; PG8_SCHED;
            } else {
            PG8_LDB(B0, 0, 0); PG8_SCHED; PG8_LDA(At, 0, 0); PG8_STAGE(PG8_SA(1, 1), a1 + hstepA, voffA);
            PG8_WAIT_L(8); PG8_BAR; PG8_WAIT_L(0); PG8_MMA(0, 0, At, B0); PG8_BAR; PG8_SCHED;
            PG8_LDB(B1, 0, 1); PG8_STAGE(PG8_SB(0, 0), b2, voffB);
            PG8_BAR; PG8_WAIT_L(0); PG8_MMA(0, 1, At, B1); PG8_BAR;
            PG8_LDA(At, 0, 1); PG8_STAGE(PG8_SA(0, 0), a2, voffA);
            PG8_BAR; PG8_WAIT_L(0); PG8_MMA(1, 0, At, B0); PG8_BAR; PG8_SCHED;
            PG8_STAGE(PG8_SB(0, 1), b2 + hstepB, voffB);
            PG8_WAIT_V(6); PG8_BAR; PG8_MMA(1, 1, At, B1); PG8_BAR;
            PG8_LDB(B0, 1, 0); PG8_SCHED; PG8_LDA(At, 1, 0); PG8_STAGE(PG8_SA(0, 1), a2 + hstepA, voffA);
            PG8_WAIT_L(8); PG8_BAR; PG8_WAIT_L(0); PG8_MMA(0, 0, At, B0); PG8_BAR; PG8_SCHED;
            PG8_LDB(B1, 1, 1); PG8_STAGE(PG8_SB(1, 0), b3, voffB);
            PG8_BAR; PG8_WAIT_L(0); PG8_MMA(0, 1, At, B1); PG8_BAR;
            PG8_LDA(At, 1, 1); PG8_STAGE(PG8_SA(1, 0), a3, voffA);
            PG8_BAR; PG8_WAIT_L(0); PG8_MMA(1, 0, At, B0); PG8_BAR; PG8_SCHED;
            PG8_STAGE(PG8_SB(1, 1), b3 + hstepB, voffB);
            PG8_WAIT_V(6); PG8_BAR; PG8_MMA(1, 1, At, B1); PG8_BAR;
            }
        }
        if constexpr (ALIGN_EPI) { if (wr == 0) PG8_BAR; }
        if constexpr (!Epi::AFTER_DRAIN) { unsigned long long _ptE = 0ull; if (Epi::PID == PROBE_SECV && blockIdx.x == 0 && wid == 0) _ptE = __builtin_amdgcn_s_memrealtime(); E(acc, cur, wr, wc, fr, fq); if (Epi::PID == PROBE_SECV && blockIdx.x == 0 && wid == 0) { volatile unsigned long long* _a = (volatile unsigned long long*)((unsigned char*)lds + 147456 - 128); *_a = *_a + (__builtin_amdgcn_s_memrealtime() - _ptE); } S.done(cur); }
        if (!has_next) break;
#pragma unroll
        for (int a = 0; a < 2; ++a)
#pragma unroll
            for (int b = 0; b < 2; ++b)
#pragma unroll
                for (int m = 0; m < 4; ++m)
#pragma unroll
                    for (int n = 0; n < 2; ++n) acc[a][b][m][n] = (f32x4){0.f, 0.f, 0.f, 0.f};
        cur = nxt; cA = nA; cB = nB; ++ui;
        if constexpr (ALIGN_EPI) { if (wr == 1) PG8_BAR; }
    }
    PG8_WAIT_V(0);
    if constexpr (!ALIGN_EPI) { if (wr == 0) PG8_BAR; }
    PG8_BAR;
    if constexpr (Epi::AFTER_DRAIN) { E.fused(acc, cur, wr, wc, fr, fq, lds, wid, lane); S.done(cur); }
#undef PG8_SA
#undef PG8_SB
#undef PG8_STAGE
#undef PG8_LDA
#undef PG8_LDB
#undef PG8_MMA
#undef PG8_WAIT_V
#undef PG8_WAIT_L
#undef PG8_BAR
#undef PG8_SCHED
}
}

constexpr size_t MiB = 1u << 20;
constexpr size_t WS_P = 0;
constexpr size_t WS_U = 384 * MiB;
constexpr size_t WS_WE_IN = 448 * MiB, WS_WE_G = 460 * MiB, WS_WE_OUT = 462 * MiB, WS_WE_DT = 466 * MiB;
constexpr size_t WS_WO_IN = 468 * MiB, WS_WO_G = 480 * MiB, WS_WO_OUT = 484 * MiB;
constexpr size_t WS_DT = 488 * MiB;
constexpr size_t WS_SSQ = 490 * MiB;
constexpr size_t WS_SSD = 492 * MiB;
constexpr size_t WS_BAR = 494 * MiB;
constexpr size_t WS_BAR_BYTES = 65536;
constexpr size_t WS_LB = 494 * MiB + 65536;
constexpr size_t WS_END = 495 * MiB;
constexpr int LDS_BYTES = 147456;
#ifndef PG8SP2
#define PG8SP2 true
#endif

struct Params {
    const float *x, *norm_w, *final_norm_w, *rel_bias, *even_w_in, *even_w_out, *conv_w, *conv_b, *dt_bias, *A_log, *D_skip, *ssd_norm_w,
        *lq1, *lk1, *lq2, *lk2, *subln_w, *odd_w_in, *odd_w_out, *hgrn_lb, *hgrn_norm_w;
    float* out; unsigned char* ws;
};

typedef const __attribute__((address_space(4))) Params* PPtr;
__device__ __forceinline__ PPtr get_params() { const __attribute__((address_space(4))) void* k = (const __attribute__((address_space(4))) void*)__builtin_amdgcn_kernarg_segment_ptr(); asm volatile("" : "+s"(k)); return (PPtr)k; }
struct Seg { const float* W; int ldw, col0, ncols, K; bf16_t* WT; int row0; const float* scale; };
__device__ __forceinline__ void convert_seg(const Seg s, float* scr, int gw, int NGW, int lane) {
    const int nblk = (s.ncols + 31) / 32, nitems = (s.K / 64) * nblk;
    for (int it = gw; it < nitems; it += NGW) {
        const int kb = it / nblk, nb = it % nblk, k0 = 64 * kb, n0 = 32 * nb;
        const int nc = lane & 31; const bool okc = (n0 + nc) < s.ncols;
        float wv[32];
#pragma unroll
        for (int i = 0; i < 32; ++i) { const int kk = 2 * i + (lane >> 5); wv[i] = okc ? s.W[(size_t)(k0 + kk) * s.ldw + s.col0 + n0 + nc] : 0.f; }
        if (s.scale) {
#pragma unroll
            for (int i = 0; i < 32; ++i) wv[i] *= s.scale[k0 + 2 * i + (lane >> 5)];
        }
#pragma unroll
        for (int i = 0; i < 32; ++i) scr[(2 * i + (lane >> 5)) * 33 + nc] = wv[i];
        __builtin_amdgcn_fence(__ATOMIC_RELEASE, "workgroup"); __builtin_amdgcn_wave_barrier();
        const int c = lane & 7;
#pragma unroll
        for (int j = 0; j < 4; ++j) {
            const int n = (lane >> 3) + 8 * j; const float* sp = scr + (8 * c) * 33 + n;
            u32x4 o; o.x = cvtpk(sp[0 * 33], sp[1 * 33]); o.y = cvtpk(sp[2 * 33], sp[3 * 33]); o.z = cvtpk(sp[4 * 33], sp[5 * 33]); o.w = cvtpk(sp[6 * 33], sp[7 * 33]);
            if (n0 + n < s.ncols) *(u32x4*)(s.WT + (size_t)(s.row0 + n0 + n) * s.K + k0 + 8 * c) = o;
        }
        __builtin_amdgcn_fence(__ATOMIC_RELEASE, "workgroup"); __builtin_amdgcn_wave_barrier();
    }
}
__device__ __forceinline__ void convert_layer(PPtr p, int layer, float* scr, int gw, int NGW, int lane) {
    const float* nw = p->norm_w + (size_t)layer * DM;
    if ((layer & 1) == 0) {
        const int e = layer >> 1;
        const float* Wi = p->even_w_in + (size_t)e * DM * 7184; const float* Wo = p->even_w_out + (size_t)e * 2048 * DM;
        bf16_t* WIN = (bf16_t*)(p->ws + WS_WE_IN);
        convert_seg(Seg{Wi, 7184, 0, 1024, DM, WIN, 0, nw}, scr, gw, NGW, lane);
        convert_seg(Seg{Wi, 7184, 3088, 1024, DM, WIN, 1024, nw}, scr, gw, NGW, lane);
        convert_seg(Seg{Wi, 7184, 1024, 2048, DM, WIN, 2048, nw}, scr, gw, NGW, lane);
        convert_seg(Seg{Wi, 7184, 4112, 2048, DM, WIN, 4096, nw}, scr, gw, NGW, lane);
        convert_seg(Seg{Wi, 7184, 6160, 1024, DM, (bf16_t*)(p->ws + WS_WE_G), 0, nw}, scr, gw, NGW, lane);
        convert_seg(Seg{Wi, 7184, 3072, 16, DM, (bf16_t*)(p->ws + WS_WE_DT), 0, nw}, scr, gw, NGW, lane);
        convert_seg(Seg{Wo, DM, 0, 1024, 2048, (bf16_t*)(p->ws + WS_WE_OUT), 0, nullptr}, scr, gw, NGW, lane);
    } else {
        const int o = layer >> 1;
        const float* Wi = p->odd_w_in + (size_t)o * DM * 8192; const float* Wo = p->odd_w_out + (size_t)o * 2048 * DM;
        convert_seg(Seg{Wi, 8192, 0, 6144, DM, (bf16_t*)(p->ws + WS_WO_IN), 0, nw}, scr, gw, NGW, lane);
        convert_seg(Seg{Wi, 8192, 6144, 2048, DM, (bf16_t*)(p->ws + WS_WO_G), 0, nw}, scr, gw, NGW, lane);
        convert_seg(Seg{Wo, DM, 0, 1024, 2048, (bf16_t*)(p->ws + WS_WO_OUT), 0, nullptr}, scr, gw, NGW, lane);
    }
}

__device__ __forceinline__ void dt_items(PPtr p, int e, int gw, int NGW, int lane) {
    const bf16_t* U = (const bf16_t*)(p->ws + WS_U); const bf16_t* Wdt = (const bf16_t*)(p->ws + WS_WE_DT);
    const float* ssq = (const float*)(p->ws + WS_SSQ); float* dt = (float*)(p->ws + WS_DT);
    const int fr = lane & 15, fq = lane >> 4;
    for (int item = gw; item < T_TOK / 16; item += NGW) {
        const int row0 = item * 16;
        f32x4 acc = {0.f, 0.f, 0.f, 0.f};
        const bf16x8* ap = (const bf16x8*)(U + (size_t)(row0 + fr) * DM + fq * 8);
        const bf16x8* bp = (const bf16x8*)(Wdt + (size_t)fr * DM + fq * 8);
#pragma unroll 8
        for (int s = 0; s < 32; ++s) acc = __builtin_amdgcn_mfma_f32_16x16x32_bf16(ap[s * 4], bp[s * 4], acc, 0, 0, 0);
        const float bias = p->dt_bias[e * 16 + fr];
#pragma unroll
        for (int i = 0; i < 4; ++i) {
            const int row = row0 + 4 * fq + i;
            const float v = acc[i] * row_rs(ssq, row) + bias;
            dt[(size_t)row * 16 + fr] = (v > 20.f) ? v : log1pf(__expf(v));
        }
    }
}

typedef short v4i16_t __attribute__((ext_vector_type(4)));
__device__ __forceinline__ s16x4 vtr(const bf16_t* ptr) { return __builtin_bit_cast(s16x4, __builtin_amdgcn_ds_read_tr16_b64_v4i16((LAS v4i16_t*)ptr)); }
__device__ __forceinline__ void ssd_unit(PPtr p, int e, int b, int h, unsigned char* lds, int tid) {
    float* sx = (float*)lds;
    float* sB = sx + 16 * 64;
    float* sC = sB + 16 * 128;
    float* sy = sC + 16 * 128;
    float* sdt = sy + 16 * 64;
    float* sda = sdt + 16;
    bf16_t* P = (bf16_t*)(p->ws + WS_P);
    const float* dt = (const float*)(p->ws + WS_DT); float* ssd = (float*)(p->ws + WS_SSD);
    const float* cw = p->conv_w + (size_t)e * 4 * 2048; const float* cb = p->conv_b + (size_t)e * 2048;
    const float Ah = -__expf(p->A_log[e * 16 + h]), Dh = p->D_skip[e * 16 + h];
    const int g = h >> 2, pp = tid >> 3, nq = tid & 7;
    const size_t rowb = (size_t)b * SEQ;
    float st[16];
#pragma unroll
    for (int i = 0; i < 16; ++i) st[i] = 0.f;
    for (int c = 0; c < SEQ / 16; ++c) {
        const int t0 = c * 16;
        for (int it = tid; it < 1280; it += 512) {
            const int t = it / 80, q4 = it % 80;
            int ch; float* dst;
            if (q4 < 16) { ch = h * 64 + q4 * 4; dst = sx + t * 64 + q4 * 4; }
            else if (q4 < 48) { ch = 1024 + g * 128 + (q4 - 16) * 4; dst = sB + t * 128 + (q4 - 16) * 4; }
            else { ch = 1536 + g * 128 + (q4 - 48) * 4; dst = sC + t * 128 + (q4 - 48) * 4; }
            f32x4 a = *(const f32x4*)(cb + ch);
#pragma unroll
            for (int j = 0; j < 4; ++j) {
                const int tt = t0 + t - 3 + j;
                if (tt >= 0) {
                    const u32x2 raw = *(const u32x2*)(P + (rowb + tt) * PP + 2048 + ch);
                    const f32x4 w = *(const f32x4*)(cw + j * 2048 + ch);
                    a[0] += w[0] * bflo(raw.x); a[1] += w[1] * bfhi(raw.x); a[2] += w[2] * bflo(raw.y); a[3] += w[3] * bfhi(raw.y);
                }
            }
            f32x4 o; o[0] = silu_f(a[0]); o[1] = silu_f(a[1]); o[2] = silu_f(a[2]); o[3] = silu_f(a[3]);
            *(f32x4*)dst = o;
        }
        if (tid < 16) { const float d = dt[(rowb + t0 + tid) * 16 + h]; sdt[tid] = d; sda[tid] = __expf(d * Ah); }
        __syncthreads();
        for (int t = 0; t < 16; ++t) {
            const float xv = sx[t * 64 + pp]; const float X = xv * sdt[t], da = sda[t];
            float y = 0.f;
#pragma unroll
            for (int i4 = 0; i4 < 4; ++i4) {
                const f32x4 bv = *(const f32x4*)(sB + t * 128 + nq * 16 + i4 * 4), cv = *(const f32x4*)(sC + t * 128 + nq * 16 + i4 * 4);
#pragma unroll
                for (int i = 0; i < 4; ++i) { st[i4 * 4 + i] = da * st[i4 * 4 + i] + X * bv[i]; y += cv[i] * st[i4 * 4 + i]; }
            }
            y += shx<1>(y); y += shx<2>(y); y += shx<4>(y);
            if (nq == 0) sy[t * 64 + pp] = y + Dh * xv;
        }
        __syncthreads();
        {
            const int t = tid >> 5, p2 = (tid & 31) * 2;
            bf16_t* zp = P + (rowb + t0 + t) * PP + h * 64 + p2;
            const unsigned zw = *(const unsigned*)zp;
            const float g0 = sy[t * 64 + p2] * silu_f(bflo(zw)), g1 = sy[t * 64 + p2 + 1] * silu_f(bfhi(zw));
            float ss = g0 * g0 + g1 * g1;
            ss += shx<1>(ss); ss += shx<2>(ss); ss += shx<4>(ss); ss += shx<8>(ss); ss += shx<16>(ss);
            *(unsigned*)zp = cvtpk(g0, g1);
            if ((tid & 31) == 0) ssd[(rowb + t0 + t) * 16 + h] = ss;
        }
    }
    __syncthreads();
}

__device__ __forceinline__ bf16x8 scale_frag(s16x4 lo, s16x4 hi, const f32x4 w0, const f32x4 w1) {
    u32x4 o;
    o.x = cvtpk(__uint_as_float((unsigned)(unsigned short)lo[0] << 16) * w0[0], __uint_as_float((unsigned)(unsigned short)lo[1] << 16) * w0[1]);
    o.y = cvtpk(__uint_as_float((unsigned)(unsigned short)lo[2] << 16) * w0[2], __uint_as_float((unsigned)(unsigned short)lo[3] << 16) * w0[3]);
    o.z = cvtpk(__uint_as_float((unsigned)(unsigned short)hi[0] << 16) * w1[0], __uint_as_float((unsigned)(unsigned short)hi[1] << 16) * w1[1]);
    o.w = cvtpk(__uint_as_float((unsigned)(unsigned short)hi[2] << 16) * w1[2], __uint_as_float((unsigned)(unsigned short)hi[3] << 16) * w1[3]);
    return __builtin_bit_cast(bf16x8, o);
}
template <int NR> __device__ __forceinline__ void ssd_stage_rows(const bf16_t* P, size_t rowb, int t0, int lrow0, int ch, bf16_t* dst, int dstr, const float* cw, const float* cb) {
    float wt[4][8], bias[8];
#pragma unroll
    for (int j = 0; j < 4; ++j) { const f32x4 a = *(const f32x4*)(cw + j * 2048 + ch), bq = *(const f32x4*)(cw + j * 2048 + ch + 4);
        wt[j][0] = a[0]; wt[j][1] = a[1]; wt[j][2] = a[2]; wt[j][3] = a[3]; wt[j][4] = bq[0]; wt[j][5] = bq[1]; wt[j][6] = bq[2]; wt[j][7] = bq[3]; }
    { const f32x4 a = *(const f32x4*)(cb + ch), bq = *(const f32x4*)(cb + ch + 4); bias[0] = a[0]; bias[1] = a[1]; bias[2] = a[2]; bias[3] = a[3]; bias[4] = bq[0]; bias[5] = bq[1]; bias[6] = bq[2]; bias[7] = bq[3]; }
    const int r0 = t0 + lrow0;
    u32x4 raw[NR + 3];
#pragma unroll
    for (int k = 0; k < NR + 3; ++k) {
        const int tt = r0 - 3 + k;
        raw[k] = (tt >= 0) ? *(const u32x4*)(P + (rowb + tt) * PP + 2048 + ch) : (u32x4){0u, 0u, 0u, 0u};
    }
#pragma unroll
    for (int k = 0; k < NR; ++k) {
        float acc[8];
#pragma unroll
        for (int q = 0; q < 8; ++q) acc[q] = bias[q];
#pragma unroll
        for (int j = 0; j < 4; ++j) {
            const u32x4 rw = raw[k + j];
            acc[0] += wt[j][0] * bflo(rw.x); acc[1] += wt[j][1] * bfhi(rw.x); acc[2] += wt[j][2] * bflo(rw.y); acc[3] += wt[j][3] * bfhi(rw.y);
            acc[4] += wt[j][4] * bflo(rw.z); acc[5] += wt[j][5] * bfhi(rw.z); acc[6] += wt[j][6] * bflo(rw.w); acc[7] += wt[j][7] * bfhi(rw.w);
        }
        u32x4 o; o.x = cvtpk(silu_f(acc[0]), silu_f(acc[1])); o.y = cvtpk(silu_f(acc[2]), silu_f(acc[3])); o.z = cvtpk(silu_f(acc[4]), silu_f(acc[5])); o.w = cvtpk(silu_f(acc[6]), silu_f(acc[7]));
        *(u32x4*)(dst + (lrow0 + k) * dstr) = o;
    }
}
__device__ __forceinline__ void ssd_unit_mfma(PPtr p, int e, int b, int h, unsigned char* lds, int tid) {
    constexpr int CS = 136, BS = 144, XS = 72, SS = 136;
    bf16_t* sC = (bf16_t*)lds;
    bf16_t* sB = sC + 128 * CS;
    bf16_t* sX = sB + 128 * BS;
    bf16_t* sSt = sX + 128 * XS;
    float* sAcs = (float*)(sSt + 2 * 64 * SS);
    float* sDt = sAcs + 128;
    float* sW = sDt + 128;
    float* sDec = sW + 128;
    bf16_t* P = (bf16_t*)(p->ws + WS_P);
    const float* dt = (const float*)(p->ws + WS_DT); float* ssd = (float*)(p->ws + WS_SSD);
    const float* cw = p->conv_w + (size_t)e * 4 * 2048; const float* cb = p->conv_b + (size_t)e * 2048;
    const float Ah = -__expf(p->A_log[e * 16 + h]), Dh = p->D_skip[e * 16 + h];
    const int lane = tid & 63, w = __builtin_amdgcn_readfirstlane(tid >> 6), c16 = lane & 15, g = lane >> 4, tq = c16 >> 2, tp = c16 & 3;
    const int grp = h >> 2;
    const size_t rowb = (size_t)b * SEQ;
    f32x4 stacc[4];
#pragma unroll
    for (int pt = 0; pt < 4; ++pt) stacc[pt] = (f32x4){0.f, 0.f, 0.f, 0.f};
    for (int i = tid; i < 64 * SS / 2; i += 512) ((unsigned*)sSt)[i] = 0u;
    for (int c = 0; c < SEQ / 128; ++c) {
        const int cur = c & 1, nxt = cur ^ 1;
        const int t0 = c * 128;
        PSEC_B(4)
        {
            { const int it = tid; const int cg8 = it % 40, seg = it / 40;
              int ch; bf16_t* dst; int dstr;
              if (cg8 < 8) { ch = h * 64 + cg8 * 8; dst = sX + cg8 * 8; dstr = XS; }
              else if (cg8 < 24) { ch = 1024 + grp * 128 + (cg8 - 8) * 8; dst = sB + (cg8 - 8) * 8; dstr = BS; }
              else { ch = 1536 + grp * 128 + (cg8 - 24) * 8; dst = sC + (cg8 - 24) * 8; dstr = CS; }
              ssd_stage_rows<8>(P, rowb, t0, seg * 8, ch, dst, dstr, cw, cb); }
            { const int it = 512 + (tid >> 2); const int cg8 = it % 40, seg = it / 40;
              int ch; bf16_t* dst; int dstr;
              if (cg8 < 8) { ch = h * 64 + cg8 * 8; dst = sX + cg8 * 8; dstr = XS; }
              else if (cg8 < 24) { ch = 1024 + grp * 128 + (cg8 - 8) * 8; dst = sB + (cg8 - 8) * 8; dstr = BS; }
              else { ch = 1536 + grp * 128 + (cg8 - 24) * 8; dst = sC + (cg8 - 24) * 8; dstr = CS; }
              ssd_stage_rows<2>(P, rowb, t0, seg * 8 + 2 * (tid & 3), ch, dst, dstr, cw, cb); }
        }
        if (w == 0) {
            const float d0 = dt[(rowb + t0 + 2 * lane) * 16 + h], d1 = dt[(rowb + t0 + 2 * lane + 1) * 16 + h];
            const float a0 = d0 * Ah, a1 = d1 * Ah;
            float sc = a0 + a1;
#pragma unroll
            for (int o = 1; o < 64; o <<= 1) { const float t = bperm(lane - o, sc); if (lane >= o) sc += t; }
            const float acs1 = sc, acs0 = sc - a1;
            const float alast = bperm(63, sc);
            sAcs[2 * lane] = acs0; sAcs[2 * lane + 1] = acs1; sDt[2 * lane] = d0; sDt[2 * lane + 1] = d1;
            sW[2 * lane] = d0 * __expf(alast - acs0); sW[2 * lane + 1] = d1 * __expf(alast - acs1);
            sDec[2 * lane] = __expf(acs0); sDec[2 * lane + 1] = __expf(acs1);
        }
        __syncthreads();
        PSEC_E(4, lds) PSEC_B(5)
        {
            const int lrow = 16 * w + c16;
            bf16_t zr[4][4];
#pragma unroll
            for (int pt = 0; pt < 4; ++pt)
#pragma unroll
                for (int j = 0; j < 4; ++j) zr[pt][j] = P[(rowb + t0 + 16 * w + 4 * g + j) * PP + h * 64 + 16 * pt + c16];
            bf16x8 cf[4];
#pragma unroll
            for (int ks = 0; ks < 4; ++ks) cf[ks] = *(const bf16x8*)(sC + lrow * CS + 32 * ks + 8 * g);
            f32x4 acc[4];
#pragma unroll
            for (int pt = 0; pt < 4; ++pt) {
                f32x4 a = {0.f, 0.f, 0.f, 0.f};
#pragma unroll
                for (int ks = 0; ks < 4; ++ks) {
                    const bf16x8 sf = *(const bf16x8*)(sSt + (cur * 64 + 16 * pt + c16) * SS + 32 * ks + 8 * g);
                    a = __builtin_amdgcn_mfma_f32_16x16x32_bf16(cf[ks], sf, a, 0, 0, 0);
                }
                acc[pt] = a;
            }
            {
                const f32x4 dl = *(const f32x4*)(sDec + 16 * w + 4 * g);
#pragma unroll
                for (int pt = 0; pt < 4; ++pt) { acc[pt][0] *= dl[0]; acc[pt][1] *= dl[1]; acc[pt][2] *= dl[2]; acc[pt][3] *= dl[3]; }
            }
            const float al = sAcs[lrow];
#pragma unroll
            for (int kp = 0; kp < 4; ++kp) {
                if (2 * kp <= w) {
                    u32x4 pk = {0u, 0u, 0u, 0u};
#pragma unroll
                    for (int hf = 0; hf < 2; ++hf) {
                        const int st = 2 * kp + hf;
                        if (st <= w) {
                            f32x4 a = {0.f, 0.f, 0.f, 0.f};
#pragma unroll
                            for (int ks = 0; ks < 4; ++ks) {
                                const bf16x8 bf = *(const bf16x8*)(sB + (16 * st + c16) * BS + 32 * ks + 8 * g);
                                a = __builtin_amdgcn_mfma_f32_16x16x32_bf16(bf, cf[ks], a, 0, 0, 0);
                            }
                            const f32x4 as = *(const f32x4*)(sAcs + 16 * st + 4 * g), ds = *(const f32x4*)(sDt + 16 * st + 4 * g);
                            float v[4];
#pragma unroll
                            for (int j = 0; j < 4; ++j) {
                                const int srow = 16 * st + 4 * g + j;
                                v[j] = (srow <= lrow) ? a[j] * __expf(al - as[j]) * ds[j] : 0.f;
                            }
                            if (hf == 0) { pk.x = cvtpk(v[0], v[1]); pk.y = cvtpk(v[2], v[3]); } else { pk.z = cvtpk(v[0], v[1]); pk.w = cvtpk(v[2], v[3]); }
                        }
                    }
                    const bf16x8 pa = __builtin_bit_cast(bf16x8, pk);
#pragma unroll
                    for (int pt = 0; pt < 4; ++pt) {
                        const s16x4 lo = vtr(sX + (32 * kp + 4 * g + tq) * XS + 16 * pt + 4 * tp);
                        const s16x4 hi = vtr(sX + (32 * kp + 16 + 4 * g + tq) * XS + 16 * pt + 4 * tp);
                        const bf16x8 xf = {lo[0], lo[1], lo[2], lo[3], hi[0], hi[1], hi[2], hi[3]};
                        acc[pt] = __builtin_amdgcn_mfma_f32_16x16x32_bf16(pa, xf, acc[pt], 0, 0, 0);
                    }
                }
            }
#pragma unroll
            for (int j = 0; j < 4; ++j) {
                const int lr = 16 * w + 4 * g + j;
                float ss = 0.f;
#pragma unroll
                for (int pt = 0; pt < 4; ++pt) {
                    const float xv = __uint_as_float((unsigned)sX[lr * XS + 16 * pt + c16] << 16);
                    const float zv = __uint_as_float((unsigned)zr[pt][j] << 16);
                    const float yg = (acc[pt][j] + Dh * xv) * silu_f(zv);
                    ss += yg * yg;
                    P[(rowb + t0 + lr) * PP + h * 64 + 16 * pt + c16] = (bf16_t)(cvtpk(yg, 0.f) & 0xffffu);
                }
                ss += shx<1>(ss); ss += shx<2>(ss); ss += shx<4>(ss); ss += shx<8>(ss);
                if (c16 == 0) ssd[(rowb + t0 + lr) * 16 + h] = ss;
            }
        }
        PSEC_E(5, lds) PSEC_B(6)
        {
            const float dlast = sDec[127];
#pragma unroll
            for (int pt = 0; pt < 4; ++pt) { stacc[pt][0] *= dlast; stacc[pt][1] *= dlast; stacc[pt][2] *= dlast; stacc[pt][3] *= dlast; }
#pragma unroll
            for (int ks = 0; ks < 4; ++ks) {
                const s16x4 blo = vtr(sB + (32 * ks + 8 * g + tq) * BS + 16 * w + 4 * tp);
                const s16x4 bhi = vtr(sB + (32 * ks + 8 * g + 4 + tq) * BS + 16 * w + 4 * tp);
                const bf16x8 bfr = {blo[0], blo[1], blo[2], blo[3], bhi[0], bhi[1], bhi[2], bhi[3]};
                const f32x4 w0 = *(const f32x4*)(sW + 32 * ks + 8 * g), w1 = *(const f32x4*)(sW + 32 * ks + 8 * g + 4);
#pragma unroll
                for (int pt = 0; pt < 4; ++pt) {
                    const s16x4 xlo = vtr(sX + (32 * ks + 8 * g + tq) * XS + 16 * pt + 4 * tp);
                    const s16x4 xhi = vtr(sX + (32 * ks + 8 * g + 4 + tq) * XS + 16 * pt + 4 * tp);
                    stacc[pt] = __builtin_amdgcn_mfma_f32_16x16x32_bf16(scale_frag(xlo, xhi, w0, w1), bfr, stacc[pt], 0, 0, 0);
                }
            }
#pragma unroll
            for (int pt = 0; pt < 4; ++pt)
#pragma unroll
                for (int j = 0; j < 4; ++j) sSt[(nxt * 64 + 16 * pt + 4 * g + j) * SS + 16 * w + c16] = (bf16_t)(cvtpk(stacc[pt][j], 0.f) & 0xffffu);
        }
        __syncthreads();
        PSEC_E(6, lds)
    }
}

__device__ __forceinline__ void hgrn_unit(PPtr p, int oi, int b, int h, unsigned char* lds, int tid) {
    float* sq = (float*)lds;
    float* sf = sq + 2048; float* sk = sf + 2048; float* sv = sk + 2048;
    float* so = sv + 2048;
    bf16_t* P = (bf16_t*)(p->ws + WS_P);
    const size_t rowb = (size_t)b * SEQ;
    const int v = tid & 127, dq = tid >> 7;
    const int st_t = tid >> 5, st_d = (tid & 31) * 4;
    const f32x4 nw = *(const f32x4*)(p->hgrn_norm_w + oi * 128 + st_d);
    float S[32];
#pragma unroll
    for (int i = 0; i < 32; ++i) S[i] = 0.f;
    const bf16_t* src = P + (rowb + st_t) * PP + h * 128 + st_d;
    u32x2 rq = *(const u32x2*)(src), rf = *(const u32x2*)(src + 2048), rv = *(const u32x2*)(src + 4096);
    for (int c = 0; c < SEQ / 16; ++c) {
        {
            f32x4 q4 = {bflo(rq.x), bfhi(rq.x), bflo(rq.y), bfhi(rq.y)};
            f32x4 f4 = {__expf(bflo(rf.x)), __expf(bfhi(rf.x)), __expf(bflo(rf.y)), __expf(bfhi(rf.y))};
            f32x4 k4 = {1.f - f4[0], 1.f - f4[1], 1.f - f4[2], 1.f - f4[3]};
            f32x4 v4 = {bflo(rv.x), bfhi(rv.x), bflo(rv.y), bfhi(rv.y)};
            *(f32x4*)(sq + st_t * 128 + st_d) = q4; *(f32x4*)(sf + st_t * 128 + st_d) = f4; *(f32x4*)(sk + st_t * 128 + st_d) = k4; *(f32x4*)(sv + st_t * 128 + st_d) = v4;
        }
        __syncthreads();
        if (c + 1 < SEQ / 16) { const bf16_t* s2 = src + (size_t)(c + 1) * 16 * PP; rq = *(const u32x2*)(s2); rf = *(const u32x2*)(s2 + 2048); rv = *(const u32x2*)(s2 + 4096); }
        for (int t = 0; t < 16; ++t) {
            const float vt = sv[t * 128 + v]; float a = 0.f;
#pragma unroll
            for (int i4 = 0; i4 < 8; ++i4) {
                const f32x4 f4 = *(const f32x4*)(sf + t * 128 + dq * 32 + i4 * 4), k4 = *(const f32x4*)(sk + t * 128 + dq * 32 + i4 * 4), q4 = *(const f32x4*)(sq + t * 128 + dq * 32 + i4 * 4);
#pragma unroll
                for (int i = 0; i < 4; ++i) { S[i4 * 4 + i] = f4[i] * S[i4 * 4 + i] + k4[i] * vt; a += q4[i] * S[i4 * 4 + i]; }
            }
            so[(dq * 16 + t) * 128 + v] = a;
        }
        __syncthreads();
        {
            f32x4 o = *(const f32x4*)(so + (0 * 16 + st_t) * 128 + st_d);
            o += *(const f32x4*)(so + (1 * 16 + st_t) * 128 + st_d); o += *(const f32x4*)(so + (2 * 16 + st_t) * 128 + st_d); o += *(const f32x4*)(so + (3 * 16 + st_t) * 128 + st_d);
            float ss = (o[0] * o[0] + o[1] * o[1]) + (o[2] * o[2] + o[3] * o[3]);
            ss += shx<1>(ss); ss += shx<2>(ss); ss += shx<4>(ss); ss += shx<8>(ss); ss += shx<16>(ss);
            const float r = rsqrtf(ss * (1.f / 128.f) + EPS);
            u32x2 w; w.x = cvtpk(o[0] * r * nw[0], o[1] * r * nw[1]); w.y = cvtpk(o[2] * r * nw[2], o[3] * r * nw[3]);
            *(u32x2*)(P + (rowb + c * 16 + st_t) * PP + h * 128 + st_d) = w;
        }
    }
    __syncthreads();
}

#define MFMA16(a, b, c) __builtin_amdgcn_mfma_f32_16x16x16bf16_1k((a), (b), (c), 0, 0, 0)
__device__ __forceinline__ s16x4 pack4(float a, float b, float c, float d) { u32x2 w; w.x = cvtpk(a, b); w.y = cvtpk(c, d); return __builtin_bit_cast(s16x4, w); }
__device__ __forceinline__ void hgrn_unit_mfma(PPtr p, int oi, int b, int h, unsigned char* lds, int tid) {
    constexpr int QS = 136, KTS = 20, NCH = SEQ / 16, PF = 4;
    bf16_t* sQ = (bf16_t*)lds;
    bf16_t* sK = sQ + 2 * 16 * QS;
    bf16_t* sKT = sK + 2 * 16 * QS;
    float* sDec = (float*)(sKT + 2 * 128 * KTS);
    float* sPart = sDec + 2 * 128;
    bf16_t* sTr = (bf16_t*)(sPart + 2 * 128);
    bf16_t* P = (bf16_t*)(p->ws + WS_P);
    const int lane = tid & 63, w = __builtin_amdgcn_readfirstlane(tid >> 6), r = lane & 15, g = lane >> 4;
    const size_t rowb = (size_t)b * SEQ;
    const float nw = p->hgrn_norm_w[oi * 128 + 16 * w + r];
    const bf16_t* gld = P + (rowb + (lane >> 2)) * PP + h * 128 + 16 * w + 4 * (lane & 3);
    bf16_t* myTr = sTr + w * (3 * 16 * 20);
    f32x4 St[8];
#pragma unroll
    for (int j = 0; j < 8; ++j) St[j] = (f32x4){0.f, 0.f, 0.f, 0.f};
    f32x4 oprev = {0.f, 0.f, 0.f, 0.f};
    u32x2 pq[PF], pl[PF], pv[PF];
#pragma unroll
    for (int k = 0; k < PF; ++k) { const bf16_t* nb = gld + (size_t)k * 16 * PP; pq[k] = *(const u32x2*)nb; pl[k] = *(const u32x2*)(nb + 2048); pv[k] = *(const u32x2*)(nb + 4096); }
#define HG_PRODUCE(SLOT, CH, BUFW, VF) do { \
        *(u32x2*)(myTr + (0 * 16 + (lane >> 2)) * 20 + 4 * (lane & 3)) = pq[SLOT]; \
        *(u32x2*)(myTr + (1 * 16 + (lane >> 2)) * 20 + 4 * (lane & 3)) = pl[SLOT]; \
        *(u32x2*)(myTr + (2 * 16 + (lane >> 2)) * 20 + 4 * (lane & 3)) = pv[SLOT]; \
        if ((CH) + PF < NCH) { const bf16_t* nb_ = gld + (size_t)((CH) + PF) * 16 * PP; pq[SLOT] = *(const u32x2*)nb_; pl[SLOT] = *(const u32x2*)(nb_ + 2048); pv[SLOT] = *(const u32x2*)(nb_ + 4096); } \
        float qv_[4], lf_[4]; \
        _Pragma("unroll") for (int i = 0; i < 4; ++i) { \
            qv_[i] = __uint_as_float((unsigned)myTr[(0 * 16 + 4 * g + i) * 20 + r] << 16); \
            lf_[i] = __uint_as_float((unsigned)myTr[(1 * 16 + 4 * g + i) * 20 + r] << 16); \
            VF[i] = (short)myTr[(2 * 16 + 4 * g + i) * 20 + r]; } \
        const float p0_ = lf_[0], p1_ = p0_ + lf_[1], p2_ = p1_ + lf_[2], p3_ = p2_ + lf_[3]; \
        const float t1_ = bperm(lane - 16, p3_), t2_ = bperm(lane - 32, p3_), t3_ = bperm(lane - 48, p3_); \
        const float ex_ = (g >= 1 ? t1_ : 0.f) + (g >= 2 ? t2_ : 0.f) + (g >= 3 ? t3_ : 0.f); \
        const float blast_ = bperm(48 + r, ex_ + p3_); \
        const float bc_[4] = {ex_ + p0_, ex_ + p1_, ex_ + p2_, ex_ + p3_}; \
        float kh_[4]; \
        const float eblast_ = fast_exp2(LOG2E * blast_); \
        _Pragma("unroll") for (int i = 0; i < 4; ++i) { \
            const float kk_ = 1.f - fast_exp2(LOG2E * lf_[i]); \
            const float eb_ = fast_exp2(LOG2E * bc_[i]); \
            const float kt_ = kk_ * fast_exp2(-LOG2E * bc_[i]); \
            sQ[((BUFW) * 16 + 4 * g + i) * QS + 16 * w + r] = (bf16_t)(cvtpk(qv_[i] * eb_, 0.f) & 0xffffu); \
            sK[((BUFW) * 16 + 4 * g + i) * QS + 16 * w + r] = (bf16_t)(cvtpk(kt_, 0.f) & 0xffffu); \
            kh_[i] = kt_ * eblast_; } \
        *(s16x4*)(sKT + ((BUFW) * 128 + 16 * w + r) * KTS + 4 * g) = pack4(kh_[0], kh_[1], kh_[2], kh_[3]); \
        if (g == 0) sDec[(BUFW) * 128 + 16 * w + r] = eblast_; \
    } while (0)
    s16x4 vf, vfn;
    vfn = (s16x4){0, 0, 0, 0};
    HG_PRODUCE(0, 0, 0, vf);
    asm volatile("s_waitcnt lgkmcnt(0)\n\ts_barrier" ::: "memory");
#pragma unroll 1
    for (int c4 = 0; c4 < NCH; c4 += PF) {
#pragma unroll
        for (int k = 0; k < PF; ++k) {
            const int c = c4 + k; const int buf = k & 1;
            if (c + 1 < NCH) HG_PRODUCE((k + 1) % PF, c + 1, buf ^ 1, vfn);
            if (c > 0) {
                const float* sp = sPart + (buf ^ 1) * 128;
#pragma unroll
                for (int i = 0; i < 4; ++i) {
                    float ss = 0.f;
#pragma unroll
                    for (int ww = 0; ww < 8; ++ww) ss += sp[ww * 16 + 4 * g + i];
                    const float rn = rsqrtf(ss * (1.f / 128.f) + EPS);
                    P[(rowb + (c - 1) * 16 + 4 * g + i) * PP + h * 128 + 16 * w + r] = (bf16_t)(cvtpk(oprev[i] * rn * nw, 0.f) & 0xffffu);
                }
            }
            f32x4 a = {0.f, 0.f, 0.f, 0.f};
#pragma unroll
            for (int ks = 0; ks < 4; ++ks) {
                const bf16x8 ka = *(const bf16x8*)(sK + (buf * 16 + r) * QS + 32 * ks + 8 * g);
                const bf16x8 qb = *(const bf16x8*)(sQ + (buf * 16 + r) * QS + 32 * ks + 8 * g);
                a = __builtin_amdgcn_mfma_f32_16x16x32_bf16(ka, qb, a, 0, 0, 0);
            }
#pragma unroll
            for (int i = 0; i < 4; ++i) a[i] = (4 * g + i <= r) ? a[i] : 0.f;
            f32x4 o = MFMA16(pack4(a[0], a[1], a[2], a[3]), vf, ((f32x4){0.f, 0.f, 0.f, 0.f}));
#pragma unroll
            for (int j = 0; j < 8; ++j) {
                const s16x4 qa = *(const s16x4*)(sQ + (buf * 16 + r) * QS + 16 * j + 4 * g);
                o = MFMA16(qa, pack4(St[j][0], St[j][1], St[j][2], St[j][3]), o);
            }
#pragma unroll
            for (int j = 0; j < 8; ++j) {
                const f32x4 d4 = *(const f32x4*)(sDec + buf * 128 + 16 * j + 4 * g);
                const s16x4 ka = *(const s16x4*)(sKT + (buf * 128 + 16 * j + r) * KTS + 4 * g);
                f32x4 sc = St[j]; sc[0] *= d4[0]; sc[1] *= d4[1]; sc[2] *= d4[2]; sc[3] *= d4[3];
                St[j] = MFMA16(ka, vf, sc);
            }
#pragma unroll
            for (int i = 0; i < 4; ++i) {
                float ss = o[i] * o[i];
                ss += shx<1>(ss); ss += shx<2>(ss); ss += shx<4>(ss); ss += shx<8>(ss);
                if (r == 0) sPart[buf * 128 + w * 16 + 4 * g + i] = ss;
            }
            oprev = o; vf = vfn;
            asm volatile("s_waitcnt lgkmcnt(0)\n\ts_barrier" ::: "memory");
        }
    }
#undef HG_PRODUCE
    __syncthreads();
    {
        const float* sp = sPart + 1 * 128;
#pragma unroll
        for (int i = 0; i < 4; ++i) {
            float ss = 0.f;
#pragma unroll
            for (int ww = 0; ww < 8; ++ww) ss += sp[ww * 16 + 4 * g + i];
            const float rn = rsqrtf(ss * (1.f / 128.f) + EPS);
            P[(rowb + 127 * 16 + 4 * g + i) * PP + h * 128 + 16 * w + r] = (bf16_t)(cvtpk(oprev[i] * rn * nw, 0.f) & 0xffffu);
        }
    }
    __syncthreads();
}

constexpr int KSTR = 136, VSTR = 144;

__device__ __forceinline__ void attn_unit(PPtr p, int e, int b, int h, int qb, float lam, float oscale, unsigned char* lds, int tid) {
    bf16_t* sK = (bf16_t*)lds;
    bf16_t* sV = sK + 64 * KSTR;
    float* sbias = (float*)(sV + 64 * VSTR);
    bf16_t* P = (bf16_t*)(p->ws + WS_P);
    const int lane = tid & 63, w = __builtin_amdgcn_readfirstlane(tid >> 6), c16 = lane & 15, g = lane >> 4;
    const size_t rowb = (size_t)b * SEQ;
    const int q0 = qb * 128, qw0 = q0 + 16 * w, qpos = qw0 + c16;
    __syncthreads();
    if (tid < 129) {
        int bucket;
        if (tid < 16) bucket = tid;
        else { int lg = 16 + (int)(__logf((float)tid * (1.f / 16.f)) / 2.0794415416798357f * 16.f); bucket = lg < 31 ? lg : 31; }
        sbias[tid] = p->rel_bias[bucket * 8 + h] * LOG2E;
    }
    bf16x8 qf[2][2];
#pragma unroll
    for (int mp = 0; mp < 2; ++mp)
#pragma unroll
        for (int ds = 0; ds < 2; ++ds) qf[mp][ds] = *(const bf16x8*)(P + (rowb + qpos) * PP + 1024 + h * 128 + mp * 64 + ds * 32 + 8 * g);
    f32x4 O[2][8];
#pragma unroll
    for (int mp = 0; mp < 2; ++mp)
#pragma unroll
        for (int vt = 0; vt < 8; ++vt) O[mp][vt] = (f32x4){0.f, 0.f, 0.f, 0.f};
    float mref[2] = {0.f, 0.f}, lsum[2] = {0.f, 0.f};
    const int NT = (q0 + 128) / 64;
    const bf16_t* Kg = P + rowb * PP + 4096 + h * 128; const bf16_t* Vg = P + rowb * PP + 5120 + h * 128;
    const int ld_row0 = tid >> 4, ld_ch = tid & 15;
    u32x4 kr[2], vr[2];
#pragma unroll
    for (int i = 0; i < 2; ++i) { kr[i] = *(const u32x4*)(Kg + (size_t)(ld_row0 + 32 * i) * PP + ld_ch * 8); vr[i] = *(const u32x4*)(Vg + (size_t)(ld_row0 + 32 * i) * PP + ld_ch * 8); }
    for (int t = 0; t < NT; ++t) {
        __syncthreads();
#pragma unroll
        for (int i = 0; i < 2; ++i) { *(u32x4*)(sK + (ld_row0 + 32 * i) * KSTR + ld_ch * 8) = kr[i]; *(u32x4*)(sV + (ld_row0 + 32 * i) * VSTR + ld_ch * 8) = vr[i]; }
        __syncthreads();
        if (t + 1 < NT) {
#pragma unroll
            for (int i = 0; i < 2; ++i) { kr[i] = *(const u32x4*)(Kg + (size_t)((t + 1) * 64 + ld_row0 + 32 * i) * PP + ld_ch * 8); vr[i] = *(const u32x4*)(Vg + (size_t)((t + 1) * 64 + ld_row0 + 32 * i) * PP + ld_ch * 8); }
        }
        const int k0 = t * 64;
        PSEC_B(9)
        if (k0 <= qw0 + 15) {
            const bool far = (qw0 - (k0 + 63)) >= 128;
            const bool first = (t == 0);
            const float bfar = sbias[128];
            bf16x8 pa[2][2];
#pragma unroll
            for (int mp = 0; mp < 2; ++mp) {
                f32x4 sc[4];
                const float cinit = (far ? bfar : 0.f) - mref[mp];
#pragma unroll
                for (int s = 0; s < 4; ++s) {
                    f32x4 a = {cinit, cinit, cinit, cinit};
#pragma unroll
                    for (int ds = 0; ds < 2; ++ds) {
                        const bf16x8 kf = *(const bf16x8*)(sK + (16 * s + c16) * KSTR + mp * 64 + ds * 32 + 8 * g);
                        a = __builtin_amdgcn_mfma_f32_16x16x32_bf16(kf, qf[mp][ds], a, 0, 0, 0);
                    }
                    sc[s] = a;
                }
                if (!far) {
#pragma unroll
                    for (int s = 0; s < 4; ++s)
#pragma unroll
                        for (int j = 0; j < 4; ++j) {
                            const int rel = qpos - (k0 + 16 * s + 4 * g + j);
                            const int idx = rel < 0 ? 0 : (rel > 128 ? 128 : rel);
                            sc[s][j] = (rel >= 0) ? sc[s][j] + sbias[idx] : -1e30f;
                        }
                }
                float mx = fmaxf(fmaxf(fmaxf(sc[0][0], sc[0][1]), fmaxf(sc[0][2], sc[0][3])), fmaxf(fmaxf(sc[1][0], sc[1][1]), fmaxf(sc[1][2], sc[1][3])));
                mx = fmaxf(mx, fmaxf(fmaxf(fmaxf(sc[2][0], sc[2][1]), fmaxf(sc[2][2], sc[2][3])), fmaxf(fmaxf(sc[3][0], sc[3][1]), fmaxf(sc[3][2], sc[3][3]))));
                mx = fmaxf(mx, shx<16>(mx)); mx = max_x32(mx);
                if (first || __any(mx > 8.f)) {
                    const float delta = first ? mx : fmaxf(mx, 0.f);
                    mref[mp] += delta;
#pragma unroll
                    for (int s = 0; s < 4; ++s)
#pragma unroll
                        for (int j = 0; j < 4; ++j) sc[s][j] -= delta;
                    const float al = fast_exp2(-delta);
                    lsum[mp] *= al;
                    if (!first) {
#pragma unroll
                        for (int j = 0; j < 4; ++j) {
                            const float aj = bperm(4 * g + j, al);
#pragma unroll
                            for (int vt = 0; vt < 8; ++vt) O[mp][vt][j] *= aj;
                        }
                    }
                }
                float rs = 0.f;
#pragma unroll
                for (int s = 0; s < 4; ++s)
#pragma unroll
                    for (int j = 0; j < 4; ++j) { const float pv = fast_exp2(sc[s][j]); sc[s][j] = pv; rs += pv; }
                lsum[mp] += rs;
#pragma unroll
                for (int ks = 0; ks < 2; ++ks) {
                    u32x4 pk;
                    pk.x = cvtpk(sc[2 * ks][0], sc[2 * ks][1]); pk.y = cvtpk(sc[2 * ks][2], sc[2 * ks][3]);
                    pk.z = cvtpk(sc[2 * ks + 1][0], sc[2 * ks + 1][1]); pk.w = cvtpk(sc[2 * ks + 1][2], sc[2 * ks + 1][3]);
                    pa[mp][ks] = __builtin_bit_cast(bf16x8, pk);
                }
                asm volatile("" ::: "memory");
            }
            const int tq = c16 >> 2, tp = c16 & 3;
#pragma unroll
            for (int ks = 0; ks < 2; ++ks)
#pragma unroll
                for (int vt = 0; vt < 8; ++vt) {
                    const s16x4 lo = vtr(sV + (32 * ks + 4 * g + tq) * VSTR + 16 * vt + 4 * tp);
                    const s16x4 hi = vtr(sV + (32 * ks + 16 + 4 * g + tq) * VSTR + 16 * vt + 4 * tp);
                    const bf16x8 vf = {lo[0], lo[1], lo[2], lo[3], hi[0], hi[1], hi[2], hi[3]};
                    O[0][vt] = __builtin_amdgcn_mfma_f32_16x16x32_bf16(pa[0][ks], vf, O[0][vt], 0, 0, 0);
                    O[1][vt] = __builtin_amdgcn_mfma_f32_16x16x32_bf16(pa[1][ks], vf, O[1][vt], 0, 0, 0);
                    if (vt & 1) asm volatile("" ::: "memory");
                }
        }
        PSEC_E(9, lds)
    }
#pragma unroll
    for (int mp = 0; mp < 2; ++mp) { lsum[mp] += shx<16>(lsum[mp]); lsum[mp] = sum_x32(lsum[mp]); }
    const float lrun[2] = {lsum[0], lsum[1]};
    const float il0 = 1.f / lrun[0], il1 = lam / lrun[1];
    float sw[8];
#pragma unroll
    for (int vt = 0; vt < 8; ++vt) sw[vt] = p->subln_w[e * 128 + 16 * vt + c16] * oscale;
#pragma unroll
    for (int j = 0; j < 4; ++j) {
        const float a0 = bperm(4 * g + j, il0), a1 = bperm(4 * g + j, il1);
        float o[8]; float ss = 0.f;
#pragma unroll
        for (int vt = 0; vt < 8; ++vt) { o[vt] = O[0][vt][j] * a0 - O[1][vt][j] * a1; ss += o[vt] * o[vt]; }
        ss += shx<1>(ss); ss += shx<2>(ss); ss += shx<4>(ss); ss += shx<8>(ss);
        const float r = rsqrtf(ss * (1.f / 128.f) + EPS);
        bf16_t* op = P + (rowb + qw0 + 4 * g + j) * PP + 1024 + h * 128 + c16;
#pragma unroll
        for (int vt = 0; vt < 8; ++vt) op[16 * vt] = (bf16_t)(cvtpk(o[vt] * r * sw[vt], 0.f) & 0xffffu);
    }
}

#define XB_TMO      128
#define XB_XCNT(j)  (256  + 64 * (j))
#define XB_XSUB(j)  (1280 + 64 * (j))
#define XB_XGEN(j)  (2304 + 64 * (j))
#define XB_TOP      3328
#define XB_TOPGEN   3392
#define XCD_BAR_WORDS 3456
#define XB_SPIN_CAP (1u << 18)

__device__ __forceinline__ unsigned xb_ld(unsigned* p)              { return __hip_atomic_load(p, __ATOMIC_RELAXED, __HIP_MEMORY_SCOPE_AGENT); }
__device__ __forceinline__ unsigned xb_add(unsigned* p, unsigned v) { return __hip_atomic_fetch_add(p, v, __ATOMIC_RELAXED, __HIP_MEMORY_SCOPE_AGENT); }
__device__ __forceinline__ unsigned xb_xcc_id() { return (unsigned)__builtin_amdgcn_s_getreg((3 << 11) | 20) & 0xFu; }
#define XB_SPIN(cond, bar) do { unsigned _sp = 0; while (cond) { __builtin_amdgcn_s_sleep(1); \
    if ((++_sp & 255u) == 0u) { if (xb_ld(&(bar)[XB_TMO])) break; if (_sp > XB_SPIN_CAP) { atomicAdd(&(bar)[XB_TMO], 1u); break; } } } } while (0)

struct XcdBarrier {
    unsigned* bar; unsigned x;
    volatile LAS unsigned* st;
};

__device__ __forceinline__ XcdBarrier xcd_barrier_post(unsigned* bar, volatile LAS unsigned* st, bool leader) {
    XcdBarrier b; b.bar = bar; b.x = xb_xcc_id(); b.st = st;
    if (leader) (void)xb_add(&bar[XB_XCNT(b.x)], 1u);
    return b;
}
__device__ __forceinline__ void xcd_barrier_complete(unsigned* bar, unsigned x, unsigned& nloc, unsigned& nx) {
    const unsigned G = gridDim.x * gridDim.y * gridDim.z;
    unsigned sum, cnt, mine, sp = 0u;
    for (;;) {
        sum = 0u; cnt = 0u; mine = 0u;
#pragma unroll
        for (unsigned j = 0; j < 16; ++j) { const unsigned c = xb_ld(&bar[XB_XCNT(j)]); sum += c; cnt += (c > 0u) ? 1u : 0u; mine = (j == x) ? c : mine; }
        if (sum == G) break;
        __builtin_amdgcn_s_sleep(1);
        if ((++sp & 255u) == 0u) { if (xb_ld(&bar[XB_TMO])) break; if (sp > XB_SPIN_CAP) { atomicAdd(&bar[XB_TMO], 1u); break; } }
    }
    nloc = mine > 0u ? mine : 1u; nx = cnt > 0u ? cnt : 1u;
}

__device__ __forceinline__ void xcd_barrier(const XcdBarrier& b, bool leader) {
    asm volatile("s_waitcnt vmcnt(0)" ::: "memory");
    __syncthreads();
    if (leader) {
        unsigned* bar = b.bar;
        __builtin_amdgcn_s_waitcnt(0);
        unsigned nloc = b.st[0], nx = b.st[1];
        if (nloc == 0u) { xcd_barrier_complete(bar, b.x, nloc, nx); b.st[0] = nloc; b.st[1] = nx; }
        const unsigned old = xb_add(&bar[XB_XSUB(b.x)], 1u);
        const unsigned gen = old / nloc;
        if (old + 1u == (gen + 1u) * nloc) {
            __builtin_amdgcn_fence(__ATOMIC_RELEASE, "agent");
            asm volatile("s_waitcnt vmcnt(0)" ::: "memory");
            const unsigned og = xb_add(&bar[XB_TOP], 1u);
            const unsigned tg = og / nx;
            if (og + 1u == (tg + 1u) * nx) xb_add(&bar[XB_TOPGEN], 1u);
            else XB_SPIN(xb_ld(&bar[XB_TOPGEN]) == tg, bar);
            __builtin_amdgcn_fence(__ATOMIC_ACQUIRE, "agent");
            xb_add(&bar[XB_XGEN(b.x)], 1u);
            asm volatile("s_waitcnt vmcnt(0)" ::: "memory");
        } else {
            XB_SPIN(xb_ld(&bar[XB_XGEN(b.x)]) == gen, bar);
            __builtin_amdgcn_fence(__ATOMIC_ACQUIRE, "agent");
            asm volatile("s_waitcnt vmcnt(0)" ::: "memory");
        }
    }
    __syncthreads();
}

#define p get_params()
__global__ void __launch_bounds__(512, 2) fwd_kernel(Params p_unused) {
    extern __shared__ __attribute__((aligned(16))) unsigned char lds[];
    cg::grid_group grid = cg::this_grid();
    int tid = threadIdx.x, lane = tid & 63; const int wave = __builtin_amdgcn_readfirstlane(tid >> 6);
#define FRESH_LANES() do { lane = (int)__builtin_amdgcn_mbcnt_hi(~0u, __builtin_amdgcn_mbcnt_lo(~0u, 0u)); asm volatile("" : "+v"(lane)); tid = wave * 64 + lane; } while (0)
    const int G = gridDim.x, blk = blockIdx.x;
    volatile LAS unsigned* bar_st = (volatile LAS unsigned*)(lds + LDS_BYTES - 512);
    if (tid < 2) bar_st[tid] = 0u;
#ifdef PROBE_SEC
    if (wave == 0) *(volatile unsigned long long*)(lds + LDS_BYTES - 128) = 0ull;
#endif
    __syncthreads();
    const XcdBarrier xbar = xcd_barrier_post((unsigned*)(get_params()->ws + WS_BAR), bar_st, tid == 0);
#define GRID_SYNC() do { FRESH_LANES(); xcd_barrier(xbar, tid == 0); } while (0)
    const int gw = blk * 8 + wave, NGW = G * 8;
    bf16_t* P = (bf16_t*)(p->ws + WS_P); bf16_t* U = (bf16_t*)(p->ws + WS_U);
    float* ssq = (float*)(p->ws + WS_SSQ);
    float* scr = (float*)(lds + wave * 8704);
    PG8_LAS unsigned char* ring = (PG8_LAS unsigned char*)lds;

#ifdef PROBE_MASK
    unsigned long long* tstamp = (unsigned long long*)(lds + LDS_BYTES - 256);
    int n_ts = 0;
#define STAMP() do { if (blk == 0 && threadIdx.x == 0) tstamp[n_ts] = __builtin_amdgcn_s_memrealtime(); ++n_ts; } while (0)
#else
#define STAMP() do {} while (0)
#endif
    STAMP();
    for (int r0 = gw; r0 < T_TOK; r0 += 4 * NGW) {
        f32x4 v[4][4];
#pragma unroll
        for (int u = 0; u < 4; ++u) { const int row = min(r0 + u * NGW, T_TOK - 1); const f32x4* xr = (const f32x4*)(p->x + (size_t)row * DM) + lane;
#pragma unroll
            for (int j = 0; j < 4; ++j) v[u][j] = xr[64 * j]; }
#pragma unroll
        for (int u = 0; u < 4; ++u) {
            const int row = r0 + u * NGW;
            float s = 0.f;
#pragma unroll
            for (int j = 0; j < 4; ++j) s += (v[u][j][0] * v[u][j][0] + v[u][j][1] * v[u][j][1]) + (v[u][j][2] * v[u][j][2] + v[u][j][3] * v[u][j][3]);
            s = wave_sum(s);
            if (row < T_TOK) {
                u32x2* up = (u32x2*)(U + (size_t)row * DM) + lane;
#pragma unroll
                for (int j = 0; j < 4; ++j) { u32x2 w; w.x = cvtpk(v[u][j][0], v[u][j][1]); w.y = cvtpk(v[u][j][2], v[u][j][3]); up[64 * j] = w; }
                if (lane < 16) ssq[(size_t)row * 16 + lane] = (lane == 0) ? s : 0.f;
            }
        }
    }
    convert_layer(p, 0, scr, gw, NGW, lane);
    for (int i = blk * 512 + tid; i < 4096; i += G * 512) ((float*)(p->ws + WS_LB))[i] = lb_val(p->hgrn_lb, i & 2047, (i >> 11) ? 3 : 1);
    grid.sync(); STAMP();

#pragma unroll 1
    for (int layer = 0; layer < 4; ++layer) {
        const bool even = (layer & 1) == 0; const int e = layer >> 1;
        FRESH_LANES();
        if (even) {
            dt_items(p, e, gw, NGW, lane);
            pg8::Gemm gm{U, (const bf16_t*)(p->ws + WS_WE_IN), T_TOK, 6144, DM, DM}; pg8::StaticOrder S; S.init(T_TOK, 6144, G, blk);
            pg8::EpiIn E{P, ssq, 0, 0.125f * LOG2E, nullptr, 0};
#ifndef SKIP_IN
            pg8::gemm_phase<pg8::EpiIn, pg8::StaticOrder, true, PG8SP2, 1024, 1024>(ring, gm, S, E, tid);
#endif
        } else {
            pg8::Gemm gm{U, (const bf16_t*)(p->ws + WS_WO_IN), T_TOK, 6144, DM, DM}; pg8::StaticOrder S; S.init(T_TOK, 6144, G, blk);
            pg8::EpiIn E{P, ssq, 1, 1.f, (const float*)(p->ws + WS_LB) + e * 2048, layer};
#ifndef SKIP_IN
            pg8::gemm_phase<pg8::EpiIn, pg8::StaticOrder, true, PG8SP2, 1024, 1024>(ring, gm, S, E, tid);
#endif
        }
        GRID_SYNC(); STAMP();
        FRESH_LANES();
        if (even) {
            const float lam_init = 0.8f - 0.6f * __expf(-0.3f * (float)layer);
            float d1 = p->lq1[e * 64 + lane] * p->lk1[e * 64 + lane], d2 = p->lq2[e * 64 + lane] * p->lk2[e * 64 + lane];
            d1 = wave_sum(d1); d2 = wave_sum(d2);
            const float lam = __expf(d1) - __expf(d2) + lam_init;
            const int vcu = (G % 8 == 0) ? (blk % 8) * (G / 8) + blk / 8 : blk;
            for (int pi = vcu; pi < 1024; pi += G) {
                const int bh = pi >> 3, s = pi & 7;
#ifndef SKIP_ATTN
#pragma unroll 1
                for (int half = 0; half < 2; ++half) { FRESH_LANES(); attn_unit(p, e, bh >> 3, bh & 7, half ? s : 15 - s, lam, 1.f - lam_init, lds, tid); }
#endif
            }
            __syncthreads(); STAMP();
            FRESH_LANES();
#ifndef SKIP_SSD
            for (int ui = vcu; ui < 256; ui += G) ssd_unit_mfma(p, e, ui >> 4, ui & 15, lds, tid);
#endif
        } else {
#ifndef SKIP_HGRN
            for (int ui = blk; ui < 256; ui += G) hgrn_unit_mfma(p, e, ui >> 4, ui & 15, lds, tid);
#endif
        }
        GRID_SYNC(); STAMP();
        FRESH_LANES();
        if (even) {
            pg8::Gemm gm{U, (const bf16_t*)(p->ws + WS_WE_G), T_TOK, 1024, DM, DM}; pg8::StaticOrder S; S.init(T_TOK, 1024, G, blk);
            pg8::EpiGate E{P + 1024, ssq, (const float*)(p->ws + WS_SSD), p->ssd_norm_w + e * 1024, P};
#ifndef SKIP_GATE
            pg8::gemm_phase<pg8::EpiGate, pg8::StaticOrder, true, PG8SP2, 1024, 1024>(ring, gm, S, E, tid);
#endif
        } else {
            pg8::Gemm gm{U, (const bf16_t*)(p->ws + WS_WO_G), T_TOK, 2048, DM, DM}; pg8::StaticOrder S; S.init(T_TOK, 2048, G, blk);
            pg8::EpiGate E{P, ssq, nullptr, nullptr, nullptr};
#ifndef SKIP_GATE
            pg8::gemm_phase<pg8::EpiGate, pg8::StaticOrder, true, PG8SP2, 1024, 1024>(ring, gm, S, E, tid);
#endif
        }
        GRID_SYNC(); STAMP();
        FRESH_LANES();
        {
            pg8::Gemm gm{P, (const bf16_t*)(p->ws + (even ? WS_WE_OUT : WS_WO_OUT)), T_TOK, 1024, 2048, PP}; pg8::StaticOrder S; S.init(T_TOK, 1024, G, blk);
            pg8::EpiOut E{layer == 0 ? p->x : p->out, p->out, layer < 3 ? U : nullptr, ssq};
#ifndef SKIP_OUT
            pg8::gemm_phase<pg8::EpiOut, pg8::StaticOrder, true, PG8SP2, 2048, 6144>(ring, gm, S, E, tid);
#endif
            FRESH_LANES();
            if (layer < 3) convert_layer(p, layer + 1, scr, gw, NGW, lane);
        }
        GRID_SYNC(); STAMP();
    }
    FRESH_LANES();
    for (int r0 = gw; r0 < T_TOK; r0 += 4 * NGW) {
        float r[4]; f32x4 v[4][4];
#pragma unroll
        for (int u = 0; u < 4; ++u) { const int row = min(r0 + u * NGW, T_TOK - 1); r[u] = row_rs(ssq, row); const f32x4* hp = (const f32x4*)(p->out + (size_t)row * DM) + lane;
#pragma unroll
            for (int j = 0; j < 4; ++j) v[u][j] = hp[64 * j]; }
        const f32x4* wp = (const f32x4*)p->final_norm_w + lane;
        const f32x4 w0 = wp[0], w1 = wp[64], w2 = wp[128], w3 = wp[192];
#pragma unroll
        for (int u = 0; u < 4; ++u) {
            const int row = r0 + u * NGW;
            if (row < T_TOK) {
                f32x4* hp = (f32x4*)(p->out + (size_t)row * DM) + lane;
#pragma unroll
                for (int j = 0; j < 4; ++j) { f32x4 x = v[u][j]; const f32x4 w = (j == 0) ? w0 : (j == 1) ? w1 : (j == 2) ? w2 : w3; const float rr = r[u];
                    x[0] *= rr * w[0]; x[1] *= rr * w[1]; x[2] *= rr * w[2]; x[3] *= rr * w[3]; hp[64 * j] = x; }
            }
        }
    }
#ifdef PROBE_SEC
    if (blk == 0 && wave == 0) {
        const unsigned long long tend = __builtin_amdgcn_s_memrealtime();
        const unsigned long long acc_t = *(volatile unsigned long long*)(lds + LDS_BYTES - 128) * PROBE_MULT;
        while (__builtin_amdgcn_s_memrealtime() - tend < acc_t) __builtin_amdgcn_s_sleep(32);
    }
#endif
#ifdef PROBE_MASK
    if (blk == 0 && threadIdx.x == 0) {
        const unsigned long long tend = __builtin_amdgcn_s_memrealtime();
        unsigned long long acc_t = 0;
        for (int k = 0; k + 1 < n_ts; ++k) if ((PROBE_MASK >> k) & 1u) acc_t += tstamp[k + 1] - tstamp[k];
        acc_t *= PROBE_MULT;
        while (__builtin_amdgcn_s_memrealtime() - tend < acc_t) __builtin_amdgcn_s_sleep(32);
    }
#endif
}

#undef p
extern "C" void kernel_launch(void* const* d_in, const int* in_sizes, int n_in, void* d_out, int out_size, void* d_ws, size_t ws_size, hipStream_t stream) {
    static int grid = 0;
    if (grid == 0) {
        if (n_in != 21 || out_size != T_TOK * DM || ws_size < WS_END) { fprintf(stderr, "kernel_launch: unexpected shapes: n_in %d out %d ws %zu (need %zu)\n", n_in, out_size, ws_size, (size_t)WS_END); grid = -1; return; }
        int dev = 0, cus = 0, per_cu = 0;
        hipGetDevice(&dev); hipDeviceGetAttribute(&cus, hipDeviceAttributeMultiprocessorCount, dev);
        hipFuncSetAttribute((const void*)fwd_kernel, hipFuncAttributeMaxDynamicSharedMemorySize, LDS_BYTES);
        hipOccupancyMaxActiveBlocksPerMultiprocessor(&per_cu, (const void*)fwd_kernel, 512, LDS_BYTES);
        if (per_cu < 1) { fprintf(stderr, "kernel_launch: occupancy query says %d blocks per CU\n", per_cu); per_cu = 1; }
        (void)hipGetLastError();
        grid = cus * per_cu;
        if (grid > 256) grid = 256;
    }
    if (grid < 0) return;
    Params p{};
    const float** f = (const float**)&p;
    for (int i = 0; i < 21; ++i) f[i] = (const float*)d_in[i];
    p.out = (float*)d_out; p.ws = (unsigned char*)d_ws;
    if (hipMemsetAsync((char*)d_ws + WS_BAR, 0, WS_BAR_BYTES, stream) != hipSuccess) { fprintf(stderr, "kernel_launch: memset of barrier words failed\n"); return; }
    void* args[] = {&p};
    hipError_t err = hipLaunchCooperativeKernel((const void*)fwd_kernel, dim3(grid), dim3(512), args, LDS_BYTES, stream);
    if (err != hipSuccess) fprintf(stderr, "kernel_launch: cooperative launch failed: %s (grid %d)\n", hipGetErrorString(err), grid);
}
```

```cpp
#include <hip/hip_runtime.h>
#include <hip/hip_cooperative_groups.h>
#include <cstdio>
#include <cstdint>
#include <cmath>
namespace cg = cooperative_groups;

#ifdef PROBE_SEC
#define PROBE_SECV PROBE_SEC
#define PSEC_B(id) unsigned long long _pt##id = 0ull; if ((id) == PROBE_SEC && blockIdx.x == 0 && __builtin_amdgcn_readfirstlane(tid >> 6) == 0) _pt##id = __builtin_amdgcn_s_memrealtime();
#define PSEC_E(id, ldsbase) if ((id) == PROBE_SEC && blockIdx.x == 0 && __builtin_amdgcn_readfirstlane(tid >> 6) == 0) { volatile unsigned long long* _a = (volatile unsigned long long*)((unsigned char*)(ldsbase) + 147456 - 128); *_a = *_a + (__builtin_amdgcn_s_memrealtime() - _pt##id); }
#else
#define PROBE_SECV (-1)
#define PSEC_B(id)
#define PSEC_E(id, ldsbase)
#endif

#define LAS __attribute__((address_space(3)))
typedef unsigned short bf16_t;
typedef short bf16x8 __attribute__((ext_vector_type(8)));
typedef short s16x4 __attribute__((ext_vector_type(4)));
typedef float f32x4 __attribute__((ext_vector_type(4)));
typedef unsigned u32x4 __attribute__((ext_vector_type(4)));
typedef unsigned u32x2 __attribute__((ext_vector_type(2)));
typedef float f32x2_t __attribute__((ext_vector_type(2)));
typedef __bf16 bf16x2_t __attribute__((ext_vector_type(2)));

constexpr int T_TOK = 32768, DM = 1024, SEQ = 2048, NBATCH = 16, PP = 6144;
constexpr float EPS = 1e-6f;
constexpr float LOG2E = 1.4426950408889634f;

__device__ __forceinline__ unsigned cvtpk(float lo, float hi) { f32x2_t v = {lo, hi}; bf16x2_t b = __builtin_convertvector(v, bf16x2_t); return __builtin_bit_cast(unsigned, b); }
__device__ __forceinline__ float bflo(unsigned w) { return __uint_as_float(w << 16); }
__device__ __forceinline__ float bfhi(unsigned w) { return __uint_as_float(w & 0xffff0000u); }
__device__ __forceinline__ float fast_exp2(float x) { return __builtin_amdgcn_exp2f(x); }
__device__ __forceinline__ float sigmoid_f(float x) { return __builtin_amdgcn_rcpf(1.f + fast_exp2(-LOG2E * x)); }
__device__ __forceinline__ float silu_f(float x) { return x * sigmoid_f(x); }

template <int M> __device__ __forceinline__ float shx(float v) { static_assert(M < 32, "shx: xor mask within a 32-lane half"); return __int_as_float(__builtin_amdgcn_ds_swizzle(__float_as_int(v), 0x1f | (M << 10))); }
__device__ __forceinline__ float sum_x32(float v) { auto rr = __builtin_amdgcn_permlane32_swap(__float_as_uint(v), __float_as_uint(v), false, false); return __uint_as_float(rr[0]) + __uint_as_float(rr[1]); }
__device__ __forceinline__ float max_x32(float v) { auto rr = __builtin_amdgcn_permlane32_swap(__float_as_uint(v), __float_as_uint(v), false, false); return fmaxf(__uint_as_float(rr[0]), __uint_as_float(rr[1])); }
__device__ __forceinline__ float bperm(int srclane, float v) { return __int_as_float(__builtin_amdgcn_ds_bpermute(srclane << 2, __float_as_int(v))); }
__device__ __forceinline__ float wave_sum(float v) { v += shx<1>(v); v += shx<2>(v); v += shx<4>(v); v += shx<8>(v); v += shx<16>(v); return sum_x32(v); }
__device__ __forceinline__ float row_rs(const float* ssq, int row) {
    const f32x4* p = (const f32x4*)(ssq + (size_t)row * 16);
    const f32x4 a = p[0], b = p[1], c = p[2], d = p[3];
    const float s = ((a[0] + a[1]) + (a[2] + a[3])) + ((b[0] + b[1]) + (b[2] + b[3])) + ((c[0] + c[1]) + (c[2] + c[3])) + ((d[0] + d[1]) + (d[2] + d[3]));
    return rsqrtf(s * (1.f / 1024.f) + EPS);
}

__device__ __forceinline__ void row_rs8(const float* ssq, int row0, int fq, float (&rsv)[8]) {
#pragma unroll
    for (int i = 0; i < 8; ++i) {
        const int row = row0 + (i >> 2) * 128 + (i & 3) * 16;
        const f32x4 a = *(const f32x4*)(ssq + (size_t)row * 16 + fq * 4);
        float s = (a[0] + a[1]) + (a[2] + a[3]);
        s += shx<16>(s); s = sum_x32(s);
        rsv[i] = rsqrtf(s * (1.f / 1024.f) + EPS);
    }
    asm volatile("" ::: "memory");
}
__device__ __forceinline__ float lb_val(const float* lbp, int cf, int li) {
    const float a0 = lbp[cf], a1 = lbp[2048 + cf], a2 = lbp[4096 + cf], a3 = lbp[6144 + cf];
    const float m = fmaxf(fmaxf(a0, a1), fmaxf(a2, a3));
    const float e0 = __expf(a0 - m), e1 = __expf(a1 - m), e2 = __expf(a2 - m), e3 = __expf(a3 - m);
    const float s = (e0 + e1) + (e2 + e3);
    const float num = (li == 1) ? e1 : (e1 + e2 + e3);
    return num / s;
}
namespace pg8 {
#define PG8_LAS __attribute__((address_space(3)))
typedef unsigned short bf16_t;
typedef short bf16x8 __attribute__((ext_vector_type(8)));
typedef float f32x4 __attribute__((ext_vector_type(4)));
typedef unsigned u32x4 __attribute__((ext_vector_type(4)));
constexpr int BM = 256, BK = 64, HALF = 128, HTB = HALF * BK * 2  , STAGE_BYTES = 8 * HTB, NXCD = 8, WGM = 8;

__host__ __device__ __forceinline__ int lds_byte(int r, int c) { const int st = (r >> 4) * 2 + (c >> 5), rr = r & 15, cc = c & 31, ob = rr * 64 + cc * 2; return st * 1024 + (ob ^ (((ob >> 9) & 1) << 5)); }
__host__ __device__ __forceinline__ void stage_rc(int b, int& R, int& C) { const int st = b / 1024, sb = b % 1024, swz = sb ^ (((sb >> 9) & 1) << 5); R = (st >> 1) * 16 + swz / 64; C = (st & 1) * 32 + (swz % 64) / 2; }
__host__ __device__ __forceinline__ int perm32(int rho) { const int n = rho >> 4, i = rho & 15; return 8 * (i >> 2) + 4 * n + (i & 3); }

struct Unit { int pm, pn; };
struct Gemm { const bf16_t* A; const bf16_t* Bt; int M, N, K, lda; };

struct StaticOrder {
    int nM, nN, nwg, G, c;
    __host__ __device__ void init(int M, int N, int G_, int c_) { nM = M / BM; nN = N / BM; nwg = nM * nN; G = G_; c = c_; }
    __host__ __device__ bool next(int i, Unit& u) const {
        const long L = (long)i * G + c; if (L >= nwg) return false;
        int wgid = (int)L; { const int q = nwg / NXCD, r = nwg % NXCD, xcd = wgid % NXCD, off = wgid / NXCD; wgid = (xcd < r ? xcd * (q + 1) : r * (q + 1) + (xcd - r) * q) + off; }
        const int nig = WGM * nN, gid = wgid / nig, fm = gid * WGM, gsz = (nM - fm) < WGM ? (nM - fm) : WGM;
        u.pm = fm + ((wgid % nig) % gsz); u.pn = (wgid % nig) / gsz; return true;
    }
    __device__ __forceinline__ void a_ready(const Unit&) const {}
    __device__ __forceinline__ void done(const Unit&) const {}
};

struct EpiIn {
    static constexpr bool PERM = true, AFTER_DRAIN = false; static constexpr int PID = 1;
    bf16_t* P; const float* ssq; int mode; float qscale; const float* lbp; int li;
    __device__ __forceinline__ void operator()(const f32x4 (&acc)[2][2][4][2], const Unit& u, int wr, int wc, int fr, int fq) const {
        const int row0 = u.pm * BM + wr * 64 + fr; const int col0 = u.pn * BM + wc * 32 + 8 * fq;
        int act = 0; float sc = 1.f;
#ifndef TRIVIAL_EPI
        if (mode == 0) { if (u.pn >= 4 && u.pn < 8) sc = qscale; }
        else { act = (u.pn < 8) ? 1 : ((u.pn < 16) ? 2 : 0); }
#endif
        float lb[2][8];
#pragma unroll
        for (int bj = 0; bj < 2; ++bj)
#pragma unroll
            for (int i = 0; i < 8; ++i) lb[bj][i] = 0.f;
        if (act == 2) {
#pragma unroll
            for (int bj = 0; bj < 2; ++bj)
#pragma unroll
                for (int i = 0; i < 8; ++i) lb[bj][i] = lbp[col0 + bj * HALF + i - 2048];
        }
        float rsv[8]; row_rs8(ssq, row0, fq, rsv);
#pragma unroll
        for (int ai = 0; ai < 2; ++ai)
#pragma unroll
            for (int m = 0; m < 4; ++m) {
                const int row = row0 + ai * HALF + m * 16;
                const float r = rsv[ai * 4 + m] * sc;
                bf16_t* rowp = P + (size_t)row * PP + col0;
#pragma unroll
                for (int bj = 0; bj < 2; ++bj) {
                    float v[8];
#pragma unroll
                    for (int i = 0; i < 4; ++i) { v[i] = acc[ai][bj][m][0][i] * r; v[4 + i] = acc[ai][bj][m][1][i] * r; }
                    if (act == 1) {
#pragma unroll
                        for (int i = 0; i < 8; ++i) v[i] = silu_f(v[i]);
                    } else if (act == 2) {
#pragma unroll
                        for (int i = 0; i < 8; ++i) { const float sg = sigmoid_f(v[i]); v[i] = 0.6931471805599453f * __builtin_amdgcn_logf(lb[bj][i] + (1.f - lb[bj][i]) * sg); }
                    }
                    u32x4 w; w.x = cvtpk(v[0], v[1]); w.y = cvtpk(v[2], v[3]); w.z = cvtpk(v[4], v[5]); w.w = cvtpk(v[6], v[7]);
                    *(u32x4*)(rowp + bj * HALF) = w;
                }
                asm volatile("" ::: "memory");
            }
    }
};
struct EpiGate {
    static constexpr bool PERM = true, AFTER_DRAIN = false; static constexpr int PID = 2;
    bf16_t* Y; const float* ssq; const float* ssd; const float* ssdw; bf16_t* YA; const float* ssqh; const float* hnw;
    __device__ __forceinline__ void operator()(const f32x4 (&acc)[2][2][4][2], const Unit& u, int wr, int wc, int fr, int fq) const {
        const int row0 = u.pm * BM + wr * 64 + fr; const int col0 = u.pn * BM + wc * 32 + 8 * fq;
        float rsv[8]; row_rs8(ssq, row0, fq, rsv);
        f32x4 hw0 = {1.f, 1.f, 1.f, 1.f}, hw1 = hw0;
        if (ssqh) { hw0 = *(const f32x4*)(hnw + wc * 32 + 8 * fq); hw1 = *(const f32x4*)(hnw + wc * 32 + 8 * fq + 4); }
#pragma unroll
        for (int ai = 0; ai < 2; ++ai) {
            float rh[4][2];
#pragma unroll
            for (int m = 0; m < 4; ++m) { rh[m][0] = 1.f; rh[m][1] = 1.f; }
            if (ssqh) {
                f32x4 pr[4];
#pragma unroll
                for (int m = 0; m < 4; ++m) pr[m] = *(const f32x4*)(ssqh + ((size_t)(row0 + ai * HALF + m * 16) * 16 + 2 * u.pn + (fq >> 1)) * 8 + (fq & 1) * 4);
#pragma unroll
                for (int m = 0; m < 4; ++m) {
                    float sq = (pr[m][0] + pr[m][1]) + (pr[m][2] + pr[m][3]);
                    sq += shx<16>(sq);
                    const auto rr = __builtin_amdgcn_permlane32_swap(__float_as_uint(sq), __float_as_uint(sq), false, false);
                    rh[m][0] = rsqrtf(__uint_as_float(rr[0]) * (1.f / 128.f) + EPS); rh[m][1] = rsqrtf(__uint_as_float(rr[1]) * (1.f / 128.f) + EPS);
                }
                asm volatile("" ::: "memory");
            }
            u32x4 ov[4][2];
#pragma unroll
            for (int m = 0; m < 4; ++m)
#pragma unroll
                for (int bj = 0; bj < 2; ++bj) ov[m][bj] = *(const u32x4*)(Y + (size_t)(row0 + ai * HALF + m * 16) * PP + col0 + bj * HALF);
#pragma unroll
            for (int m = 0; m < 4; ++m) {
                const float r = rsv[ai * 4 + m];
                bf16_t* rowp = Y + (size_t)(row0 + ai * HALF + m * 16) * PP + col0;
#pragma unroll
                for (int bj = 0; bj < 2; ++bj) {
                    const u32x4 o = ov[m][bj];
                    float v[8];
#pragma unroll
                    for (int i = 0; i < 4; ++i) { v[i] = silu_f(acc[ai][bj][m][0][i] * r) * (rh[m][bj] * hw0[i]); v[4 + i] = silu_f(acc[ai][bj][m][1][i] * r) * (rh[m][bj] * hw1[i]); }
                    u32x4 w;
                    w.x = cvtpk(v[0] * bflo(o.x), v[1] * bfhi(o.x)); w.y = cvtpk(v[2] * bflo(o.y), v[3] * bfhi(o.y));
                    w.z = cvtpk(v[4] * bflo(o.z), v[5] * bfhi(o.z)); w.w = cvtpk(v[6] * bflo(o.w), v[7] * bfhi(o.w));
                    *(u32x4*)(rowp + bj * HALF) = w;
                }
            }
            asm volatile("" ::: "memory");
        }
        if (ssd) {
            float rsd[8]; row_rs8(ssd, row0, fq, rsd);
#pragma unroll
            for (int bj = 0; bj < 2; ++bj) {
                const f32x4 w0 = *(const f32x4*)(ssdw + col0 + bj * HALF), w1 = *(const f32x4*)(ssdw + col0 + bj * HALF + 4);
                u32x4 yv[8];
#pragma unroll
                for (int i = 0; i < 8; ++i) yv[i] = *(const u32x4*)(YA + (size_t)(row0 + (i >> 2) * HALF + (i & 3) * 16) * PP + col0 + bj * HALF);
#pragma unroll
                for (int i = 0; i < 8; ++i) {
                    const float rr = rsd[i]; u32x4 y = yv[i];
                    y.x = cvtpk(bflo(y.x) * rr * w0[0], bfhi(y.x) * rr * w0[1]); y.y = cvtpk(bflo(y.y) * rr * w0[2], bfhi(y.y) * rr * w0[3]);
                    y.z = cvtpk(bflo(y.z) * rr * w1[0], bfhi(y.z) * rr * w1[1]); y.w = cvtpk(bflo(y.w) * rr * w1[2], bfhi(y.w) * rr * w1[3]);
                    *(u32x4*)(YA + (size_t)(row0 + (i >> 2) * HALF + (i & 3) * 16) * PP + col0 + bj * HALF) = y;
                }
                asm volatile("" ::: "memory");
            }
        }
    }
};
struct EpiOut {
    static constexpr bool PERM = false, AFTER_DRAIN = false; static constexpr int PID = 3;
    const float* hin; float* hout; bf16_t* U; float* ssq;
    __device__ __forceinline__ void operator()(const f32x4 (&acc)[2][2][4][2], const Unit& u, int wr, int wc, int fr, int fq) const {
        const int row0 = u.pm * BM + wr * 64 + fr; const int col0 = u.pn * BM + wc * 32 + 4 * fq;
#pragma unroll
        for (int ai = 0; ai < 2; ++ai)
#pragma unroll
            for (int m = 0; m < 4; ++m) {
                const int row = row0 + ai * HALF + m * 16;
                const size_t off = (size_t)row * DM + col0;
                float s = 0.f;
#pragma unroll
                for (int bj = 0; bj < 2; ++bj)
#pragma unroll
                    for (int n = 0; n < 2; ++n) {
                        const f32x4 hv = *(const f32x4*)(hin + off + bj * HALF + n * 16) + acc[ai][bj][m][n];
                        *(f32x4*)(hout + off + bj * HALF + n * 16) = hv;
                        if (U) { u32x2 w; w.x = cvtpk(hv[0], hv[1]); w.y = cvtpk(hv[2], hv[3]); *(u32x2*)(U + off + bj * HALF + n * 16) = w; }
                        s += (hv[0] * hv[0] + hv[1] * hv[1]) + (hv[2] * hv[2] + hv[3] * hv[3]);
                    }
                s += shx<16>(s); s = sum_x32(s);
                if (fq == 0) ssq[(size_t)row * 16 + u.pn * 4 + wc] = s;
                if (m == 3) asm volatile("" ::: "memory");
            }
    }
};
template <class Epi, class Sched, bool ALIGN_EPI, bool SP2, int KK, int LDA>
__device__ __forceinline__ void gemm_phase(PG8_LAS unsigned char* lds, const Gemm g, const Sched& S, const Epi& E, int tid_arg) {
    int tid = tid_arg; asm volatile("" : "+v"(tid));
    const int wid = __builtin_amdgcn_readfirstlane(tid >> 6), lane = tid & 63, wr = wid >> 2, wc = wid & 3, fr = lane & 15, fq = lane >> 4;
    constexpr int K = KK, nt = K / BK;
    unsigned voffA[2], voffB[2];
#pragma unroll
    for (int i = 0; i < 2; ++i) { int R, C; stage_rc(tid * 16 + i * 8192, R, C); const int Rb = Epi::PERM ? ((R & ~31) + perm32(R & 31)) : R;
        voffA[i] = (unsigned)(R * LDA + C) * 2u; voffB[i] = (unsigned)(Rb * K + C) * 2u; }
    constexpr size_t kstep = (size_t)(BK * 2);
    constexpr size_t hstepA = (size_t)HALF * LDA * 2, hstepB = (size_t)HALF * K * 2;
    constexpr size_t tstepA = 2 * hstepA, tstepB = 2 * hstepB;
    const unsigned ldsw = (unsigned)wid * 1024u;
    const int aoff = lds_byte(wr * 64 + fr, fq * 8), boff = lds_byte(wc * 32 + fr, fq * 8);
#define PG8_SA(b, h) (((b) * 2 + (h)) * HTB)
#define PG8_SB(b, h) ((4 + (b) * 2 + (h)) * HTB)
#define PG8_STAGE(bufoff, gbase, voff) do { _Pragma("unroll") for (int _i = 0; _i < 2; ++_i) \
        __builtin_amdgcn_global_load_lds((const unsigned*)((const char*)(gbase) + (voff)[_i]), (PG8_LAS unsigned*)(lds + (bufoff) + ldsw + _i * 8192), 16, 0, 0); } while (0)
#define PG8_LDA(dst, b, h) do { _Pragma("unroll") for (int m = 0; m < 4; ++m) _Pragma("unroll") for (int k = 0; k < 2; ++k) dst[m][k] = *(const PG8_LAS bf16x8*)(lds + PG8_SA(b, h) + aoff + m * 2048 + k * 1024); } while (0)
#define PG8_LDB(dst, b, h) do { _Pragma("unroll") for (int n = 0; n < 2; ++n) _Pragma("unroll") for (int k = 0; k < 2; ++k) dst[n][k] = *(const PG8_LAS bf16x8*)(lds + PG8_SB(b, h) + boff + n * 2048 + k * 1024); } while (0)
#define PG8_MMA(ai, bj, At, Bt) do { __builtin_amdgcn_s_setprio(1); _Pragma("unroll") for (int m = 0; m < 4; ++m) _Pragma("unroll") for (int n = 0; n < 2; ++n) _Pragma("unroll") for (int k = 0; k < 2; ++k) \
        acc[ai][bj][m][n] = __builtin_amdgcn_mfma_f32_16x16x32_bf16(Bt[n][k], At[m][k], acc[ai][bj][m][n], 0, 0, 0); __builtin_amdgcn_s_setprio(0); } while (0)
#define PG8_WAIT_V(n) asm volatile("s_waitcnt vmcnt(" #n ")" ::: "memory")
#define PG8_WAIT_L(n) asm volatile("s_waitcnt lgkmcnt(" #n ")" ::: "memory")
#define PG8_BAR __builtin_amdgcn_s_barrier()
#define PG8_SCHED __builtin_amdgcn_sched_barrier(0)
    Unit cur, nxt; int ui = 0;
    if (!S.next(0, cur)) return;
    f32x4 acc[2][2][4][2];
#pragma unroll
    for (int a = 0; a < 2; ++a)
#pragma unroll
        for (int b = 0; b < 2; ++b)
#pragma unroll
            for (int m = 0; m < 4; ++m)
#pragma unroll
                for (int n = 0; n < 2; ++n) acc[a][b][m][n] = (f32x4){0.f, 0.f, 0.f, 0.f};
    bf16x8 At[4][2], B0[2][2], B1[2][2];
    const char* cA = (const char*)g.A + (size_t)cur.pm * tstepA; const char* cB = (const char*)g.Bt + (size_t)cur.pn * tstepB;
    S.a_ready(cur);
    if constexpr (SP2) {
        PG8_STAGE(PG8_SB(0, 0), cB, voffB); PG8_STAGE(PG8_SB(0, 1), cB + hstepB, voffB); PG8_STAGE(PG8_SA(0, 0), cA, voffA); PG8_STAGE(PG8_SA(0, 1), cA + hstepA, voffA);
        if (wr == 1) PG8_BAR;
        PG8_WAIT_V(2); PG8_BAR;
        PG8_STAGE(PG8_SB(1, 0), cB + kstep, voffB); PG8_STAGE(PG8_SA(1, 0), cA + kstep, voffA); PG8_STAGE(PG8_SB(1, 1), cB + hstepB + kstep, voffB);
        PG8_WAIT_V(6); PG8_BAR;
    } else {
        PG8_STAGE(PG8_SB(0, 0), cB, voffB); PG8_STAGE(PG8_SA(0, 0), cA, voffA); PG8_STAGE(PG8_SB(0, 1), cB + hstepB, voffB); PG8_STAGE(PG8_SA(0, 1), cA + hstepA, voffA);
        if (wr == 1) PG8_BAR;
        PG8_WAIT_V(4); PG8_BAR;
        PG8_STAGE(PG8_SB(1, 0), cB + kstep, voffB); PG8_STAGE(PG8_SA(1, 0), cA + kstep, voffA); PG8_STAGE(PG8_SB(1, 1), cB + hstepB + kstep, voffB);
        PG8_WAIT_V(6); PG8_BAR;
    }
    for (;;) {
        const bool has_next = S.next(ui + 1, nxt);
        const char* nA = has_next ? (const char*)g.A + (size_t)nxt.pm * tstepA : cA; const char* nB = has_next ? (const char*)g.Bt + (size_t)nxt.pn * tstepB : cB;
        for (int t = 0; t < nt; t += 2) {
            const bool last = (t == nt - 2);
            const char* a1 = cA + (size_t)(t + 1) * kstep;
            const char* a2 = last ? nA : cA + (size_t)(t + 2) * kstep; const char* b2 = last ? nB : cB + (size_t)(t + 2) * kstep;
            const char* a3 = a2 + kstep; const char* b3 = b2 + kstep;
            if (last && has_next) S.a_ready(nxt);
            if constexpr (SP2) {
            PG8_LDB(B0, 0, 0); PG8_LDB(B1, 0, 1); PG8_SCHED; PG8_LDA(At, 0, 0); PG8_STAGE(PG8_SA(1, 1), a1 + hstepA, voffA);
            PG8_WAIT_V(8); PG8_WAIT_L(0); PG8_BAR; PG8_MMA(0, 0, At, B0); PG8_MMA(0, 1, At, B1); PG8_BAR; PG8_SCHED;
            PG8_LDA(At, 0, 1); PG8_STAGE(PG8_SB(0, 0), b2, voffB); PG8_STAGE(PG8_SB(0, 1), b2 + hstepB, voffB); PG8_STAGE(PG8_SA(0, 0), a2, voffA);
            PG8_WAIT_V(8); PG8_WAIT_L(0); PG8_BAR; PG8_MMA(1, 0, At, B0); PG8_MMA(1, 1, At, B1); PG8_BAR; PG8_SCHED;
            PG8_LDB(B0, 1, 0); PG8_LDB(B1, 1, 1); PG8_SCHED; PG8_LDA(At, 1, 0); PG8_STAGE(PG8_SA(0, 1), a2 + hstepA, voffA);
            PG8_WAIT_V(8); PG8_WAIT_L(0); PG8_BAR; PG8_MMA(0, 0, At, B0); PG8_MMA(0, 1, At, B1); PG8_BAR; PG8_SCHED;
            PG8_LDA(At, 1, 1); PG8_STAGE(PG8_SB(1, 0), b3, voffB); PG8_STAGE(PG8_SB(1, 1), b3 + hstepB, voffB); PG8_STAGE(PG8_SA(1, 0), a3, voffA);
            PG8_WAIT_V(8); PG8_WAIT_L(0); PG8_BAR; PG8_MMA(1, 0, At, B0); PG8_MMA(1, 1, At, B1); PG8_BAR; PG8_SCHED;
            } else {
            PG8_LDB(B0, 0, 0); PG8_SCHED; PG8_LDA(At, 0, 0); PG8_STAGE(PG8_SA(1, 1), a1 + hstepA, voffA);
            PG8_WAIT_L(8); PG8_BAR; PG8_WAIT_L(0); PG8_MMA(0, 0, At, B0); PG8_BAR; PG8_SCHED;
            PG8_LDB(B1, 0, 1); PG8_STAGE(PG8_SB(0, 0), b2, voffB);
            PG8_BAR; PG8_WAIT_L(0); PG8_MMA(0, 1, At, B1); PG8_BAR;
            PG8_LDA(At, 0, 1); PG8_STAGE(PG8_SA(0, 0), a2, voffA);
            PG8_BAR; PG8_WAIT_L(0); PG8_MMA(1, 0, At, B0); PG8_BAR; PG8_SCHED;
            PG8_STAGE(PG8_SB(0, 1), b2 + hstepB, voffB);
            PG8_WAIT_V(6); PG8_BAR; PG8_MMA(1, 1, At, B1); PG8_BAR;
            PG8_LDB(B0, 1, 0); PG8_SCHED; PG8_LDA(At, 1, 0); PG8_STAGE(PG8_SA(0, 1), a2 + hstepA, voffA);
            PG8_WAIT_L(8); PG8_BAR; PG8_WAIT_L(0); PG8_MMA(0, 0, At, B0); PG8_BAR; PG8_SCHED;
            PG8_LDB(B1, 1, 1); PG8_STAGE(PG8_SB(1, 0), b3, voffB);
            PG8_BAR; PG8_WAIT_L(0); PG8_MMA(0, 1, At, B1); PG8_BAR;
            PG8_LDA(At, 1, 1); PG8_STAGE(PG8_SA(1, 0), a3, voffA);
            PG8_BAR; PG8_WAIT_L(0); PG8_MMA(1, 0, At, B0); PG8_BAR; PG8_SCHED;
            PG8_STAGE(PG8_SB(1, 1), b3 + hstepB, voffB);
            PG8_WAIT_V(6); PG8_BAR; PG8_MMA(1, 1, At, B1); PG8_BAR;
            }
        }
        if constexpr (ALIGN_EPI) { if (wr == 0) PG8_BAR; }
        if constexpr (!Epi::AFTER_DRAIN) { unsigned long long _ptE = 0ull; if (Epi::PID == PROBE_SECV && blockIdx.x == 0 && wid == 0) _ptE = __builtin_amdgcn_s_memrealtime(); E(acc, cur, wr, wc, fr, fq); if (Epi::PID == PROBE_SECV && blockIdx.x == 0 && wid == 0) { volatile unsigned long long* _a = (volatile unsigned long long*)((unsigned char*)lds + 147456 - 128); *_a = *_a + (__builtin_amdgcn_s_memrealtime() - _ptE); } S.done(cur); }
        if (!has_next) break;
#pragma unroll
        for (int a = 0; a < 2; ++a)
#pragma unroll
            for (int b = 0; b < 2; ++b)
#pragma unroll
                for (int m = 0; m < 4; ++m)
#pragma unroll
                    for (int n = 0; n < 2; ++n) acc[a][b][m][n] = (f32x4){0.f, 0.f, 0.f, 0.f};
        cur = nxt; cA = nA; cB = nB; ++ui;
        if constexpr (ALIGN_EPI) { if (wr == 1) PG8_BAR; }
    }
    PG8_WAIT_V(0);
    if constexpr (!ALIGN_EPI) { if (wr == 0) PG8_BAR; }
    PG8_BAR;
    if constexpr (Epi::AFTER_DRAIN) { E.fused(acc, cur, wr, wc, fr, fq, lds, wid, lane); S.done(cur); }
#undef PG8_SA
#undef PG8_SB
#undef PG8_STAGE
#undef PG8_LDA
#undef PG8_LDB
#undef PG8_MMA
#undef PG8_WAIT_V
#undef PG8_WAIT_L
#undef PG8_BAR
#undef PG8_SCHED
}
}

constexpr size_t MiB = 1u << 20;
constexpr size_t WS_P = 0;
constexpr size_t WS_U = 384 * MiB;
constexpr size_t WS_WE_IN = 448 * MiB, WS_WE_G = 460 * MiB, WS_WE_OUT = 462 * MiB, WS_WE_DT = 466 * MiB;
constexpr size_t WS_WO_IN = 468 * MiB, WS_WO_G = 480 * MiB, WS_WO_OUT = 484 * MiB;
constexpr size_t WS_DT = 488 * MiB;
constexpr size_t WS_SSQ = 490 * MiB;
constexpr size_t WS_SSD = 492 * MiB;
constexpr size_t WS_BAR = 494 * MiB;
constexpr size_t WS_BAR_BYTES = 65536;
constexpr size_t WS_LB = 494 * MiB + 65536;
constexpr size_t WS_SSQH = 495 * MiB;
constexpr size_t WS_END = 511 * MiB;
constexpr int LDS_BYTES = 147456;
#ifndef PG8SP2
#define PG8SP2 true
#endif

struct Params {
    const float *x, *norm_w, *final_norm_w, *rel_bias, *even_w_in, *even_w_out, *conv_w, *conv_b, *dt_bias, *A_log, *D_skip, *ssd_norm_w,
        *lq1, *lk1, *lq2, *lk2, *subln_w, *odd_w_in, *odd_w_out, *hgrn_lb, *hgrn_norm_w;
    float* out; unsigned char* ws;
};

typedef const __attribute__((address_space(4))) Params* PPtr;
__device__ __forceinline__ PPtr get_params() { const __attribute__((address_space(4))) void* k = (const __attribute__((address_space(4))) void*)__builtin_amdgcn_kernarg_segment_ptr(); asm volatile("" : "+s"(k)); return (PPtr)k; }
struct Seg { const float* W; int ldw, col0, ncols, K; bf16_t* WT; int row0; const float* scale; };
__device__ __forceinline__ void convert_seg(const Seg s, float* scr, int gw, int NGW, int lane) {
    const int nblk = (s.ncols + 31) / 32, nitems = (s.K / 64) * nblk;
    for (int it = gw; it < nitems; it += NGW) {
        const int kb = it / nblk, nb = it % nblk, k0 = 64 * kb, n0 = 32 * nb;
        const int nc = lane & 31; const bool okc = (n0 + nc) < s.ncols;
        float wv[32];
#pragma unroll
        for (int i = 0; i < 32; ++i) { const int kk = 2 * i + (lane >> 5); wv[i] = okc ? s.W[(size_t)(k0 + kk) * s.ldw + s.col0 + n0 + nc] : 0.f; }
        if (s.scale) {
#pragma unroll
            for (int i = 0; i < 32; ++i) wv[i] *= s.scale[k0 + 2 * i + (lane >> 5)];
        }
#pragma unroll
        for (int i = 0; i < 32; ++i) scr[(2 * i + (lane >> 5)) * 33 + nc] = wv[i];
        __builtin_amdgcn_fence(__ATOMIC_RELEASE, "workgroup"); __builtin_amdgcn_wave_barrier();
        const int c = lane & 7;
#pragma unroll
        for (int j = 0; j < 4; ++j) {
            const int n = (lane >> 3) + 8 * j; const float* sp = scr + (8 * c) * 33 + n;
            u32x4 o; o.x = cvtpk(sp[0 * 33], sp[1 * 33]); o.y = cvtpk(sp[2 * 33], sp[3 * 33]); o.z = cvtpk(sp[4 * 33], sp[5 * 33]); o.w = cvtpk(sp[6 * 33], sp[7 * 33]);
            if (n0 + n < s.ncols) *(u32x4*)(s.WT + (size_t)(s.row0 + n0 + n) * s.K + k0 + 8 * c) = o;
        }
        __builtin_amdgcn_fence(__ATOMIC_RELEASE, "workgroup"); __builtin_amdgcn_wave_barrier();
    }
}
__device__ __forceinline__ void convert_layer(PPtr p, int layer, float* scr, int gw, int NGW, int lane) {
    const float* nw = p->norm_w + (size_t)layer * DM;
    if ((layer & 1) == 0) {
        const int e = layer >> 1;
        const float* Wi = p->even_w_in + (size_t)e * DM * 7184; const float* Wo = p->even_w_out + (size_t)e * 2048 * DM;
        bf16_t* WIN = (bf16_t*)(p->ws + WS_WE_IN);
        convert_seg(Seg{Wi, 7184, 0, 1024, DM, WIN, 0, nw}, scr, gw, NGW, lane);
        convert_seg(Seg{Wi, 7184, 3088, 1024, DM, WIN, 1024, nw}, scr, gw, NGW, lane);
        convert_seg(Seg{Wi, 7184, 1024, 2048, DM, WIN, 2048, nw}, scr, gw, NGW, lane);
        convert_seg(Seg{Wi, 7184, 4112, 2048, DM, WIN, 4096, nw}, scr, gw, NGW, lane);
        convert_seg(Seg{Wi, 7184, 6160, 1024, DM, (bf16_t*)(p->ws + WS_WE_G), 0, nw}, scr, gw, NGW, lane);
        convert_seg(Seg{Wi, 7184, 3072, 16, DM, (bf16_t*)(p->ws + WS_WE_DT), 0, nw}, scr, gw, NGW, lane);
        convert_seg(Seg{Wo, DM, 0, 1024, 2048, (bf16_t*)(p->ws + WS_WE_OUT), 0, nullptr}, scr, gw, NGW, lane);
    } else {
        const int o = layer >> 1;
        const float* Wi = p->odd_w_in + (size_t)o * DM * 8192; const float* Wo = p->odd_w_out + (size_t)o * 2048 * DM;
        convert_seg(Seg{Wi, 8192, 0, 6144, DM, (bf16_t*)(p->ws + WS_WO_IN), 0, nw}, scr, gw, NGW, lane);
        convert_seg(Seg{Wi, 8192, 6144, 2048, DM, (bf16_t*)(p->ws + WS_WO_G), 0, nw}, scr, gw, NGW, lane);
        convert_seg(Seg{Wo, DM, 0, 1024, 2048, (bf16_t*)(p->ws + WS_WO_OUT), 0, nullptr}, scr, gw, NGW, lane);
    }
}

__device__ __forceinline__ void dt_items(PPtr p, int e, int gw, int NGW, int lane) {
    const bf16_t* U = (const bf16_t*)(p->ws + WS_U); const bf16_t* Wdt = (const bf16_t*)(p->ws + WS_WE_DT);
    const float* ssq = (const float*)(p->ws + WS_SSQ); float* dt = (float*)(p->ws + WS_DT);
    const int fr = lane & 15, fq = lane >> 4;
    for (int item = gw; item < T_TOK / 16; item += NGW) {
        const int row0 = item * 16;
        f32x4 acc = {0.f, 0.f, 0.f, 0.f};
        const bf16x8* ap = (const bf16x8*)(U + (size_t)(row0 + fr) * DM + fq * 8);
        const bf16x8* bp = (const bf16x8*)(Wdt + (size_t)fr * DM + fq * 8);
#pragma unroll 8
        for (int s = 0; s < 32; ++s) acc = __builtin_amdgcn_mfma_f32_16x16x32_bf16(ap[s * 4], bp[s * 4], acc, 0, 0, 0);
        const float bias = p->dt_bias[e * 16 + fr];
#pragma unroll
        for (int i = 0; i < 4; ++i) {
            const int row = row0 + 4 * fq + i;
            const float v = acc[i] * row_rs(ssq, row) + bias;
            dt[(size_t)row * 16 + fr] = (v > 20.f) ? v : log1pf(__expf(v));
        }
    }
}

typedef short v4i16_t __attribute__((ext_vector_type(4)));
__device__ __forceinline__ s16x4 vtr(const bf16_t* ptr) { return __builtin_bit_cast(s16x4, __builtin_amdgcn_ds_read_tr16_b64_v4i16((LAS v4i16_t*)ptr)); }
__device__ __forceinline__ void ssd_unit(PPtr p, int e, int b, int h, unsigned char* lds, int tid) {
    float* sx = (float*)lds;
    float* sB = sx + 16 * 64;
    float* sC = sB + 16 * 128;
    float* sy = sC + 16 * 128;
    float* sdt = sy + 16 * 64;
    float* sda = sdt + 16;
    bf16_t* P = (bf16_t*)(p->ws + WS_P);
    const float* dt = (const float*)(p->ws + WS_DT); float* ssd = (float*)(p->ws + WS_SSD);
    const float* cw = p->conv_w + (size_t)e * 4 * 2048; const float* cb = p->conv_b + (size_t)e * 2048;
    const float Ah = -__expf(p->A_log[e * 16 + h]), Dh = p->D_skip[e * 16 + h];
    const int g = h >> 2, pp = tid >> 3, nq = tid & 7;
    const size_t rowb = (size_t)b * SEQ;
    float st[16];
#pragma unroll
    for (int i = 0; i < 16; ++i) st[i] = 0.f;
    for (int c = 0; c < SEQ / 16; ++c) {
        const int t0 = c * 16;
        for (int it = tid; it < 1280; it += 512) {
            const int t = it / 80, q4 = it % 80;
            int ch; float* dst;
            if (q4 < 16) { ch = h * 64 + q4 * 4; dst = sx + t * 64 + q4 * 4; }
            else if (q4 < 48) { ch = 1024 + g * 128 + (q4 - 16) * 4; dst = sB + t * 128 + (q4 - 16) * 4; }
            else { ch = 1536 + g * 128 + (q4 - 48) * 4; dst = sC + t * 128 + (q4 - 48) * 4; }
            f32x4 a = *(const f32x4*)(cb + ch);
#pragma unroll
            for (int j = 0; j < 4; ++j) {
                const int tt = t0 + t - 3 + j;
                if (tt >= 0) {
                    const u32x2 raw = *(const u32x2*)(P + (rowb + tt) * PP + 2048 + ch);
                    const f32x4 w = *(const f32x4*)(cw + j * 2048 + ch);
                    a[0] += w[0] * bflo(raw.x); a[1] += w[1] * bfhi(raw.x); a[2] += w[2] * bflo(raw.y); a[3] += w[3] * bfhi(raw.y);
                }
            }
            f32x4 o; o[0] = silu_f(a[0]); o[1] = silu_f(a[1]); o[2] = silu_f(a[2]); o[3] = silu_f(a[3]);
            *(f32x4*)dst = o;
        }
        if (tid < 16) { const float d = dt[(rowb + t0 + tid) * 16 + h]; sdt[tid] = d; sda[tid] = __expf(d * Ah); }
        __syncthreads();
        for (int t = 0; t < 16; ++t) {
            const float xv = sx[t * 64 + pp]; const float X = xv * sdt[t], da = sda[t];
            float y = 0.f;
#pragma unroll
            for (int i4 = 0; i4 < 4; ++i4) {
                const f32x4 bv = *(const f32x4*)(sB + t * 128 + nq * 16 + i4 * 4), cv = *(const f32x4*)(sC + t * 128 + nq * 16 + i4 * 4);
#pragma unroll
                for (int i = 0; i < 4; ++i) { st[i4 * 4 + i] = da * st[i4 * 4 + i] + X * bv[i]; y += cv[i] * st[i4 * 4 + i]; }
            }
            y += shx<1>(y); y += shx<2>(y); y += shx<4>(y);
            if (nq == 0) sy[t * 64 + pp] = y + Dh * xv;
        }
        __syncthreads();
        {
            const int t = tid >> 5, p2 = (tid & 31) * 2;
            bf16_t* zp = P + (rowb + t0 + t) * PP + h * 64 + p2;
            const unsigned zw = *(const unsigned*)zp;
            const float g0 = sy[t * 64 + p2] * silu_f(bflo(zw)), g1 = sy[t * 64 + p2 + 1] * silu_f(bfhi(zw));
            float ss = g0 * g0 + g1 * g1;
            ss += shx<1>(ss); ss += shx<2>(ss); ss += shx<4>(ss); ss += shx<8>(ss); ss += shx<16>(ss);
            *(unsigned*)zp = cvtpk(g0, g1);
            if ((tid & 31) == 0) ssd[(rowb + t0 + t) * 16 + h] = ss;
        }
    }
    __syncthreads();
}

__device__ __forceinline__ bf16x8 scale_frag(s16x4 lo, s16x4 hi, const f32x4 w0, const f32x4 w1) {
    u32x4 o;
    o.x = cvtpk(__uint_as_float((unsigned)(unsigned short)lo[0] << 16) * w0[0], __uint_as_float((unsigned)(unsigned short)lo[1] << 16) * w0[1]);
    o.y = cvtpk(__uint_as_float((unsigned)(unsigned short)lo[2] << 16) * w0[2], __uint_as_float((unsigned)(unsigned short)lo[3] << 16) * w0[3]);
    o.z = cvtpk(__uint_as_float((unsigned)(unsigned short)hi[0] << 16) * w1[0], __uint_as_float((unsigned)(unsigned short)hi[1] << 16) * w1[1]);
    o.w = cvtpk(__uint_as_float((unsigned)(unsigned short)hi[2] << 16) * w1[2], __uint_as_float((unsigned)(unsigned short)hi[3] << 16) * w1[3]);
    return __builtin_bit_cast(bf16x8, o);
}
template <int NR> __device__ __forceinline__ void ssd_stage_rows(const bf16_t* P, size_t rowb, int t0, int lrow0, int ch, bf16_t* dst, int dstr, const float* cw, const float* cb) {
    float wt[4][8], bias[8];
#pragma unroll
    for (int j = 0; j < 4; ++j) { const f32x4 a = *(const f32x4*)(cw + j * 2048 + ch), bq = *(const f32x4*)(cw + j * 2048 + ch + 4);
        wt[j][0] = a[0]; wt[j][1] = a[1]; wt[j][2] = a[2]; wt[j][3] = a[3]; wt[j][4] = bq[0]; wt[j][5] = bq[1]; wt[j][6] = bq[2]; wt[j][7] = bq[3]; }
    { const f32x4 a = *(const f32x4*)(cb + ch), bq = *(const f32x4*)(cb + ch + 4); bias[0] = a[0]; bias[1] = a[1]; bias[2] = a[2]; bias[3] = a[3]; bias[4] = bq[0]; bias[5] = bq[1]; bias[6] = bq[2]; bias[7] = bq[3]; }
    const int r0 = t0 + lrow0;
    u32x4 raw[NR + 3];
#pragma unroll
    for (int k = 0; k < NR + 3; ++k) {
        const int tt = r0 - 3 + k;
        raw[k] = (tt >= 0) ? *(const u32x4*)(P + (rowb + tt) * PP + 2048 + ch) : (u32x4){0u, 0u, 0u, 0u};
    }
#pragma unroll
    for (int k = 0; k < NR; ++k) {
        float acc[8];
#pragma unroll
        for (int q = 0; q < 8; ++q) acc[q] = bias[q];
#pragma unroll
        for (int j = 0; j < 4; ++j) {
            const u32x4 rw = raw[k + j];
            acc[0] += wt[j][0] * bflo(rw.x); acc[1] += wt[j][1] * bfhi(rw.x); acc[2] += wt[j][2] * bflo(rw.y); acc[3] += wt[j][3] * bfhi(rw.y);
            acc[4] += wt[j][4] * bflo(rw.z); acc[5] += wt[j][5] * bfhi(rw.z); acc[6] += wt[j][6] * bflo(rw.w); acc[7] += wt[j][7] * bfhi(rw.w);
        }
        u32x4 o; o.x = cvtpk(silu_f(acc[0]), silu_f(acc[1])); o.y = cvtpk(silu_f(acc[2]), silu_f(acc[3])); o.z = cvtpk(silu_f(acc[4]), silu_f(acc[5])); o.w = cvtpk(silu_f(acc[6]), silu_f(acc[7]));
        *(u32x4*)(dst + (lrow0 + k) * dstr) = o;
    }
}
__device__ __forceinline__ void ssd_unit_mfma(PPtr p, int e, int b, int h, unsigned char* lds, int tid) {
    constexpr int CS = 136, BS = 144, XS = 72, SS = 136;
    bf16_t* sC = (bf16_t*)lds;
    bf16_t* sB = sC + 128 * CS;
    bf16_t* sX = sB + 128 * BS;
    bf16_t* sSt = sX + 128 * XS;
    float* sAcs = (float*)(sSt + 2 * 64 * SS);
    float* sDt = sAcs + 128;
    float* sW = sDt + 128;
    float* sDec = sW + 128;
    bf16_t* P = (bf16_t*)(p->ws + WS_P);
    const float* dt = (const float*)(p->ws + WS_DT); float* ssd = (float*)(p->ws + WS_SSD);
    const float* cw = p->conv_w + (size_t)e * 4 * 2048; const float* cb = p->conv_b + (size_t)e * 2048;
    const float Ah = -__expf(p->A_log[e * 16 + h]), Dh = p->D_skip[e * 16 + h];
    const int lane = tid & 63, w = __builtin_amdgcn_readfirstlane(tid >> 6), c16 = lane & 15, g = lane >> 4, tq = c16 >> 2, tp = c16 & 3;
    const int grp = h >> 2;
    const size_t rowb = (size_t)b * SEQ;
    f32x4 stacc[4];
#pragma unroll
    for (int pt = 0; pt < 4; ++pt) stacc[pt] = (f32x4){0.f, 0.f, 0.f, 0.f};
    for (int i = tid; i < 64 * SS / 2; i += 512) ((unsigned*)sSt)[i] = 0u;
    for (int c = 0; c < SEQ / 128; ++c) {
        const int cur = c & 1, nxt = cur ^ 1;
        const int t0 = c * 128;
        PSEC_B(4)
        {
            { const int it = tid; const int cg8 = it % 40, seg = it / 40;
              int ch; bf16_t* dst; int dstr;
              if (cg8 < 8) { ch = h * 64 + cg8 * 8; dst = sX + cg8 * 8; dstr = XS; }
              else if (cg8 < 24) { ch = 1024 + grp * 128 + (cg8 - 8) * 8; dst = sB + (cg8 - 8) * 8; dstr = BS; }
              else { ch = 1536 + grp * 128 + (cg8 - 24) * 8; dst = sC + (cg8 - 24) * 8; dstr = CS; }
              ssd_stage_rows<8>(P, rowb, t0, seg * 8, ch, dst, dstr, cw, cb); }
            { const int it = 512 + (tid >> 2); const int cg8 = it % 40, seg = it / 40;
              int ch; bf16_t* dst; int dstr;
              if (cg8 < 8) { ch = h * 64 + cg8 * 8; dst = sX + cg8 * 8; dstr = XS; }
              else if (cg8 < 24) { ch = 1024 + grp * 128 + (cg8 - 8) * 8; dst = sB + (cg8 - 8) * 8; dstr = BS; }
              else { ch = 1536 + grp * 128 + (cg8 - 24) * 8; dst = sC + (cg8 - 24) * 8; dstr = CS; }
              ssd_stage_rows<2>(P, rowb, t0, seg * 8 + 2 * (tid & 3), ch, dst, dstr, cw, cb); }
        }
        if (w == 0) {
            const float d0 = dt[(rowb + t0 + 2 * lane) * 16 + h], d1 = dt[(rowb + t0 + 2 * lane + 1) * 16 + h];
            const float a0 = d0 * Ah, a1 = d1 * Ah;
            float sc = a0 + a1;
#pragma unroll
            for (int o = 1; o < 64; o <<= 1) { const float t = bperm(lane - o, sc); if (lane >= o) sc += t; }
            const float acs1 = sc, acs0 = sc - a1;
            const float alast = bperm(63, sc);
            sAcs[2 * lane] = acs0; sAcs[2 * lane + 1] = acs1; sDt[2 * lane] = d0; sDt[2 * lane + 1] = d1;
            sW[2 * lane] = d0 * __expf(alast - acs0); sW[2 * lane + 1] = d1 * __expf(alast - acs1);
            sDec[2 * lane] = __expf(acs0); sDec[2 * lane + 1] = __expf(acs1);
        }
        __syncthreads();
        PSEC_E(4, lds) PSEC_B(5)
        {
            const int lrow = 16 * w + c16;
            bf16_t zr[4][4];
#pragma unroll
            for (int pt = 0; pt < 4; ++pt)
#pragma unroll
                for (int j = 0; j < 4; ++j) zr[pt][j] = P[(rowb + t0 + 16 * w + 4 * g + j) * PP + h * 64 + 16 * pt + c16];
            bf16x8 cf[4];
#pragma unroll
            for (int ks = 0; ks < 4; ++ks) cf[ks] = *(const bf16x8*)(sC + lrow * CS + 32 * ks + 8 * g);
            f32x4 acc[4];
#pragma unroll
            for (int pt = 0; pt < 4; ++pt) {
                f32x4 a = {0.f, 0.f, 0.f, 0.f};
#pragma unroll
                for (int ks = 0; ks < 4; ++ks) {
                    const bf16x8 sf = *(const bf16x8*)(sSt + (cur * 64 + 16 * pt + c16) * SS + 32 * ks + 8 * g);
                    a = __builtin_amdgcn_mfma_f32_16x16x32_bf16(cf[ks], sf, a, 0, 0, 0);
                }
                acc[pt] = a;
            }
            {
                const f32x4 dl = *(const f32x4*)(sDec + 16 * w + 4 * g);
#pragma unroll
                for (int pt = 0; pt < 4; ++pt) { acc[pt][0] *= dl[0]; acc[pt][1] *= dl[1]; acc[pt][2] *= dl[2]; acc[pt][3] *= dl[3]; }
            }
            const float al = sAcs[lrow];
#pragma unroll
            for (int kp = 0; kp < 4; ++kp) {
                if (2 * kp <= w) {
                    u32x4 pk = {0u, 0u, 0u, 0u};
#pragma unroll
                    for (int hf = 0; hf < 2; ++hf) {
                        const int st = 2 * kp + hf;
                        if (st <= w) {
                            f32x4 a = {0.f, 0.f, 0.f, 0.f};
#pragma unroll
                            for (int ks = 0; ks < 4; ++ks) {
                                const bf16x8 bf = *(const bf16x8*)(sB + (16 * st + c16) * BS + 32 * ks + 8 * g);
                                a = __builtin_amdgcn_mfma_f32_16x16x32_bf16(bf, cf[ks], a, 0, 0, 0);
                            }
                            const f32x4 as = *(const f32x4*)(sAcs + 16 * st + 4 * g), ds = *(const f32x4*)(sDt + 16 * st + 4 * g);
                            float v[4];
#pragma unroll
                            for (int j = 0; j < 4; ++j) {
                                const int srow = 16 * st + 4 * g + j;
                                v[j] = (srow <= lrow) ? a[j] * __expf(al - as[j]) * ds[j] : 0.f;
                            }
                            if (hf == 0) { pk.x = cvtpk(v[0], v[1]); pk.y = cvtpk(v[2], v[3]); } else { pk.z = cvtpk(v[0], v[1]); pk.w = cvtpk(v[2], v[3]); }
                        }
                    }
                    const bf16x8 pa = __builtin_bit_cast(bf16x8, pk);
#pragma unroll
                    for (int pt = 0; pt < 4; ++pt) {
                        const s16x4 lo = vtr(sX + (32 * kp + 4 * g + tq) * XS + 16 * pt + 4 * tp);
                        const s16x4 hi = vtr(sX + (32 * kp + 16 + 4 * g + tq) * XS + 16 * pt + 4 * tp);
                        const bf16x8 xf = {lo[0], lo[1], lo[2], lo[3], hi[0], hi[1], hi[2], hi[3]};
                        acc[pt] = __builtin_amdgcn_mfma_f32_16x16x32_bf16(pa, xf, acc[pt], 0, 0, 0);
                    }
                }
            }
#pragma unroll
            for (int j = 0; j < 4; ++j) {
                const int lr = 16 * w + 4 * g + j;
                float ss = 0.f;
#pragma unroll
                for (int pt = 0; pt < 4; ++pt) {
                    const float xv = __uint_as_float((unsigned)sX[lr * XS + 16 * pt + c16] << 16);
                    const float zv = __uint_as_float((unsigned)zr[pt][j] << 16);
                    const float yg = (acc[pt][j] + Dh * xv) * silu_f(zv);
                    ss += yg * yg;
                    P[(rowb + t0 + lr) * PP + h * 64 + 16 * pt + c16] = (bf16_t)(cvtpk(yg, 0.f) & 0xffffu);
                }
                ss += shx<1>(ss); ss += shx<2>(ss); ss += shx<4>(ss); ss += shx<8>(ss);
                if (c16 == 0) ssd[(rowb + t0 + lr) * 16 + h] = ss;
            }
        }
        PSEC_E(5, lds) PSEC_B(6)
        {
            const float dlast = sDec[127];
#pragma unroll
            for (int pt = 0; pt < 4; ++pt) { stacc[pt][0] *= dlast; stacc[pt][1] *= dlast; stacc[pt][2] *= dlast; stacc[pt][3] *= dlast; }
#pragma unroll
            for (int ks = 0; ks < 4; ++ks) {
                const s16x4 blo = vtr(sB + (32 * ks + 8 * g + tq) * BS + 16 * w + 4 * tp);
                const s16x4 bhi = vtr(sB + (32 * ks + 8 * g + 4 + tq) * BS + 16 * w + 4 * tp);
                const bf16x8 bfr = {blo[0], blo[1], blo[2], blo[3], bhi[0], bhi[1], bhi[2], bhi[3]};
                const f32x4 w0 = *(const f32x4*)(sW + 32 * ks + 8 * g), w1 = *(const f32x4*)(sW + 32 * ks + 8 * g + 4);
#pragma unroll
                for (int pt = 0; pt < 4; ++pt) {
                    const s16x4 xlo = vtr(sX + (32 * ks + 8 * g + tq) * XS + 16 * pt + 4 * tp);
                    const s16x4 xhi = vtr(sX + (32 * ks + 8 * g + 4 + tq) * XS + 16 * pt + 4 * tp);
                    stacc[pt] = __builtin_amdgcn_mfma_f32_16x16x32_bf16(scale_frag(xlo, xhi, w0, w1), bfr, stacc[pt], 0, 0, 0);
                }
            }
#pragma unroll
            for (int pt = 0; pt < 4; ++pt)
#pragma unroll
                for (int j = 0; j < 4; ++j) sSt[(nxt * 64 + 16 * pt + 4 * g + j) * SS + 16 * w + c16] = (bf16_t)(cvtpk(stacc[pt][j], 0.f) & 0xffffu);
        }
        __syncthreads();
        PSEC_E(6, lds)
    }
}

__device__ __forceinline__ void hgrn_unit(PPtr p, int oi, int b, int h, unsigned char* lds, int tid) {
    float* sq = (float*)lds;
    float* sf = sq + 2048; float* sk = sf + 2048; float* sv = sk + 2048;
    float* so = sv + 2048;
    bf16_t* P = (bf16_t*)(p->ws + WS_P);
    const size_t rowb = (size_t)b * SEQ;
    const int v = tid & 127, dq = tid >> 7;
    const int st_t = tid >> 5, st_d = (tid & 31) * 4;
    const f32x4 nw = *(const f32x4*)(p->hgrn_norm_w + oi * 128 + st_d);
    float S[32];
#pragma unroll
    for (int i = 0; i < 32; ++i) S[i] = 0.f;
    const bf16_t* src = P + (rowb + st_t) * PP + h * 128 + st_d;
    u32x2 rq = *(const u32x2*)(src), rf = *(const u32x2*)(src + 2048), rv = *(const u32x2*)(src + 4096);
    for (int c = 0; c < SEQ / 16; ++c) {
        {
            f32x4 q4 = {bflo(rq.x), bfhi(rq.x), bflo(rq.y), bfhi(rq.y)};
            f32x4 f4 = {__expf(bflo(rf.x)), __expf(bfhi(rf.x)), __expf(bflo(rf.y)), __expf(bfhi(rf.y))};
            f32x4 k4 = {1.f - f4[0], 1.f - f4[1], 1.f - f4[2], 1.f - f4[3]};
            f32x4 v4 = {bflo(rv.x), bfhi(rv.x), bflo(rv.y), bfhi(rv.y)};
            *(f32x4*)(sq + st_t * 128 + st_d) = q4; *(f32x4*)(sf + st_t * 128 + st_d) = f4; *(f32x4*)(sk + st_t * 128 + st_d) = k4; *(f32x4*)(sv + st_t * 128 + st_d) = v4;
        }
        __syncthreads();
        if (c + 1 < SEQ / 16) { const bf16_t* s2 = src + (size_t)(c + 1) * 16 * PP; rq = *(const u32x2*)(s2); rf = *(const u32x2*)(s2 + 2048); rv = *(const u32x2*)(s2 + 4096); }
        for (int t = 0; t < 16; ++t) {
            const float vt = sv[t * 128 + v]; float a = 0.f;
#pragma unroll
            for (int i4 = 0; i4 < 8; ++i4) {
                const f32x4 f4 = *(const f32x4*)(sf + t * 128 + dq * 32 + i4 * 4), k4 = *(const f32x4*)(sk + t * 128 + dq * 32 + i4 * 4), q4 = *(const f32x4*)(sq + t * 128 + dq * 32 + i4 * 4);
#pragma unroll
                for (int i = 0; i < 4; ++i) { S[i4 * 4 + i] = f4[i] * S[i4 * 4 + i] + k4[i] * vt; a += q4[i] * S[i4 * 4 + i]; }
            }
            so[(dq * 16 + t) * 128 + v] = a;
        }
        __syncthreads();
        {
            f32x4 o = *(const f32x4*)(so + (0 * 16 + st_t) * 128 + st_d);
            o += *(const f32x4*)(so + (1 * 16 + st_t) * 128 + st_d); o += *(const f32x4*)(so + (2 * 16 + st_t) * 128 + st_d); o += *(const f32x4*)(so + (3 * 16 + st_t) * 128 + st_d);
            float ss = (o[0] * o[0] + o[1] * o[1]) + (o[2] * o[2] + o[3] * o[3]);
            ss += shx<1>(ss); ss += shx<2>(ss); ss += shx<4>(ss); ss += shx<8>(ss); ss += shx<16>(ss);
            const float r = rsqrtf(ss * (1.f / 128.f) + EPS);
            u32x2 w; w.x = cvtpk(o[0] * r * nw[0], o[1] * r * nw[1]); w.y = cvtpk(o[2] * r * nw[2], o[3] * r * nw[3]);
            *(u32x2*)(P + (rowb + c * 16 + st_t) * PP + h * 128 + st_d) = w;
        }
    }
    __syncthreads();
}

#define MFMA16(a, b, c) __builtin_amdgcn_mfma_f32_16x16x16bf16_1k((a), (b), (c), 0, 0, 0)
__device__ __forceinline__ s16x4 pack4(float a, float b, float c, float d) { u32x2 w; w.x = cvtpk(a, b); w.y = cvtpk(c, d); return __builtin_bit_cast(s16x4, w); }
__device__ __forceinline__ void hgrn_unit_mfma(PPtr p, int oi, int b, int h, unsigned char* lds, int tid) {
    constexpr int QS = 136, KTS = 20, NCH = SEQ / 16, PF = 4;
    bf16_t* sQ = (bf16_t*)lds;
    bf16_t* sK = sQ + 2 * 16 * QS;
    bf16_t* sKT = sK + 2 * 16 * QS;
    float* sDec = (float*)(sKT + 2 * 128 * KTS);
    float* sPart = sDec + 2 * 128;
    bf16_t* sTr = (bf16_t*)(sPart + 2 * 128);
    bf16_t* P = (bf16_t*)(p->ws + WS_P);
    const int lane = tid & 63, w = __builtin_amdgcn_readfirstlane(tid >> 6), r = lane & 15, g = lane >> 4;
    const size_t rowb = (size_t)b * SEQ;
    float* ssqh = (float*)(p->ws + WS_SSQH);
    const bf16_t* gld = P + (rowb + (lane >> 2)) * PP + h * 128 + 16 * w + 4 * (lane & 3);
    bf16_t* myTr = sTr + w * (3 * 16 * 20);
    f32x4 St[8];
#pragma unroll
    for (int j = 0; j < 8; ++j) St[j] = (f32x4){0.f, 0.f, 0.f, 0.f};
    u32x2 pq[PF], pl[PF], pv[PF];
#pragma unroll
    for (int k = 0; k < PF; ++k) { const bf16_t* nb = gld + (size_t)k * 16 * PP; pq[k] = *(const u32x2*)nb; pl[k] = *(const u32x2*)(nb + 2048); pv[k] = *(const u32x2*)(nb + 4096); }
#pragma unroll 1
    for (int c4 = 0; c4 < NCH; c4 += PF) {
#pragma unroll
        for (int k = 0; k < PF; ++k) {
            const int c = c4 + k; const int buf = k & 1;
            PSEC_B(7)
            *(u32x2*)(myTr + (0 * 16 + (lane >> 2)) * 20 + 4 * (lane & 3)) = pq[k];
            *(u32x2*)(myTr + (1 * 16 + (lane >> 2)) * 20 + 4 * (lane & 3)) = pl[k];
            *(u32x2*)(myTr + (2 * 16 + (lane >> 2)) * 20 + 4 * (lane & 3)) = pv[k];
            if (c + PF < NCH) { const bf16_t* nb = gld + (size_t)(c + PF) * 16 * PP; pq[k] = *(const u32x2*)nb; pl[k] = *(const u32x2*)(nb + 2048); pv[k] = *(const u32x2*)(nb + 4096); }
            float qv[4], lf[4]; s16x4 vf;
#pragma unroll
            for (int i = 0; i < 4; ++i) {
                qv[i] = __uint_as_float((unsigned)myTr[(0 * 16 + 4 * g + i) * 20 + r] << 16);
                lf[i] = __uint_as_float((unsigned)myTr[(1 * 16 + 4 * g + i) * 20 + r] << 16);
                vf[i] = (short)myTr[(2 * 16 + 4 * g + i) * 20 + r];
            }
            const float p0 = lf[0], p1 = p0 + lf[1], p2 = p1 + lf[2], p3 = p2 + lf[3];
            const float t1 = bperm(lane - 16, p3), t2 = bperm(lane - 32, p3), t3 = bperm(lane - 48, p3);
            const float ex = (g >= 1 ? t1 : 0.f) + (g >= 2 ? t2 : 0.f) + (g >= 3 ? t3 : 0.f);
            const float blast = bperm(48 + r, ex + p3);
            const float bc[4] = {ex + p0, ex + p1, ex + p2, ex + p3};
            float kh[4];
            const float eblast = fast_exp2(LOG2E * blast);
#pragma unroll
            for (int i = 0; i < 4; ++i) {
                const float kk = 1.f - fast_exp2(LOG2E * lf[i]);
                const float eb = fast_exp2(LOG2E * bc[i]);
                const float kt = kk * fast_exp2(-LOG2E * bc[i]);
                sQ[(buf * 16 + 4 * g + i) * QS + 16 * w + r] = (bf16_t)(cvtpk(qv[i] * eb, 0.f) & 0xffffu);
                sK[(buf * 16 + 4 * g + i) * QS + 16 * w + r] = (bf16_t)(cvtpk(kt, 0.f) & 0xffffu);
                kh[i] = kt * eblast;
            }
            *(s16x4*)(sKT + (buf * 128 + 16 * w + r) * KTS + 4 * g) = pack4(kh[0], kh[1], kh[2], kh[3]);
            if (g == 0) sDec[buf * 128 + 16 * w + r] = eblast;
            asm volatile("s_waitcnt lgkmcnt(0)\n\ts_barrier" ::: "memory");
            PSEC_E(7, lds) PSEC_B(8)
            f32x4 a = {0.f, 0.f, 0.f, 0.f};
#pragma unroll
            for (int ks = 0; ks < 4; ++ks) {
                const bf16x8 ka = *(const bf16x8*)(sK + (buf * 16 + r) * QS + 32 * ks + 8 * g);
                const bf16x8 qb = *(const bf16x8*)(sQ + (buf * 16 + r) * QS + 32 * ks + 8 * g);
                a = __builtin_amdgcn_mfma_f32_16x16x32_bf16(ka, qb, a, 0, 0, 0);
            }
#pragma unroll
            for (int i = 0; i < 4; ++i) a[i] = (4 * g + i <= r) ? a[i] : 0.f;
            f32x4 o = MFMA16(pack4(a[0], a[1], a[2], a[3]), vf, ((f32x4){0.f, 0.f, 0.f, 0.f}));
#pragma unroll
            for (int j = 0; j < 8; ++j) {
                const s16x4 qa = *(const s16x4*)(sQ + (buf * 16 + r) * QS + 16 * j + 4 * g);
                o = MFMA16(qa, pack4(St[j][0], St[j][1], St[j][2], St[j][3]), o);
            }
#pragma unroll
            for (int j = 0; j < 8; ++j) {
                const f32x4 d4 = *(const f32x4*)(sDec + buf * 128 + 16 * j + 4 * g);
                const s16x4 ka = *(const s16x4*)(sKT + (buf * 128 + 16 * j + r) * KTS + 4 * g);
                f32x4 sc = St[j]; sc[0] *= d4[0]; sc[1] *= d4[1]; sc[2] *= d4[2]; sc[3] *= d4[3];
                St[j] = MFMA16(ka, vf, sc);
            }
#pragma unroll
            for (int i = 0; i < 4; ++i) {
                const size_t grow = rowb + c * 16 + 4 * g + i;
                P[grow * PP + h * 128 + 16 * w + r] = (bf16_t)(cvtpk(o[i], 0.f) & 0xffffu);
                float ss = o[i] * o[i];
                ss += shx<1>(ss); ss += shx<2>(ss); ss += shx<4>(ss); ss += shx<8>(ss);
                if (r == 0) ssqh[(grow * 16 + h) * 8 + w] = ss;
            }
            PSEC_E(8, lds)
        }
    }
    __syncthreads();
}

constexpr int KSTR = 136, VSTR = 144;

__device__ __forceinline__ void attn_unit(PPtr p, int e, int b, int h, int qb, float lam, float oscale, unsigned char* lds, int tid) {
    bf16_t* sK = (bf16_t*)lds;
    bf16_t* sV = sK + 64 * KSTR;
    float* sbias = (float*)(sV + 64 * VSTR);
    bf16_t* P = (bf16_t*)(p->ws + WS_P);
    const int lane = tid & 63, w = __builtin_amdgcn_readfirstlane(tid >> 6), c16 = lane & 15, g = lane >> 4;
    const size_t rowb = (size_t)b * SEQ;
    const int q0 = qb * 128, qw0 = q0 + 16 * w, qpos = qw0 + c16;
    __syncthreads();
    if (tid < 129) {
        int bucket;
        if (tid < 16) bucket = tid;
        else { int lg = 16 + (int)(__logf((float)tid * (1.f / 16.f)) / 2.0794415416798357f * 16.f); bucket = lg < 31 ? lg : 31; }
        sbias[tid] = p->rel_bias[bucket * 8 + h] * LOG2E;
    }
    bf16x8 qf[2][2];
#pragma unroll
    for (int mp = 0; mp < 2; ++mp)
#pragma unroll
        for (int ds = 0; ds < 2; ++ds) qf[mp][ds] = *(const bf16x8*)(P + (rowb + qpos) * PP + 1024 + h * 128 + mp * 64 + ds * 32 + 8 * g);
    f32x4 O[2][8];
#pragma unroll
    for (int mp = 0; mp < 2; ++mp)
#pragma unroll
        for (int vt = 0; vt < 8; ++vt) O[mp][vt] = (f32x4){0.f, 0.f, 0.f, 0.f};
    float mref[2] = {0.f, 0.f}, lsum[2] = {0.f, 0.f};
    const int NT = (q0 + 128) / 64;
    const bf16_t* Kg = P + rowb * PP + 4096 + h * 128; const bf16_t* Vg = P + rowb * PP + 5120 + h * 128;
    const int ld_row0 = tid >> 4, ld_ch = tid & 15;
    u32x4 kr[2], vr[2];
#pragma unroll
    for (int i = 0; i < 2; ++i) { kr[i] = *(const u32x4*)(Kg + (size_t)(ld_row0 + 32 * i) * PP + ld_ch * 8); vr[i] = *(const u32x4*)(Vg + (size_t)(ld_row0 + 32 * i) * PP + ld_ch * 8); }
    for (int t = 0; t < NT; ++t) {
        __syncthreads();
#pragma unroll
        for (int i = 0; i < 2; ++i) { *(u32x4*)(sK + (ld_row0 + 32 * i) * KSTR + ld_ch * 8) = kr[i]; *(u32x4*)(sV + (ld_row0 + 32 * i) * VSTR + ld_ch * 8) = vr[i]; }
        __syncthreads();
        if (t + 1 < NT) {
#pragma unroll
            for (int i = 0; i < 2; ++i) { kr[i] = *(const u32x4*)(Kg + (size_t)((t + 1) * 64 + ld_row0 + 32 * i) * PP + ld_ch * 8); vr[i] = *(const u32x4*)(Vg + (size_t)((t + 1) * 64 + ld_row0 + 32 * i) * PP + ld_ch * 8); }
        }
        const int k0 = t * 64;
        PSEC_B(9)
        if (k0 <= qw0 + 15) {
            const bool far = (qw0 - (k0 + 63)) >= 128;
            const bool first = (t == 0);
            const float bfar = sbias[128];
            bf16x8 pa[2][2];
#pragma unroll
            for (int mp = 0; mp < 2; ++mp) {
                f32x4 sc[4];
                const float cinit = (far ? bfar : 0.f) - mref[mp];
#pragma unroll
                for (int s = 0; s < 4; ++s) {
                    f32x4 a = {cinit, cinit, cinit, cinit};
#pragma unroll
                    for (int ds = 0; ds < 2; ++ds) {
                        const bf16x8 kf = *(const bf16x8*)(sK + (16 * s + c16) * KSTR + mp * 64 + ds * 32 + 8 * g);
                        a = __builtin_amdgcn_mfma_f32_16x16x32_bf16(kf, qf[mp][ds], a, 0, 0, 0);
                    }
                    sc[s] = a;
                }
                if (!far) {
#pragma unroll
                    for (int s = 0; s < 4; ++s)
#pragma unroll
                        for (int j = 0; j < 4; ++j) {
                            const int rel = qpos - (k0 + 16 * s + 4 * g + j);
                            const int idx = rel < 0 ? 0 : (rel > 128 ? 128 : rel);
                            sc[s][j] = (rel >= 0) ? sc[s][j] + sbias[idx] : -1e30f;
                        }
                }
                float mx = fmaxf(fmaxf(fmaxf(sc[0][0], sc[0][1]), fmaxf(sc[0][2], sc[0][3])), fmaxf(fmaxf(sc[1][0], sc[1][1]), fmaxf(sc[1][2], sc[1][3])));
                mx = fmaxf(mx, fmaxf(fmaxf(fmaxf(sc[2][0], sc[2][1]), fmaxf(sc[2][2], sc[2][3])), fmaxf(fmaxf(sc[3][0], sc[3][1]), fmaxf(sc[3][2], sc[3][3]))));
                mx = fmaxf(mx, shx<16>(mx)); mx = max_x32(mx);
                if (first || __any(mx > 8.f)) {
                    const float delta = first ? mx : fmaxf(mx, 0.f);
                    mref[mp] += delta;
#pragma unroll
                    for (int s = 0; s < 4; ++s)
#pragma unroll
                        for (int j = 0; j < 4; ++j) sc[s][j] -= delta;
                    const float al = fast_exp2(-delta);
                    lsum[mp] *= al;
                    if (!first) {
#pragma unroll
                        for (int j = 0; j < 4; ++j) {
                            const float aj = bperm(4 * g + j, al);
#pragma unroll
                            for (int vt = 0; vt < 8; ++vt) O[mp][vt][j] *= aj;
                        }
                    }
                }
                float rs = 0.f;
#pragma unroll
                for (int s = 0; s < 4; ++s)
#pragma unroll
                    for (int j = 0; j < 4; ++j) { const float pv = fast_exp2(sc[s][j]); sc[s][j] = pv; rs += pv; }
                lsum[mp] += rs;
#pragma unroll
                for (int ks = 0; ks < 2; ++ks) {
                    u32x4 pk;
                    pk.x = cvtpk(sc[2 * ks][0], sc[2 * ks][1]); pk.y = cvtpk(sc[2 * ks][2], sc[2 * ks][3]);
                    pk.z = cvtpk(sc[2 * ks + 1][0], sc[2 * ks + 1][1]); pk.w = cvtpk(sc[2 * ks + 1][2], sc[2 * ks + 1][3]);
                    pa[mp][ks] = __builtin_bit_cast(bf16x8, pk);
                }
                asm volatile("" ::: "memory");
            }
            const int tq = c16 >> 2, tp = c16 & 3;
#pragma unroll
            for (int ks = 0; ks < 2; ++ks)
#pragma unroll
                for (int vt = 0; vt < 8; ++vt) {
                    const s16x4 lo = vtr(sV + (32 * ks + 4 * g + tq) * VSTR + 16 * vt + 4 * tp);
                    const s16x4 hi = vtr(sV + (32 * ks + 16 + 4 * g + tq) * VSTR + 16 * vt + 4 * tp);
                    const bf16x8 vf = {lo[0], lo[1], lo[2], lo[3], hi[0], hi[1], hi[2], hi[3]};
                    O[0][vt] = __builtin_amdgcn_mfma_f32_16x16x32_bf16(pa[0][ks], vf, O[0][vt], 0, 0, 0);
                    O[1][vt] = __builtin_amdgcn_mfma_f32_16x16x32_bf16(pa[1][ks], vf, O[1][vt], 0, 0, 0);
                    if (vt & 1) asm volatile("" ::: "memory");
                }
        }
        PSEC_E(9, lds)
    }
#pragma unroll
    for (int mp = 0; mp < 2; ++mp) { lsum[mp] += shx<16>(lsum[mp]); lsum[mp] = sum_x32(lsum[mp]); }
    const float lrun[2] = {lsum[0], lsum[1]};
    const float il0 = 1.f / lrun[0], il1 = lam / lrun[1];
    float sw[8];
#pragma unroll
    for (int vt = 0; vt < 8; ++vt) sw[vt] = p->subln_w[e * 128 + 16 * vt + c16] * oscale;
#pragma unroll
    for (int j = 0; j < 4; ++j) {
        const float a0 = bperm(4 * g + j, il0), a1 = bperm(4 * g + j, il1);
        float o[8]; float ss = 0.f;
#pragma unroll
        for (int vt = 0; vt < 8; ++vt) { o[vt] = O[0][vt][j] * a0 - O[1][vt][j] * a1; ss += o[vt] * o[vt]; }
        ss += shx<1>(ss); ss += shx<2>(ss); ss += shx<4>(ss); ss += shx<8>(ss);
        const float r = rsqrtf(ss * (1.f / 128.f) + EPS);
        bf16_t* op = P + (rowb + qw0 + 4 * g + j) * PP + 1024 + h * 128 + c16;
#pragma unroll
        for (int vt = 0; vt < 8; ++vt) op[16 * vt] = (bf16_t)(cvtpk(o[vt] * r * sw[vt], 0.f) & 0xffffu);
    }
}

#define XB_TMO      128
#define XB_XCNT(j)  (256  + 64 * (j))
#define XB_XSUB(j)  (1280 + 64 * (j))
#define XB_XGEN(j)  (2304 + 64 * (j))
#define XB_TOP      3328
#define XB_TOPGEN   3392
#define XCD_BAR_WORDS 3456
#define XB_SPIN_CAP (1u << 18)

__device__ __forceinline__ unsigned xb_ld(unsigned* p)              { return __hip_atomic_load(p, __ATOMIC_RELAXED, __HIP_MEMORY_SCOPE_AGENT); }
__device__ __forceinline__ unsigned xb_add(unsigned* p, unsigned v) { return __hip_atomic_fetch_add(p, v, __ATOMIC_RELAXED, __HIP_MEMORY_SCOPE_AGENT); }
__device__ __forceinline__ unsigned xb_xcc_id() { return (unsigned)__builtin_amdgcn_s_getreg((3 << 11) | 20) & 0xFu; }
#define XB_SPIN(cond, bar) do { unsigned _sp = 0; while (cond) { __builtin_amdgcn_s_sleep(1); \
    if ((++_sp & 255u) == 0u) { if (xb_ld(&(bar)[XB_TMO])) break; if (_sp > XB_SPIN_CAP) { atomicAdd(&(bar)[XB_TMO], 1u); break; } } } } while (0)

struct XcdBarrier {
    unsigned* bar; unsigned x;
    volatile LAS unsigned* st;
};

__device__ __forceinline__ XcdBarrier xcd_barrier_post(unsigned* bar, volatile LAS unsigned* st, bool leader) {
    XcdBarrier b; b.bar = bar; b.x = xb_xcc_id(); b.st = st;
    if (leader) (void)xb_add(&bar[XB_XCNT(b.x)], 1u);
    return b;
}
__device__ __forceinline__ void xcd_barrier_complete(unsigned* bar, unsigned x, unsigned& nloc, unsigned& nx) {
    const unsigned G = gridDim.x * gridDim.y * gridDim.z;
    unsigned sum, cnt, mine, sp = 0u;
    for (;;) {
        sum = 0u; cnt = 0u; mine = 0u;
#pragma unroll
        for (unsigned j = 0; j < 16; ++j) { const unsigned c = xb_ld(&bar[XB_XCNT(j)]); sum += c; cnt += (c > 0u) ? 1u : 0u; mine = (j == x) ? c : mine; }
        if (sum == G) break;
        __builtin_amdgcn_s_sleep(1);
        if ((++sp & 255u) == 0u) { if (xb_ld(&bar[XB_TMO])) break; if (sp > XB_SPIN_CAP) { atomicAdd(&bar[XB_TMO], 1u); break; } }
    }
    nloc = mine > 0u ? mine : 1u; nx = cnt > 0u ? cnt : 1u;
}

__device__ __forceinline__ void xcd_barrier(const XcdBarrier& b, bool leader) {
    asm volatile("s_waitcnt vmcnt(0)" ::: "memory");
    __syncthreads();
    if (leader) {
        unsigned* bar = b.bar;
        __builtin_amdgcn_s_waitcnt(0);
        unsigned nloc = b.st[0], nx = b.st[1];
        if (nloc == 0u) { xcd_barrier_complete(bar, b.x, nloc, nx); b.st[0] = nloc; b.st[1] = nx; }
        const unsigned old = xb_add(&bar[XB_XSUB(b.x)], 1u);
        const unsigned gen = old / nloc;
        if (old + 1u == (gen + 1u) * nloc) {
            __builtin_amdgcn_fence(__ATOMIC_RELEASE, "agent");
            asm volatile("s_waitcnt vmcnt(0)" ::: "memory");
            const unsigned og = xb_add(&bar[XB_TOP], 1u);
            const unsigned tg = og / nx;
            if (og + 1u == (tg + 1u) * nx) xb_add(&bar[XB_TOPGEN], 1u);
            else XB_SPIN(xb_ld(&bar[XB_TOPGEN]) == tg, bar);
            __builtin_amdgcn_fence(__ATOMIC_ACQUIRE, "agent");
            xb_add(&bar[XB_XGEN(b.x)], 1u);
            asm volatile("s_waitcnt vmcnt(0)" ::: "memory");
        } else {
            XB_SPIN(xb_ld(&bar[XB_XGEN(b.x)]) == gen, bar);
            __builtin_amdgcn_fence(__ATOMIC_ACQUIRE, "agent");
            asm volatile("s_waitcnt vmcnt(0)" ::: "memory");
        }
    }
    __syncthreads();
}

#define p get_params()
__global__ void __launch_bounds__(512, 2) fwd_kernel(Params p_unused) {
    extern __shared__ __attribute__((aligned(16))) unsigned char lds[];
    cg::grid_group grid = cg::this_grid();
    int tid = threadIdx.x, lane = tid & 63; const int wave = __builtin_amdgcn_readfirstlane(tid >> 6);
#define FRESH_LANES() do { lane = (int)__builtin_amdgcn_mbcnt_hi(~0u, __builtin_amdgcn_mbcnt_lo(~0u, 0u)); asm volatile("" : "+v"(lane)); tid = wave * 64 + lane; } while (0)
    const int G = gridDim.x, blk = blockIdx.x;
    volatile LAS unsigned* bar_st = (volatile LAS unsigned*)(lds + LDS_BYTES - 512);
    if (tid < 2) bar_st[tid] = 0u;
#ifdef PROBE_SEC
    if (wave == 0) *(volatile unsigned long long*)(lds + LDS_BYTES - 128) = 0ull;
#endif
    __syncthreads();
    const XcdBarrier xbar = xcd_barrier_post((unsigned*)(get_params()->ws + WS_BAR), bar_st, tid == 0);
#define GRID_SYNC() do { FRESH_LANES(); xcd_barrier(xbar, tid == 0); } while (0)
    __builtin_assume(blk >= 0 && blk < 256 && G >= 1 && G <= 256);
    const int gw = blk * 8 + wave, NGW = G * 8;
    const int vcu = __builtin_amdgcn_readfirstlane((G % 8 == 0) ? (blk % 8) * (G / 8) + blk / 8 : blk);
    bf16_t* P = (bf16_t*)(p->ws + WS_P); bf16_t* U = (bf16_t*)(p->ws + WS_U);
    float* ssq = (float*)(p->ws + WS_SSQ);
    float* scr = (float*)(lds + wave * 8704);
    PG8_LAS unsigned char* ring = (PG8_LAS unsigned char*)lds;

#ifdef PROBE_MASK
    unsigned long long* tstamp = (unsigned long long*)(lds + LDS_BYTES - 256);
    int n_ts = 0;
#define STAMP() do { if (blk == 0 && threadIdx.x == 0) tstamp[n_ts] = __builtin_amdgcn_s_memrealtime(); ++n_ts; } while (0)
#else
#define STAMP() do {} while (0)
#endif
    STAMP();
    for (int r0 = gw; r0 < T_TOK; r0 += 4 * NGW) {
        f32x4 v[4][4];
#pragma unroll
        for (int u = 0; u < 4; ++u) { const int row = min(r0 + u * NGW, T_TOK - 1); const f32x4* xr = (const f32x4*)(p->x + (size_t)row * DM) + lane;
#pragma unroll
            for (int j = 0; j < 4; ++j) v[u][j] = xr[64 * j]; }
#pragma unroll
        for (int u = 0; u < 4; ++u) {
            const int row = r0 + u * NGW;
            float s = 0.f;
#pragma unroll
            for (int j = 0; j < 4; ++j) s += (v[u][j][0] * v[u][j][0] + v[u][j][1] * v[u][j][1]) + (v[u][j][2] * v[u][j][2] + v[u][j][3] * v[u][j][3]);
            s = wave_sum(s);
            if (row < T_TOK) {
                u32x2* up = (u32x2*)(U + (size_t)row * DM) + lane;
#pragma unroll
                for (int j = 0; j < 4; ++j) { u32x2 w; w.x = cvtpk(v[u][j][0], v[u][j][1]); w.y = cvtpk(v[u][j][2], v[u][j][3]); up[64 * j] = w; }
                if (lane < 16) ssq[(size_t)row * 16 + lane] = (lane == 0) ? s : 0.f;
            }
        }
    }
    convert_layer(p, 0, scr, gw, NGW, lane);
    for (int i = blk * 512 + tid; i < 4096; i += G * 512) ((float*)(p->ws + WS_LB))[i] = lb_val(p->hgrn_lb, i & 2047, (i >> 11) ? 3 : 1);
    grid.sync(); STAMP();

#pragma unroll 1
    for (int layer = 0; layer < 4; ++layer) {
        const bool even = (layer & 1) == 0; const int e = layer >> 1;
        FRESH_LANES();
        if (even) {
            dt_items(p, e, gw, NGW, lane);
            pg8::Gemm gm{U, (const bf16_t*)(p->ws + WS_WE_IN), T_TOK, 6144, DM, DM}; pg8::StaticOrder S; S.init(T_TOK, 6144, G, blk);
            pg8::EpiIn E{P, ssq, 0, 0.125f * LOG2E, nullptr, 0};
#ifndef SKIP_IN
            pg8::gemm_phase<pg8::EpiIn, pg8::StaticOrder, true, PG8SP2, 1024, 1024>(ring, gm, S, E, tid);
#endif
        } else {
            pg8::Gemm gm{U, (const bf16_t*)(p->ws + WS_WO_IN), T_TOK, 6144, DM, DM}; pg8::StaticOrder S; S.init(T_TOK, 6144, G, blk);
            pg8::EpiIn E{P, ssq, 1, 1.f, (const float*)(p->ws + WS_LB) + e * 2048, layer};
#ifndef SKIP_IN
            pg8::gemm_phase<pg8::EpiIn, pg8::StaticOrder, true, PG8SP2, 1024, 1024>(ring, gm, S, E, tid);
#endif
        }
        GRID_SYNC(); STAMP();
        FRESH_LANES();
        if (even) {
            const float lam_init = 0.8f - 0.6f * __expf(-0.3f * (float)layer);
            float d1 = p->lq1[e * 64 + lane] * p->lk1[e * 64 + lane], d2 = p->lq2[e * 64 + lane] * p->lk2[e * 64 + lane];
            d1 = wave_sum(d1); d2 = wave_sum(d2);
            const float lam = __expf(d1) - __expf(d2) + lam_init;
            for (int pi = vcu; pi < 1024; pi += G) {
                const int bh = pi >> 3, s = pi & 7;
#ifndef SKIP_ATTN
#pragma unroll 1
                for (int half = 0; half < 2; ++half) { FRESH_LANES(); attn_unit(p, e, bh >> 3, bh & 7, half ? s : 15 - s, lam, 1.f - lam_init, lds, tid); }
#endif
            }
            __syncthreads(); STAMP();
            FRESH_LANES();
#ifndef SKIP_SSD
            for (int ui = vcu; ui < 256; ui += G) ssd_unit_mfma(p, e, ui >> 4, ui & 15, lds, tid);
#endif
        } else {
#ifndef SKIP_HGRN
            for (int ui = blk; ui < 256; ui += G) hgrn_unit_mfma(p, e, ui >> 4, ui & 15, lds, tid);
#endif
        }
        GRID_SYNC(); STAMP();
        FRESH_LANES();
        if (even) {
            pg8::Gemm gm{U, (const bf16_t*)(p->ws + WS_WE_G), T_TOK, 1024, DM, DM}; pg8::StaticOrder S; S.init(T_TOK, 1024, G, blk);
            pg8::EpiGate E{P + 1024, ssq, (const float*)(p->ws + WS_SSD), p->ssd_norm_w + e * 1024, P, nullptr, nullptr};
#ifndef SKIP_GATE
            pg8::gemm_phase<pg8::EpiGate, pg8::StaticOrder, true, PG8SP2, 1024, 1024>(ring, gm, S, E, tid);
#endif
        } else {
            pg8::Gemm gm{U, (const bf16_t*)(p->ws + WS_WO_G), T_TOK, 2048, DM, DM}; pg8::StaticOrder S; S.init(T_TOK, 2048, G, blk);
            pg8::EpiGate E{P, ssq, nullptr, nullptr, nullptr, (const float*)(p->ws + WS_SSQH), p->hgrn_norm_w + e * 128};
#ifndef SKIP_GATE
            pg8::gemm_phase<pg8::EpiGate, pg8::StaticOrder, true, PG8SP2, 1024, 1024>(ring, gm, S, E, tid);
#endif
        }
        GRID_SYNC(); STAMP();
        FRESH_LANES();
        {
            pg8::Gemm gm{P, (const bf16_t*)(p->ws + (even ? WS_WE_OUT : WS_WO_OUT)), T_TOK, 1024, 2048, PP}; pg8::StaticOrder S; S.init(T_TOK, 1024, G, blk);
            pg8::EpiOut E{layer == 0 ? p->x : p->out, p->out, layer < 3 ? U : nullptr, ssq};
#ifndef SKIP_OUT
            pg8::gemm_phase<pg8::EpiOut, pg8::StaticOrder, true, PG8SP2, 2048, 6144>(ring, gm, S, E, tid);
#endif
            FRESH_LANES();
            if (layer < 3) convert_layer(p, layer + 1, scr, gw, NGW, lane);
        }
        GRID_SYNC(); STAMP();
    }
    FRESH_LANES();
    for (int r0 = gw; r0 < T_TOK; r0 += 4 * NGW) {
        float r[4]; f32x4 v[4][4];
#pragma unroll
        for (int u = 0; u < 4; ++u) { const int row = min(r0 + u * NGW, T_TOK - 1); r[u] = row_rs(ssq, row); const f32x4* hp = (const f32x4*)(p->out + (size_t)row * DM) + lane;
#pragma unroll
            for (int j = 0; j < 4; ++j) v[u][j] = hp[64 * j]; }
        const f32x4* wp = (const f32x4*)p->final_norm_w + lane;
        const f32x4 w0 = wp[0], w1 = wp[64], w2 = wp[128], w3 = wp[192];
#pragma unroll
        for (int u = 0; u < 4; ++u) {
            const int row = r0 + u * NGW;
            if (row < T_TOK) {
                f32x4* hp = (f32x4*)(p->out + (size_t)row * DM) + lane;
#pragma unroll
                for (int j = 0; j < 4; ++j) { f32x4 x = v[u][j]; const f32x4 w = (j == 0) ? w0 : (j == 1) ? w1 : (j == 2) ? w2 : w3; const float rr = r[u];
                    x[0] *= rr * w[0]; x[1] *= rr * w[1]; x[2] *= rr * w[2]; x[3] *= rr * w[3]; hp[64 * j] = x; }
            }
        }
    }
#ifdef PROBE_SEC
    if (blk == 0 && wave == 0) {
        const unsigned long long tend = __builtin_amdgcn_s_memrealtime();
        const unsigned long long acc_t = *(volatile unsigned long long*)(lds + LDS_BYTES - 128) * PROBE_MULT;
        while (__builtin_amdgcn_s_memrealtime() - tend < acc_t) __builtin_amdgcn_s_sleep(32);
    }
#endif
#ifdef PROBE_MASK
    if (blk == 0 && threadIdx.x == 0) {
        const unsigned long long tend = __builtin_amdgcn_s_memrealtime();
        unsigned long long acc_t = 0;
        for (int k = 0; k + 1 < n_ts; ++k) if ((PROBE_MASK >> k) & 1u) acc_t += tstamp[k + 1] - tstamp[k];
        acc_t *= PROBE_MULT;
        while (__builtin_amdgcn_s_memrealtime() - tend < acc_t) __builtin_amdgcn_s_sleep(32);
    }
#endif
}

#undef p
extern "C" void kernel_launch(void* const* d_in, const int* in_sizes, int n_in, void* d_out, int out_size, void* d_ws, size_t ws_size, hipStream_t stream) {
    static int grid = 0;
    if (grid == 0) {
        if (n_in != 21 || out_size != T_TOK * DM || ws_size < WS_END) { fprintf(stderr, "kernel_launch: unexpected shapes: n_in %d out %d ws %zu (need %zu)\n", n_in, out_size, ws_size, (size_t)WS_END); grid = -1; return; }
        int dev = 0, cus = 0, per_cu = 0;
        hipGetDevice(&dev); hipDeviceGetAttribute(&cus, hipDeviceAttributeMultiprocessorCount, dev);
        hipFuncSetAttribute((const void*)fwd_kernel, hipFuncAttributeMaxDynamicSharedMemorySize, LDS_BYTES);
        hipOccupancyMaxActiveBlocksPerMultiprocessor(&per_cu, (const void*)fwd_kernel, 512, LDS_BYTES);
        if (per_cu < 1) { fprintf(stderr, "kernel_launch: occupancy query says %d blocks per CU\n", per_cu); per_cu = 1; }
        (void)hipGetLastError();
        grid = cus * per_cu;
        if (grid > 256) grid = 256;
    }
    if (grid < 0) return;
    Params p{};
    const float** f = (const float**)&p;
    for (int i = 0; i < 21; ++i) f[i] = (const float*)d_in[i];
    p.out = (float*)d_out; p.ws = (unsigned char*)d_ws;
    if (hipMemsetAsync((char*)d_ws + WS_BAR, 0, WS_BAR_BYTES, stream) != hipSuccess) { fprintf(stderr, "kernel_launch: memset of barrier words failed\n"); return; }
    void* args[] = {&p};
    hipError_t err = hipLaunchCooperativeKernel((const void*)fwd_kernel, dim3(grid), dim3(512), args, LDS_BYTES, stream);
    if (err != hipSuccess) fprintf(stderr, "kernel_launch: cooperative launch failed: %s (grid %d)\n", hipGetErrorString(err), grid);
}
```

```cpp
#include <hip/hip_runtime.h>
#include <hip/hip_cooperative_groups.h>
#include <cstdio>
#include <cstdint>
#include <cmath>
namespace cg = cooperative_groups;

#ifdef PROBE_SEC
#define PROBE_SECV PROBE_SEC
#define PSEC_B(id) unsigned long long _pt##id = 0ull; if ((id) == PROBE_SEC && blockIdx.x == 0 && __builtin_amdgcn_readfirstlane(tid >> 6) == 0) _pt##id = __builtin_amdgcn_s_memrealtime();
#define PSEC_E(id, ldsbase) if ((id) == PROBE_SEC && blockIdx.x == 0 && __builtin_amdgcn_readfirstlane(tid >> 6) == 0) { volatile unsigned long long* _a = (volatile unsigned long long*)((unsigned char*)(ldsbase) + 147456 - 128); *_a = *_a + (__builtin_amdgcn_s_memrealtime() - _pt##id); }
#else
#define PROBE_SECV (-1)
#define PSEC_B(id)
#define PSEC_E(id, ldsbase)
#endif

#define LAS __attribute__((address_space(3)))
typedef unsigned short bf16_t;
typedef short bf16x8 __attribute__((ext_vector_type(8)));
typedef short s16x4 __attribute__((ext_vector_type(4)));
typedef float f32x4 __attribute__((ext_vector_type(4)));
typedef unsigned u32x4 __attribute__((ext_vector_type(4)));
typedef unsigned u32x2 __attribute__((ext_vector_type(2)));
typedef float f32x2_t __attribute__((ext_vector_type(2)));
typedef __bf16 bf16x2_t __attribute__((ext_vector_type(2)));

constexpr int T_TOK = 32768, DM = 1024, SEQ = 2048, NBATCH = 16, PP = 6144;
constexpr float EPS = 1e-6f;
constexpr float LOG2E = 1.4426950408889634f;

__device__ __forceinline__ unsigned cvtpk(float lo, float hi) { f32x2_t v = {lo, hi}; bf16x2_t b = __builtin_convertvector(v, bf16x2_t); return __builtin_bit_cast(unsigned, b); }
__device__ __forceinline__ float bflo(unsigned w) { return __uint_as_float(w << 16); }
__device__ __forceinline__ float bfhi(unsigned w) { return __uint_as_float(w & 0xffff0000u); }
__device__ __forceinline__ float fast_exp2(float x) { return __builtin_amdgcn_exp2f(x); }
__device__ __forceinline__ float sigmoid_f(float x) { return __builtin_amdgcn_rcpf(1.f + fast_exp2(-LOG2E * x)); }
__device__ __forceinline__ float silu_f(float x) { return x * sigmoid_f(x); }

template <int M> __device__ __forceinline__ float shx(float v) { static_assert(M < 32, "shx: xor mask within a 32-lane half"); return __int_as_float(__builtin_amdgcn_ds_swizzle(__float_as_int(v), 0x1f | (M << 10))); }
__device__ __forceinline__ float sum_x32(float v) { auto rr = __builtin_amdgcn_permlane32_swap(__float_as_uint(v), __float_as_uint(v), false, false); return __uint_as_float(rr[0]) + __uint_as_float(rr[1]); }
__device__ __forceinline__ float max_x32(float v) { auto rr = __builtin_amdgcn_permlane32_swap(__float_as_uint(v), __float_as_uint(v), false, false); return fmaxf(__uint_as_float(rr[0]), __uint_as_float(rr[1])); }
__device__ __forceinline__ float bperm(int srclane, float v) { return __int_as_float(__builtin_amdgcn_ds_bpermute(srclane << 2, __float_as_int(v))); }
__device__ __forceinline__ float wave_sum(float v) { v += shx<1>(v); v += shx<2>(v); v += shx<4>(v); v += shx<8>(v); v += shx<16>(v); return sum_x32(v); }
__device__ __forceinline__ float row_rs(const float* ssq, int row) {
    const f32x4* p = (const f32x4*)(ssq + (size_t)row * 16);
    const f32x4 a = p[0], b = p[1], c = p[2], d = p[3];
    const float s = ((a[0] + a[1]) + (a[2] + a[3])) + ((b[0] + b[1]) + (b[2] + b[3])) + ((c[0] + c[1]) + (c[2] + c[3])) + ((d[0] + d[1]) + (d[2] + d[3]));
    return rsqrtf(s * (1.f / 1024.f) + EPS);
}

__device__ __forceinline__ void row_rs8(const float* ssq, int row0, int fq, float (&rsv)[8]) {
#pragma unroll
    for (int i = 0; i < 8; ++i) {
        const int row = row0 + (i >> 2) * 128 + (i & 3) * 16;
        const f32x4 a = *(const f32x4*)(ssq + (size_t)row * 16 + fq * 4);
        float s = (a[0] + a[1]) + (a[2] + a[3]);
        s += shx<16>(s); s = sum_x32(s);
        rsv[i] = rsqrtf(s * (1.f / 1024.f) + EPS);
    }
    asm volatile("" ::: "memory");
}
__device__ __forceinline__ float lb_val(const float* lbp, int cf, int li) {
    const float a0 = lbp[cf], a1 = lbp[2048 + cf], a2 = lbp[4096 + cf], a3 = lbp[6144 + cf];
    const float m = fmaxf(fmaxf(a0, a1), fmaxf(a2, a3));
    const float e0 = __expf(a0 - m), e1 = __expf(a1 - m), e2 = __expf(a2 - m), e3 = __expf(a3 - m);
    const float s = (e0 + e1) + (e2 + e3);
    const float num = (li == 1) ? e1 : (e1 + e2 + e3);
    return num / s;
}
namespace pg8 {
#define PG8_LAS __attribute__((address_space(3)))
typedef unsigned short bf16_t;
typedef short bf16x8 __attribute__((ext_vector_type(8)));
typedef float f32x4 __attribute__((ext_vector_type(4)));
typedef unsigned u32x4 __attribute__((ext_vector_type(4)));
constexpr int BM = 256, BK = 64, HALF = 128, HTB = HALF * BK * 2  , STAGE_BYTES = 8 * HTB, NXCD = 8, WGM = 8;

__host__ __device__ __forceinline__ int lds_byte(int r, int c) { const int st = (r >> 4) * 2 + (c >> 5), rr = r & 15, cc = c & 31, ob = rr * 64 + cc * 2; return st * 1024 + (ob ^ (((ob >> 9) & 1) << 5)); }
__host__ __device__ __forceinline__ void stage_rc(int b, int& R, int& C) { const int st = b / 1024, sb = b % 1024, swz = sb ^ (((sb >> 9) & 1) << 5); R = (st >> 1) * 16 + swz / 64; C = (st & 1) * 32 + (swz % 64) / 2; }
__host__ __device__ __forceinline__ int perm32(int rho) { const int n = rho >> 4, i = rho & 15; return 8 * (i >> 2) + 4 * n + (i & 3); }

struct Unit { int pm, pn; };
struct Gemm { const bf16_t* A; const bf16_t* Bt; int M, N, K, lda; };

struct StaticOrder {
    int nM, nN, nwg, G, c;
    __host__ __device__ void init(int M, int N, int G_, int c_) { nM = M / BM; nN = N / BM; nwg = nM * nN; G = G_; c = c_; }
    __host__ __device__ bool next(int i, Unit& u) const {
        const long L = (long)i * G + c; if (L >= nwg) return false;
        int wgid = (int)L; { const int q = nwg / NXCD, r = nwg % NXCD, xcd = wgid % NXCD, off = wgid / NXCD; wgid = (xcd < r ? xcd * (q + 1) : r * (q + 1) + (xcd - r) * q) + off; }
        const int nig = WGM * nN, gid = wgid / nig, fm = gid * WGM, gsz = (nM - fm) < WGM ? (nM - fm) : WGM;
        u.pm = fm + ((wgid % nig) % gsz); u.pn = (wgid % nig) / gsz; return true;
    }
    __device__ __forceinline__ void a_ready(const Unit&) const {}
    __device__ __forceinline__ void done(const Unit&) const {}
};

struct EpiIn {
    static constexpr bool PERM = true, AFTER_DRAIN = false; static constexpr int PID = 1;
    bf16_t* P; const float* ssq; int mode; float qscale; const float* lbp; int li;
    __device__ __forceinline__ void operator()(const f32x4 (&acc)[2][2][4][2], const Unit& u, int wr, int wc, int fr, int fq) const {
        const int row0 = u.pm * BM + wr * 64 + fr; const int col0 = u.pn * BM + wc * 32 + 8 * fq;
        int act = 0; float sc = 1.f;
#ifndef TRIVIAL_EPI
        if (mode == 0) { if (u.pn >= 4 && u.pn < 8) sc = qscale; }
        else { act = (u.pn < 8) ? 1 : ((u.pn < 16) ? 2 : 0); }
#endif
        float lb[2][8];
#pragma unroll
        for (int bj = 0; bj < 2; ++bj)
#pragma unroll
            for (int i = 0; i < 8; ++i) lb[bj][i] = 0.f;
        if (act == 2) {
#pragma unroll
            for (int bj = 0; bj < 2; ++bj)
#pragma unroll
                for (int i = 0; i < 8; ++i) lb[bj][i] = lbp[col0 + bj * HALF + i - 2048];
        }
        float rsv[8]; row_rs8(ssq, row0, fq, rsv);
#pragma unroll
        for (int ai = 0; ai < 2; ++ai)
#pragma unroll
            for (int m = 0; m < 4; ++m) {
                const int row = row0 + ai * HALF + m * 16;
                const float r = rsv[ai * 4 + m] * sc;
                bf16_t* rowp = P + (size_t)row * PP + col0;
#pragma unroll
                for (int bj = 0; bj < 2; ++bj) {
                    float v[8];
#pragma unroll
                    for (int i = 0; i < 4; ++i) { v[i] = acc[ai][bj][m][0][i] * r; v[4 + i] = acc[ai][bj][m][1][i] * r; }
                    if (act == 1) {
#pragma unroll
                        for (int i = 0; i < 8; ++i) v[i] = silu_f(v[i]);
                    } else if (act == 2) {
#pragma unroll
                        for (int i = 0; i < 8; ++i) { const float sg = sigmoid_f(v[i]); v[i] = 0.6931471805599453f * __builtin_amdgcn_logf(lb[bj][i] + (1.f - lb[bj][i]) * sg); }
                    }
                    u32x4 w; w.x = cvtpk(v[0], v[1]); w.y = cvtpk(v[2], v[3]); w.z = cvtpk(v[4], v[5]); w.w = cvtpk(v[6], v[7]);
                    *(u32x4*)(rowp + bj * HALF) = w;
                }
                asm volatile("" ::: "memory");
            }
    }
};
struct EpiGate {
    static constexpr bool PERM = true, AFTER_DRAIN = false; static constexpr int PID = 2;
    bf16_t* Y; const float* ssq; const float* ssd; const float* ssdw; bf16_t* YA; const float* ssqh; const float* hnw;
    __device__ __forceinline__ void operator()(const f32x4 (&acc)[2][2][4][2], const Unit& u, int wr, int wc, int fr, int fq) const {
        const int row0 = u.pm * BM + wr * 64 + fr; const int col0 = u.pn * BM + wc * 32 + 8 * fq;
        float rsv[8]; row_rs8(ssq, row0, fq, rsv);
        f32x4 hw0 = {1.f, 1.f, 1.f, 1.f}, hw1 = hw0;
        if (ssqh) { hw0 = *(const f32x4*)(hnw + wc * 32 + 8 * fq); hw1 = *(const f32x4*)(hnw + wc * 32 + 8 * fq + 4); }
#pragma unroll
        for (int ai = 0; ai < 2; ++ai) {
            float rh[4][2];
#pragma unroll
            for (int m = 0; m < 4; ++m) { rh[m][0] = 1.f; rh[m][1] = 1.f; }
            if (ssqh) {
                f32x4 pr[4];
#pragma unroll
                for (int m = 0; m < 4; ++m) pr[m] = *(const f32x4*)(ssqh + ((size_t)(row0 + ai * HALF + m * 16) * 16 + 2 * u.pn + (fq >> 1)) * 8 + (fq & 1) * 4);
#pragma unroll
                for (int m = 0; m < 4; ++m) {
                    float sq = (pr[m][0] + pr[m][1]) + (pr[m][2] + pr[m][3]);
                    sq += shx<16>(sq);
                    const auto rr = __builtin_amdgcn_permlane32_swap(__float_as_uint(sq), __float_as_uint(sq), false, false);
                    rh[m][0] = rsqrtf(__uint_as_float(rr[0]) * (1.f / 128.f) + EPS); rh[m][1] = rsqrtf(__uint_as_float(rr[1]) * (1.f / 128.f) + EPS);
                }
                asm volatile("" ::: "memory");
            }
            u32x4 ov[4][2];
#pragma unroll
            for (int m = 0; m < 4; ++m)
#pragma unroll
                for (int bj = 0; bj < 2; ++bj) ov[m][bj] = *(const u32x4*)(Y + (size_t)(row0 + ai * HALF + m * 16) * PP + col0 + bj * HALF);
#pragma unroll
            for (int m = 0; m < 4; ++m) {
                const float r = rsv[ai * 4 + m];
                bf16_t* rowp = Y + (size_t)(row0 + ai * HALF + m * 16) * PP + col0;
#pragma unroll
                for (int bj = 0; bj < 2; ++bj) {
                    const u32x4 o = ov[m][bj];
                    float v[8];
#pragma unroll
                    for (int i = 0; i < 4; ++i) { v[i] = silu_f(acc[ai][bj][m][0][i] * r) * (rh[m][bj] * hw0[i]); v[4 + i] = silu_f(acc[ai][bj][m][1][i] * r) * (rh[m][bj] * hw1[i]); }
                    u32x4 w;
                    w.x = cvtpk(v[0] * bflo(o.x), v[1] * bfhi(o.x)); w.y = cvtpk(v[2] * bflo(o.y), v[3] * bfhi(o.y));
                    w.z = cvtpk(v[4] * bflo(o.z), v[5] * bfhi(o.z)); w.w = cvtpk(v[6] * bflo(o.w), v[7] * bfhi(o.w));
                    *(u32x4*)(rowp + bj * HALF) = w;
                }
            }
            asm volatile("" ::: "memory");
        }
        if (ssd) {
            float rsd[8]; row_rs8(ssd, row0, fq, rsd);
#pragma unroll
            for (int bj = 0; bj < 2; ++bj) {
                const f32x4 w0 = *(const f32x4*)(ssdw + col0 + bj * HALF), w1 = *(const f32x4*)(ssdw + col0 + bj * HALF + 4);
                u32x4 yv[8];
#pragma unroll
                for (int i = 0; i < 8; ++i) yv[i] = *(const u32x4*)(YA + (size_t)(row0 + (i >> 2) * HALF + (i & 3) * 16) * PP + col0 + bj * HALF);
#pragma unroll
                for (int i = 0; i < 8; ++i) {
                    const float rr = rsd[i]; u32x4 y = yv[i];
                    y.x = cvtpk(bflo(y.x) * rr * w0[0], bfhi(y.x) * rr * w0[1]); y.y = cvtpk(bflo(y.y) * rr * w0[2], bfhi(y.y) * rr * w0[3]);
                    y.z = cvtpk(bflo(y.z) * rr * w1[0], bfhi(y.z) * rr * w1[1]); y.w = cvtpk(bflo(y.w) * rr * w1[2], bfhi(y.w) * rr * w1[3]);
                    *(u32x4*)(YA + (size_t)(row0 + (i >> 2) * HALF + (i & 3) * 16) * PP + col0 + bj * HALF) = y;
                }
                asm volatile("" ::: "memory");
            }
        }
    }
};
struct EpiOut {
    static constexpr bool PERM = false, AFTER_DRAIN = false; static constexpr int PID = 3;
    const float* hin; float* hout; bf16_t* U; float* ssq;
    __device__ __forceinline__ void operator()(const f32x4 (&acc)[2][2][4][2], const Unit& u, int wr, int wc, int fr, int fq) const {
        const int row0 = u.pm * BM + wr * 64 + fr; const int col0 = u.pn * BM + wc * 32 + 4 * fq;
#pragma unroll
        for (int ai = 0; ai < 2; ++ai)
#pragma unroll
            for (int m = 0; m < 4; ++m) {
                const int row = row0 + ai * HALF + m * 16;
                const size_t off = (size_t)row * DM + col0;
                float s = 0.f;
#pragma unroll
                for (int bj = 0; bj < 2; ++bj)
#pragma unroll
                    for (int n = 0; n < 2; ++n) {
                        const f32x4 hv = *(const f32x4*)(hin + off + bj * HALF + n * 16) + acc[ai][bj][m][n];
                        *(f32x4*)(hout + off + bj * HALF + n * 16) = hv;
                        if (U) { u32x2 w; w.x = cvtpk(hv[0], hv[1]); w.y = cvtpk(hv[2], hv[3]); *(u32x2*)(U + off + bj * HALF + n * 16) = w; }
                        s += (hv[0] * hv[0] + hv[1] * hv[1]) + (hv[2] * hv[2] + hv[3] * hv[3]);
                    }
                s += shx<16>(s); s = sum_x32(s);
                if (fq == 0) ssq[(size_t)row * 16 + u.pn * 4 + wc] = s;
                if (m == 3) asm volatile("" ::: "memory");
            }
    }
};
template <class Epi, class Sched, bool ALIGN_EPI, bool SP2, int KK, int LDA>
__device__ __forceinline__ void gemm_phase(PG8_LAS unsigned char* lds, const Gemm g, const Sched& S, const Epi& E, int tid_arg) {
    int tid = tid_arg; asm volatile("" : "+v"(tid));
    const int wid = __builtin_amdgcn_readfirstlane(tid >> 6), lane = tid & 63, wr = wid >> 2, wc = wid & 3, fr = lane & 15, fq = lane >> 4;
    constexpr int K = KK, nt = K / BK;
    unsigned voffA[2], voffB[2];
#pragma unroll
    for (int i = 0; i < 2; ++i) { int R, C; stage_rc(tid * 16 + i * 8192, R, C); const int Rb = Epi::PERM ? ((R & ~31) + perm32(R & 31)) : R;
        voffA[i] = (unsigned)(R * LDA + C) * 2u; voffB[i] = (unsigned)(Rb * K + C) * 2u; }
    constexpr size_t kstep = (size_t)(BK * 2);
    constexpr size_t hstepA = (size_t)HALF * LDA * 2, hstepB = (size_t)HALF * K * 2;
    constexpr size_t tstepA = 2 * hstepA, tstepB = 2 * hstepB;
    const unsigned ldsw = (unsigned)wid * 1024u;
    const int aoff = lds_byte(wr * 64 + fr, fq * 8), boff = lds_byte(wc * 32 + fr, fq * 8);
#define PG8_SA(b, h) (((b) * 2 + (h)) * HTB)
#define PG8_SB(b, h) ((4 + (b) * 2 + (h)) * HTB)
#define PG8_STAGE(bufoff, gbase, voff) do { _Pragma("unroll") for (int _i = 0; _i < 2; ++_i) \
        __builtin_amdgcn_global_load_lds((const unsigned*)((const char*)(gbase) + (voff)[_i]), (PG8_LAS unsigned*)(lds + (bufoff) + ldsw + _i * 8192), 16, 0, 0); } while (0)
#define PG8_LDA(dst, b, h) do { _Pragma("unroll") for (int m = 0; m < 4; ++m) _Pragma("unroll") for (int k = 0; k < 2; ++k) dst[m][k] = *(const PG8_LAS bf16x8*)(lds + PG8_SA(b, h) + aoff + m * 2048 + k * 1024); } while (0)
#define PG8_LDB(dst, b, h) do { _Pragma("unroll") for (int n = 0; n < 2; ++n) _Pragma("unroll") for (int k = 0; k < 2; ++k) dst[n][k] = *(const PG8_LAS bf16x8*)(lds + PG8_SB(b, h) + boff + n * 2048 + k * 1024); } while (0)
#define PG8_MMA(ai, bj, At, Bt) do { __builtin_amdgcn_s_setprio(1); _Pragma("unroll") for (int m = 0; m < 4; ++m) _Pragma("unroll") for (int n = 0; n < 2; ++n) _Pragma("unroll") for (int k = 0; k < 2; ++k) \
        acc[ai][bj][m][n] = __builtin_amdgcn_mfma_f32_16x16x32_bf16(Bt[n][k], At[m][k], acc[ai][bj][m][n], 0, 0, 0); __builtin_amdgcn_s_setprio(0); } while (0)
#define PG8_WAIT_V(n) asm volatile("s_waitcnt vmcnt(" #n ")" ::: "memory")
#define PG8_WAIT_L(n) asm volatile("s_waitcnt lgkmcnt(" #n ")" ::: "memory")
#define PG8_BAR __builtin_amdgcn_s_barrier()
#define PG8_SCHED __builtin_amdgcn_sched_barrier(0)
    Unit cur, nxt; int ui = 0;
    if (!S.next(0, cur)) return;
    f32x4 acc[2][2][4][2];
#pragma unroll
    for (int a = 0; a < 2; ++a)
#pragma unroll
        for (int b = 0; b < 2; ++b)
#pragma unroll
            for (int m = 0; m < 4; ++m)
#pragma unroll
                for (int n = 0; n < 2; ++n) acc[a][b][m][n] = (f32x4){0.f, 0.f, 0.f, 0.f};
    bf16x8 At[4][2], B0[2][2], B1[2][2];
    const char* cA = (const char*)g.A + (size_t)cur.pm * tstepA; const char* cB = (const char*)g.Bt + (size_t)cur.pn * tstepB;
    S.a_ready(cur);
    if constexpr (SP2) {
        PG8_STAGE(PG8_SB(0, 0), cB, voffB); PG8_STAGE(PG8_SB(0, 1), cB + hstepB, voffB); PG8_STAGE(PG8_SA(0, 0), cA, voffA); PG8_STAGE(PG8_SA(0, 1), cA + hstepA, voffA);
        if (wr == 1) PG8_BAR;
        PG8_WAIT_V(2); PG8_BAR;
        PG8_STAGE(PG8_SB(1, 0), cB + kstep, voffB); PG8_STAGE(PG8_SA(1, 0), cA + kstep, voffA); PG8_STAGE(PG8_SB(1, 1), cB + hstepB + kstep, voffB);
        PG8_WAIT_V(6); PG8_BAR;
    } else {
        PG8_STAGE(PG8_SB(0, 0), cB, voffB); PG8_STAGE(PG8_SA(0, 0), cA, voffA); PG8_STAGE(PG8_SB(0, 1), cB + hstepB, voffB); PG8_STAGE(PG8_SA(0, 1), cA + hstepA, voffA);
        if (wr == 1) PG8_BAR;
        PG8_WAIT_V(4); PG8_BAR;
        PG8_STAGE(PG8_SB(1, 0), cB + kstep, voffB); PG8_STAGE(PG8_SA(1, 0), cA + kstep, voffA); PG8_STAGE(PG8_SB(1, 1), cB + hstepB + kstep, voffB);
        PG8_WAIT_V(6); PG8_BAR;
    }
    for (;;) {
        const bool has_next = S.next(ui + 1, nxt);
        const char* nA = has_next ? (const char*)g.A + (size_t)nxt.pm * tstepA : cA; const char* nB = has_next ? (const char*)g.Bt + (size_t)nxt.pn * tstepB : cB;
        for (int t = 0; t < nt; t += 2) {
            const bool last = (t == nt - 2);
            const char* a1 = cA + (size_t)(t + 1) * kstep;
            const char* a2 = last ? nA : cA + (size_t)(t + 2) * kstep; const char* b2 = last ? nB : cB + (size_t)(t + 2) * kstep;
            const char* a3 = a2 + kstep; const char* b3 = b2 + kstep;
            if (last && has_next) S.a_ready(nxt);
            if constexpr (SP2) {
            PG8_LDB(B0, 0, 0); PG8_LDB(B1, 0, 1); PG8_SCHED; PG8_LDA(At, 0, 0); PG8_STAGE(PG8_SA(1, 1), a1 + hstepA, voffA);
            PG8_WAIT_V(8); PG8_WAIT_L(0); PG8_BAR; PG8_MMA(0, 0, At, B0); PG8_MMA(0, 1, At, B1); PG8_BAR; PG8_SCHED;
            PG8_LDA(At, 0, 1); PG8_STAGE(PG8_SB(0, 0), b2, voffB); PG8_STAGE(PG8_SB(0, 1), b2 + hstepB, voffB); PG8_STAGE(PG8_SA(0, 0), a2, voffA);
            PG8_WAIT_V(8); PG8_WAIT_L(0); PG8_BAR; PG8_MMA(1, 0, At, B0); PG8_MMA(1, 1, At, B1); PG8_BAR; PG8_SCHED;
            PG8_LDB(B0, 1, 0); PG8_LDB(B1, 1, 1); PG8_SCHED; PG8_LDA(At, 1, 0); PG8_STAGE(PG8_SA(0, 1), a2 + hstepA, voffA);
            PG8_WAIT_V(8); PG8_WAIT_L(0); PG8_BAR; PG8_MMA(0, 0, At, B0); PG8_MMA(0, 1, At, B1); PG8_BAR; PG8_SCHED;
            PG8_LDA(At, 1, 1); PG8_STAGE(PG8_SB(1, 0), b3, voffB); PG8_STAGE(PG8_SB(1, 1), b3 + hstepB, voffB); PG8_STAGE(PG8_SA(1, 0), a3, voffA);
            PG8_WAIT_V(8); PG8_WAIT_L(0); PG8_BAR; PG8_MMA(1, 0, At, B0); PG8_MMA(1, 1, At, B1); PG8_BAR; PG8_SCHED;
            } else {
            PG8_LDB(B0, 0, 0); PG8_SCHED; PG8_LDA(At, 0, 0); PG8_STAGE(PG8_SA(1, 1), a1 + hstepA, voffA);
            PG8_WAIT_L(8); PG8_BAR; PG8_WAIT_L(0); PG8_MMA(0, 0, At, B0); PG8_BAR; PG8_SCHED;
            PG8_LDB(B1, 0, 1); PG8_STAGE(PG8_SB(0, 0), b2, voffB);
            PG8_BAR; PG8_WAIT_L(0); PG8_MMA(0, 1, At, B1); PG8_BAR;
            PG8_LDA(At, 0, 1); PG8_STAGE(PG8_SA(0, 0), a2, voffA);
            PG8_BAR; PG8_WAIT_L(0); PG8_MMA(1, 0, At, B0); PG8_BAR; PG8_SCHED;
            PG8_STAGE(PG8_SB(0, 1), b2 + hstepB, voffB);
            PG8_WAIT_V(6); PG8_BAR; PG8_MMA(1, 1, At, B1); PG8_BAR;
            PG8_LDB(B0, 1, 0); PG8_SCHED; PG8_LDA(At, 1, 0); PG8_STAGE(PG8_SA(0, 1), a2 + hstepA, voffA);
            PG8_WAIT_L(8); PG8_BAR; PG8_WAIT_L(0); PG8_MMA(0, 0, At, B0); PG8_BAR; PG8_SCHED;
            PG8_LDB(B1, 1, 1); PG8_STAGE(PG8_SB(1, 0), b3, voffB);
            PG8_BAR; PG8_WAIT_L(0); PG8_MMA(0, 1, At, B1); PG8_BAR;
            PG8_LDA(At, 1, 1); PG8_STAGE(PG8_SA(1, 0), a3, voffA);
            PG8_BAR; PG8_WAIT_L(0); PG8_MMA(1, 0, At, B0); PG8_BAR; PG8_SCHED;
            PG8_STAGE(PG8_SB(1, 1), b3 + hstepB, voffB);
            PG8_WAIT_V(6); PG8_BAR; PG8_MMA(1, 1, At, B1); PG8_BAR;
            }
        }
        if constexpr (ALIGN_EPI) { if (wr == 0) PG8_BAR; }
        if constexpr (!Epi::AFTER_DRAIN) { unsigned long long _ptE = 0ull; if (Epi::PID == PROBE_SECV && blockIdx.x == 0 && wid == 0) _ptE = __builtin_amdgcn_s_memrealtime(); E(acc, cur, wr, wc, fr, fq); if (Epi::PID == PROBE_SECV && blockIdx.x == 0 && wid == 0) { volatile unsigned long long* _a = (volatile unsigned long long*)((unsigned char*)lds + 147456 - 128); *_a = *_a + (__builtin_amdgcn_s_memrealtime() - _ptE); } S.done(cur); }
        if (!has_next) break;
#pragma unroll
        for (int a = 0; a < 2; ++a)
#pragma unroll
            for (int b = 0; b < 2; ++b)
#pragma unroll
                for (int m = 0; m < 4; ++m)
#pragma unroll
                    for (int n = 0; n < 2; ++n) acc[a][b][m][n] = (f32x4){0.f, 0.f, 0.f, 0.f};
        cur = nxt; cA = nA; cB = nB; ++ui;
        if constexpr (ALIGN_EPI) { if (wr == 1) PG8_BAR; }
    }
    PG8_WAIT_V(0);
    if constexpr (!ALIGN_EPI) { if (wr == 0) PG8_BAR; }
    PG8_BAR;
    if constexpr (Epi::AFTER_DRAIN) { E.fused(acc, cur, wr, wc, fr, fq, lds, wid, lane); S.done(cur); }
#undef PG8_SA
#undef PG8_SB
#undef PG8_STAGE
#undef PG8_LDA
#undef PG8_LDB
#undef PG8_MMA
#undef PG8_WAIT_V
#undef PG8_WAIT_L
#undef PG8_BAR
#undef PG8_SCHED
}
}

constexpr size_t MiB = 1u << 20;
constexpr size_t WS_P = 0;
constexpr size_t WS_U = 384 * MiB;
constexpr size_t WS_WE_IN = 448 * MiB, WS_WE_G = 460 * MiB, WS_WE_OUT = 462 * MiB, WS_WE_DT = 466 * MiB;
constexpr size_t WS_WO_IN = 468 * MiB, WS_WO_G = 480 * MiB, WS_WO_OUT = 484 * MiB;
constexpr size_t WS_DT = 488 * MiB;
constexpr size_t WS_SSQ = 490 * MiB;
constexpr size_t WS_SSD = 492 * MiB;
constexpr size_t WS_BAR = 494 * MiB;
constexpr size_t WS_BAR_BYTES = 65536;
constexpr size_t WS_LB = 494 * MiB + 65536;
constexpr size_t WS_SSQH = 495 * MiB;
constexpr size_t WS_END = 511 * MiB;
constexpr int LDS_BYTES = 147456;
#ifndef PG8SP2
#define PG8SP2 true
#endif

struct Params {
    const float *x, *norm_w, *final_norm_w, *rel_bias, *even_w_in, *even_w_out, *conv_w, *conv_b, *dt_bias, *A_log, *D_skip, *ssd_norm_w,
        *lq1, *lk1, *lq2, *lk2, *subln_w, *odd_w_in, *odd_w_out, *hgrn_lb, *hgrn_norm_w;
    float* out; unsigned char* ws;
};

typedef const __attribute__((address_space(4))) Params* PPtr;
__device__ __forceinline__ PPtr get_params() { const __attribute__((address_space(4))) void* k = (const __attribute__((address_space(4))) void*)__builtin_amdgcn_kernarg_segment_ptr(); asm volatile("" : "+s"(k)); return (PPtr)k; }
struct Seg { const float* W; int ldw, col0, ncols, K; bf16_t* WT; int row0; const float* scale; };
__device__ __forceinline__ void convert_seg(const Seg s, float* scr, int gw, int NGW, int lane) {
    const int nblk = (s.ncols + 31) / 32, nitems = (s.K / 64) * nblk;
    for (int it = gw; it < nitems; it += NGW) {
        const int kb = it / nblk, nb = it % nblk, k0 = 64 * kb, n0 = 32 * nb;
        const int nc = lane & 31; const bool okc = (n0 + nc) < s.ncols;
        float wv[32];
#pragma unroll
        for (int i = 0; i < 32; ++i) { const int kk = 2 * i + (lane >> 5); wv[i] = okc ? s.W[(size_t)(k0 + kk) * s.ldw + s.col0 + n0 + nc] : 0.f; }
        if (s.scale) {
#pragma unroll
            for (int i = 0; i < 32; ++i) wv[i] *= s.scale[k0 + 2 * i + (lane >> 5)];
        }
#pragma unroll
        for (int i = 0; i < 32; ++i) scr[(2 * i + (lane >> 5)) * 33 + nc] = wv[i];
        __builtin_amdgcn_fence(__ATOMIC_RELEASE, "workgroup"); __builtin_amdgcn_wave_barrier();
        const int c = lane & 7;
#pragma unroll
        for (int j = 0; j < 4; ++j) {
            const int n = (lane >> 3) + 8 * j; const float* sp = scr + (8 * c) * 33 + n;
            u32x4 o; o.x = cvtpk(sp[0 * 33], sp[1 * 33]); o.y = cvtpk(sp[2 * 33], sp[3 * 33]); o.z = cvtpk(sp[4 * 33], sp[5 * 33]); o.w = cvtpk(sp[6 * 33], sp[7 * 33]);
            if (n0 + n < s.ncols) *(u32x4*)(s.WT + (size_t)(s.row0 + n0 + n) * s.K + k0 + 8 * c) = o;
        }
        __builtin_amdgcn_fence(__ATOMIC_RELEASE, "workgroup"); __builtin_amdgcn_wave_barrier();
    }
}
__device__ __forceinline__ void convert_layer(PPtr p, int layer, float* scr, int gw, int NGW, int lane) {
    const float* nw = p->norm_w + (size_t)layer * DM;
    if ((layer & 1) == 0) {
        const int e = layer >> 1;
        const float* Wi = p->even_w_in + (size_t)e * DM * 7184; const float* Wo = p->even_w_out + (size_t)e * 2048 * DM;
        bf16_t* WIN = (bf16_t*)(p->ws + WS_WE_IN);
        convert_seg(Seg{Wi, 7184, 0, 1024, DM, WIN, 0, nw}, scr, gw, NGW, lane);
        convert_seg(Seg{Wi, 7184, 3088, 1024, DM, WIN, 1024, nw}, scr, gw, NGW, lane);
        convert_seg(Seg{Wi, 7184, 1024, 2048, DM, WIN, 2048, nw}, scr, gw, NGW, lane);
        convert_seg(Seg{Wi, 7184, 4112, 2048, DM, WIN, 4096, nw}, scr, gw, NGW, lane);
        convert_seg(Seg{Wi, 7184, 6160, 1024, DM, (bf16_t*)(p->ws + WS_WE_G), 0, nw}, scr, gw, NGW, lane);
        convert_seg(Seg{Wi, 7184, 3072, 16, DM, (bf16_t*)(p->ws + WS_WE_DT), 0, nw}, scr, gw, NGW, lane);
        convert_seg(Seg{Wo, DM, 0, 1024, 2048, (bf16_t*)(p->ws + WS_WE_OUT), 0, nullptr}, scr, gw, NGW, lane);
    } else {
        const int o = layer >> 1;
        const float* Wi = p->odd_w_in + (size_t)o * DM * 8192; const float* Wo = p->odd_w_out + (size_t)o * 2048 * DM;
        convert_seg(Seg{Wi, 8192, 0, 6144, DM, (bf16_t*)(p->ws + WS_WO_IN), 0, nw}, scr, gw, NGW, lane);
        convert_seg(Seg{Wi, 8192, 6144, 2048, DM, (bf16_t*)(p->ws + WS_WO_G), 0, nw}, scr, gw, NGW, lane);
        convert_seg(Seg{Wo, DM, 0, 1024, 2048, (bf16_t*)(p->ws + WS_WO_OUT), 0, nullptr}, scr, gw, NGW, lane);
    }
}

__device__ __forceinline__ void dt_items(PPtr p, int e, int gw, int NGW, int lane) {
    const bf16_t* U = (const bf16_t*)(p->ws + WS_U); const bf16_t* Wdt = (const bf16_t*)(p->ws + WS_WE_DT);
    const float* ssq = (const float*)(p->ws + WS_SSQ); float* dt = (float*)(p->ws + WS_DT);
    const int fr = lane & 15, fq = lane >> 4;
    for (int item = gw; item < T_TOK / 16; item += NGW) {
        const int row0 = item * 16;
        f32x4 acc = {0.f, 0.f, 0.f, 0.f};
        const bf16x8* ap = (const bf16x8*)(U + (size_t)(row0 + fr) * DM + fq * 8);
        const bf16x8* bp = (const bf16x8*)(Wdt + (size_t)fr * DM + fq * 8);
#pragma unroll 8
        for (int s = 0; s < 32; ++s) acc = __builtin_amdgcn_mfma_f32_16x16x32_bf16(ap[s * 4], bp[s * 4], acc, 0, 0, 0);
        const float bias = p->dt_bias[e * 16 + fr];
#pragma unroll
        for (int i = 0; i < 4; ++i) {
            const int row = row0 + 4 * fq + i;
            const float v = acc[i] * row_rs(ssq, row) + bias;
            dt[(size_t)row * 16 + fr] = (v > 20.f) ? v : log1pf(__expf(v));
        }
    }
}

typedef short v4i16_t __attribute__((ext_vector_type(4)));
__device__ __forceinline__ s16x4 vtr(const bf16_t* ptr) { return __builtin_bit_cast(s16x4, __builtin_amdgcn_ds_read_tr16_b64_v4i16((LAS v4i16_t*)ptr)); }
__device__ __forceinline__ void ssd_unit(PPtr p, int e, int b, int h, unsigned char* lds, int tid) {
    float* sx = (float*)lds;
    float* sB = sx + 16 * 64;
    float* sC = sB + 16 * 128;
    float* sy = sC + 16 * 128;
    float* sdt = sy + 16 * 64;
    float* sda = sdt + 16;
    bf16_t* P = (bf16_t*)(p->ws + WS_P);
    const float* dt = (const float*)(p->ws + WS_DT); float* ssd = (float*)(p->ws + WS_SSD);
    const float* cw = p->conv_w + (size_t)e * 4 * 2048; const float* cb = p->conv_b + (size_t)e * 2048;
    const float Ah = -__expf(p->A_log[e * 16 + h]), Dh = p->D_skip[e * 16 + h];
    const int g = h >> 2, pp = tid >> 3, nq = tid & 7;
    const size_t rowb = (size_t)b * SEQ;
    float st[16];
#pragma unroll
    for (int i = 0; i < 16; ++i) st[i] = 0.f;
    for (int c = 0; c < SEQ / 16; ++c) {
        const int t0 = c * 16;
        for (int it = tid; it < 1280; it += 512) {
            const int t = it / 80, q4 = it % 80;
            int ch; float* dst;
            if (q4 < 16) { ch = h * 64 + q4 * 4; dst = sx + t * 64 + q4 * 4; }
            else if (q4 < 48) { ch = 1024 + g * 128 + (q4 - 16) * 4; dst = sB + t * 128 + (q4 - 16) * 4; }
            else { ch = 1536 + g * 128 + (q4 - 48) * 4; dst = sC + t * 128 + (q4 - 48) * 4; }
            f32x4 a = *(const f32x4*)(cb + ch);
#pragma unroll
            for (int j = 0; j < 4; ++j) {
                const int tt = t0 + t - 3 + j;
                if (tt >= 0) {
                    const u32x2 raw = *(const u32x2*)(P + (rowb + tt) * PP + 2048 + ch);
                    const f32x4 w = *(const f32x4*)(cw + j * 2048 + ch);
                    a[0] += w[0] * bflo(raw.x); a[1] += w[1] * bfhi(raw.x); a[2] += w[2] * bflo(raw.y); a[3] += w[3] * bfhi(raw.y);
                }
            }
            f32x4 o; o[0] = silu_f(a[0]); o[1] = silu_f(a[1]); o[2] = silu_f(a[2]); o[3] = silu_f(a[3]);
            *(f32x4*)dst = o;
        }
        if (tid < 16) { const float d = dt[(rowb + t0 + tid) * 16 + h]; sdt[tid] = d; sda[tid] = __expf(d * Ah); }
        __syncthreads();
        for (int t = 0; t < 16; ++t) {
            const float xv = sx[t * 64 + pp]; const float X = xv * sdt[t], da = sda[t];
            float y = 0.f;
#pragma unroll
            for (int i4 = 0; i4 < 4; ++i4) {
                const f32x4 bv = *(const f32x4*)(sB + t * 128 + nq * 16 + i4 * 4), cv = *(const f32x4*)(sC + t * 128 + nq * 16 + i4 * 4);
#pragma unroll
                for (int i = 0; i < 4; ++i) { st[i4 * 4 + i] = da * st[i4 * 4 + i] + X * bv[i]; y += cv[i] * st[i4 * 4 + i]; }
            }
            y += shx<1>(y); y += shx<2>(y); y += shx<4>(y);
            if (nq == 0) sy[t * 64 + pp] = y + Dh * xv;
        }
        __syncthreads();
        {
            const int t = tid >> 5, p2 = (tid & 31) * 2;
            bf16_t* zp = P + (rowb + t0 + t) * PP + h * 64 + p2;
            const unsigned zw = *(const unsigned*)zp;
            const float g0 = sy[t * 64 + p2] * silu_f(bflo(zw)), g1 = sy[t * 64 + p2 + 1] * silu_f(bfhi(zw));
            float ss = g0 * g0 + g1 * g1;
            ss += shx<1>(ss); ss += shx<2>(ss); ss += shx<4>(ss); ss += shx<8>(ss); ss += shx<16>(ss);
            *(unsigned*)zp = cvtpk(g0, g1);
            if ((tid & 31) == 0) ssd[(rowb + t0 + t) * 16 + h] = ss;
        }
    }
    __syncthreads();
}

__device__ __forceinline__ bf16x8 scale_frag(s16x4 lo, s16x4 hi, const f32x4 w0, const f32x4 w1) {
    u32x4 o;
    o.x = cvtpk(__uint_as_float((unsigned)(unsigned short)lo[0] << 16) * w0[0], __uint_as_float((unsigned)(unsigned short)lo[1] << 16) * w0[1]);
    o.y = cvtpk(__uint_as_float((unsigned)(unsigned short)lo[2] << 16) * w0[2], __uint_as_float((unsigned)(unsigned short)lo[3] << 16) * w0[3]);
    o.z = cvtpk(__uint_as_float((unsigned)(unsigned short)hi[0] << 16) * w1[0], __uint_as_float((unsigned)(unsigned short)hi[1] << 16) * w1[1]);
    o.w = cvtpk(__uint_as_float((unsigned)(unsigned short)hi[2] << 16) * w1[2], __uint_as_float((unsigned)(unsigned short)hi[3] << 16) * w1[3]);
    return __builtin_bit_cast(bf16x8, o);
}
template <int NR> __device__ __forceinline__ void ssd_stage_rows(const bf16_t* P, size_t rowb, int t0, int lrow0, int ch, bf16_t* dst, int dstr, const float* cw, const float* cb) {
    float wt[4][8], bias[8];
#pragma unroll
    for (int j = 0; j < 4; ++j) { const f32x4 a = *(const f32x4*)(cw + j * 2048 + ch), bq = *(const f32x4*)(cw + j * 2048 + ch + 4);
        wt[j][0] = a[0]; wt[j][1] = a[1]; wt[j][2] = a[2]; wt[j][3] = a[3]; wt[j][4] = bq[0]; wt[j][5] = bq[1]; wt[j][6] = bq[2]; wt[j][7] = bq[3]; }
    { const f32x4 a = *(const f32x4*)(cb + ch), bq = *(const f32x4*)(cb + ch + 4); bias[0] = a[0]; bias[1] = a[1]; bias[2] = a[2]; bias[3] = a[3]; bias[4] = bq[0]; bias[5] = bq[1]; bias[6] = bq[2]; bias[7] = bq[3]; }
    const int r0 = t0 + lrow0;
    u32x4 raw[NR + 3];
#pragma unroll
    for (int k = 0; k < NR + 3; ++k) {
        const int tt = r0 - 3 + k;
        raw[k] = (tt >= 0) ? *(const u32x4*)(P + (rowb + tt) * PP + 2048 + ch) : (u32x4){0u, 0u, 0u, 0u};
    }
#pragma unroll
    for (int k = 0; k < NR; ++k) {
        float acc[8];
#pragma unroll
        for (int q = 0; q < 8; ++q) acc[q] = bias[q];
#pragma unroll
        for (int j = 0; j < 4; ++j) {
            const u32x4 rw = raw[k + j];
            acc[0] += wt[j][0] * bflo(rw.x); acc[1] += wt[j][1] * bfhi(rw.x); acc[2] += wt[j][2] * bflo(rw.y); acc[3] += wt[j][3] * bfhi(rw.y);
            acc[4] += wt[j][4] * bflo(rw.z); acc[5] += wt[j][5] * bfhi(rw.z); acc[6] += wt[j][6] * bflo(rw.w); acc[7] += wt[j][7] * bfhi(rw.w);
        }
        u32x4 o; o.x = cvtpk(silu_f(acc[0]), silu_f(acc[1])); o.y = cvtpk(silu_f(acc[2]), silu_f(acc[3])); o.z = cvtpk(silu_f(acc[4]), silu_f(acc[5])); o.w = cvtpk(silu_f(acc[6]), silu_f(acc[7]));
        *(u32x4*)(dst + (lrow0 + k) * dstr) = o;
    }
}
__device__ __forceinline__ void ssd_unit_mfma(PPtr p, int e, int b, int h, unsigned char* lds, int tid) {
    constexpr int CS = 136, BS = 144, XS = 72, SS = 136;
    bf16_t* sC = (bf16_t*)lds;
    bf16_t* sB = sC + 128 * CS;
    bf16_t* sX = sB + 128 * BS;
    bf16_t* sSt = sX + 128 * XS;
    float* sAcs = (float*)(sSt + 2 * 64 * SS);
    float* sDt = sAcs + 128;
    float* sW = sDt + 128;
    float* sDec = sW + 128;
    bf16_t* P = (bf16_t*)(p->ws + WS_P);
    const float* dt = (const float*)(p->ws + WS_DT); float* ssd = (float*)(p->ws + WS_SSD);
    const float* cw = p->conv_w + (size_t)e * 4 * 2048; const float* cb = p->conv_b + (size_t)e * 2048;
    const float Ah = -__expf(p->A_log[e * 16 + h]), Dh = p->D_skip[e * 16 + h];
    const int lane = tid & 63, w = __builtin_amdgcn_readfirstlane(tid >> 6), c16 = lane & 15, g = lane >> 4, tq = c16 >> 2, tp = c16 & 3;
    const int grp = h >> 2;
    const size_t rowb = (size_t)b * SEQ;
    f32x4 stacc[4];
#pragma unroll
    for (int pt = 0; pt < 4; ++pt) stacc[pt] = (f32x4){0.f, 0.f, 0.f, 0.f};
    for (int i = tid; i < 64 * SS / 2; i += 512) ((unsigned*)sSt)[i] = 0u;
    for (int c = 0; c < SEQ / 128; ++c) {
        const int cur = c & 1, nxt = cur ^ 1;
        const int t0 = c * 128;
        PSEC_B(4)
        {
            { const int it = tid; const int cg8 = it % 40, seg = it / 40;
              int ch; bf16_t* dst; int dstr;
              if (cg8 < 8) { ch = h * 64 + cg8 * 8; dst = sX + cg8 * 8; dstr = XS; }
              else if (cg8 < 24) { ch = 1024 + grp * 128 + (cg8 - 8) * 8; dst = sB + (cg8 - 8) * 8; dstr = BS; }
              else { ch = 1536 + grp * 128 + (cg8 - 24) * 8; dst = sC + (cg8 - 24) * 8; dstr = CS; }
              ssd_stage_rows<8>(P, rowb, t0, seg * 8, ch, dst, dstr, cw, cb); }
            { const int it = 512 + (tid >> 2); const int cg8 = it % 40, seg = it / 40;
              int ch; bf16_t* dst; int dstr;
              if (cg8 < 8) { ch = h * 64 + cg8 * 8; dst = sX + cg8 * 8; dstr = XS; }
              else if (cg8 < 24) { ch = 1024 + grp * 128 + (cg8 - 8) * 8; dst = sB + (cg8 - 8) * 8; dstr = BS; }
              else { ch = 1536 + grp * 128 + (cg8 - 24) * 8; dst = sC + (cg8 - 24) * 8; dstr = CS; }
              ssd_stage_rows<2>(P, rowb, t0, seg * 8 + 2 * (tid & 3), ch, dst, dstr, cw, cb); }
        }
        if (w == 0) {
            const float d0 = dt[(rowb + t0 + 2 * lane) * 16 + h], d1 = dt[(rowb + t0 + 2 * lane + 1) * 16 + h];
            const float a0 = d0 * Ah, a1 = d1 * Ah;
            float sc = a0 + a1;
#pragma unroll
            for (int o = 1; o < 64; o <<= 1) { const float t = bperm(lane - o, sc); if (lane >= o) sc += t; }
            const float acs1 = sc, acs0 = sc - a1;
            const float alast = bperm(63, sc);
            sAcs[2 * lane] = acs0; sAcs[2 * lane + 1] = acs1; sDt[2 * lane] = d0; sDt[2 * lane + 1] = d1;
            sW[2 * lane] = d0 * __expf(alast - acs0); sW[2 * lane + 1] = d1 * __expf(alast - acs1);
            sDec[2 * lane] = __expf(acs0); sDec[2 * lane + 1] = __expf(acs1);
        }
        __syncthreads();
        PSEC_E(4, lds) PSEC_B(5)
        {
            const int lrow = 16 * w + c16;
            bf16_t zr[4][4];
#pragma unroll
            for (int pt = 0; pt < 4; ++pt)
#pragma unroll
                for (int j = 0; j < 4; ++j) zr[pt][j] = P[(rowb + t0 + 16 * w + 4 * g + j) * PP + h * 64 + 16 * pt + c16];
            bf16x8 cf[4];
#pragma unroll
            for (int ks = 0; ks < 4; ++ks) cf[ks] = *(const bf16x8*)(sC + lrow * CS + 32 * ks + 8 * g);
            f32x4 acc[4];
#pragma unroll
            for (int pt = 0; pt < 4; ++pt) {
                f32x4 a = {0.f, 0.f, 0.f, 0.f};
#pragma unroll
                for (int ks = 0; ks < 4; ++ks) {
                    const bf16x8 sf = *(const bf16x8*)(sSt + (cur * 64 + 16 * pt + c16) * SS + 32 * ks + 8 * g);
                    a = __builtin_amdgcn_mfma_f32_16x16x32_bf16(cf[ks], sf, a, 0, 0, 0);
                }
                acc[pt] = a;
            }
            {
                const f32x4 dl = *(const f32x4*)(sDec + 16 * w + 4 * g);
#pragma unroll
                for (int pt = 0; pt < 4; ++pt) { acc[pt][0] *= dl[0]; acc[pt][1] *= dl[1]; acc[pt][2] *= dl[2]; acc[pt][3] *= dl[3]; }
            }
            const float al = sAcs[lrow];
#pragma unroll
            for (int kp = 0; kp < 4; ++kp) {
                if (2 * kp <= w) {
                    u32x4 pk = {0u, 0u, 0u, 0u};
#pragma unroll
                    for (int hf = 0; hf < 2; ++hf) {
                        const int st = 2 * kp + hf;
                        if (st <= w) {
                            f32x4 a = {0.f, 0.f, 0.f, 0.f};
#pragma unroll
                            for (int ks = 0; ks < 4; ++ks) {
                                const bf16x8 bf = *(const bf16x8*)(sB + (16 * st + c16) * BS + 32 * ks + 8 * g);
                                a = __builtin_amdgcn_mfma_f32_16x16x32_bf16(bf, cf[ks], a, 0, 0, 0);
                            }
                            const f32x4 as = *(const f32x4*)(sAcs + 16 * st + 4 * g), ds = *(const f32x4*)(sDt + 16 * st + 4 * g);
                            float v[4];
#pragma unroll
                            for (int j = 0; j < 4; ++j) {
                                const int srow = 16 * st + 4 * g + j;
                                v[j] = (srow <= lrow) ? a[j] * __expf(al - as[j]) * ds[j] : 0.f;
                            }
                            if (hf == 0) { pk.x = cvtpk(v[0], v[1]); pk.y = cvtpk(v[2], v[3]); } else { pk.z = cvtpk(v[0], v[1]); pk.w = cvtpk(v[2], v[3]); }
                        }
                    }
                    const bf16x8 pa = __builtin_bit_cast(bf16x8, pk);
#pragma unroll
                    for (int pt = 0; pt < 4; ++pt) {
                        const s16x4 lo = vtr(sX + (32 * kp + 4 * g + tq) * XS + 16 * pt + 4 * tp);
                        const s16x4 hi = vtr(sX + (32 * kp + 16 + 4 * g + tq) * XS + 16 * pt + 4 * tp);
                        const bf16x8 xf = {lo[0], lo[1], lo[2], lo[3], hi[0], hi[1], hi[2], hi[3]};
                        acc[pt] = __builtin_amdgcn_mfma_f32_16x16x32_bf16(pa, xf, acc[pt], 0, 0, 0);
                    }
                }
            }
#pragma unroll
            for (int j = 0; j < 4; ++j) {
                const int lr = 16 * w + 4 * g + j;
                float ss = 0.f;
#pragma unroll
                for (int pt = 0; pt < 4; ++pt) {
                    const float xv = __uint_as_float((unsigned)sX[lr * XS + 16 * pt + c16] << 16);
                    const float zv = __uint_as_float((unsigned)zr[pt][j] << 16);
                    const float yg = (acc[pt][j] + Dh * xv) * silu_f(zv);
                    ss += yg * yg;
                    P[(rowb + t0 + lr) * PP + h * 64 + 16 * pt + c16] = (bf16_t)(cvtpk(yg, 0.f) & 0xffffu);
                }
                ss += shx<1>(ss); ss += shx<2>(ss); ss += shx<4>(ss); ss += shx<8>(ss);
                if (c16 == 0) ssd[(rowb + t0 + lr) * 16 + h] = ss;
            }
        }
        PSEC_E(5, lds) PSEC_B(6)
        {
            const float dlast = sDec[127];
#pragma unroll
            for (int pt = 0; pt < 4; ++pt) { stacc[pt][0] *= dlast; stacc[pt][1] *= dlast; stacc[pt][2] *= dlast; stacc[pt][3] *= dlast; }
#pragma unroll
            for (int ks = 0; ks < 4; ++ks) {
                const s16x4 blo = vtr(sB + (32 * ks + 8 * g + tq) * BS + 16 * w + 4 * tp);
                const s16x4 bhi = vtr(sB + (32 * ks + 8 * g + 4 + tq) * BS + 16 * w + 4 * tp);
                const bf16x8 bfr = {blo[0], blo[1], blo[2], blo[3], bhi[0], bhi[1], bhi[2], bhi[3]};
                const f32x4 w0 = *(const f32x4*)(sW + 32 * ks + 8 * g), w1 = *(const f32x4*)(sW + 32 * ks + 8 * g + 4);
#pragma unroll
                for (int pt = 0; pt < 4; ++pt) {
                    const s16x4 xlo = vtr(sX + (32 * ks + 8 * g + tq) * XS + 16 * pt + 4 * tp);
                    const s16x4 xhi = vtr(sX + (32 * ks + 8 * g + 4 + tq) * XS + 16 * pt + 4 * tp);
                    stacc[pt] = __builtin_amdgcn_mfma_f32_16x16x32_bf16(scale_frag(xlo, xhi, w0, w1), bfr, stacc[pt], 0, 0, 0);
                }
            }
#pragma unroll
            for (int pt = 0; pt < 4; ++pt)
#pragma unroll
                for (int j = 0; j < 4; ++j) sSt[(nxt * 64 + 16 * pt + 4 * g + j) * SS + 16 * w + c16] = (bf16_t)(cvtpk(stacc[pt][j], 0.f) & 0xffffu);
        }
        __syncthreads();
        PSEC_E(6, lds)
    }
}

__device__ __forceinline__ void hgrn_unit(PPtr p, int oi, int b, int h, unsigned char* lds, int tid) {
    float* sq = (float*)lds;
    float* sf = sq + 2048; float* sk = sf + 2048; float* sv = sk + 2048;
    float* so = sv + 2048;
    bf16_t* P = (bf16_t*)(p->ws + WS_P);
    const size_t rowb = (size_t)b * SEQ;
    const int v = tid & 127, dq = tid >> 7;
    const int st_t = tid >> 5, st_d = (tid & 31) * 4;
    const f32x4 nw = *(const f32x4*)(p->hgrn_norm_w + oi * 128 + st_d);
    float S[32];
#pragma unroll
    for (int i = 0; i < 32; ++i) S[i] = 0.f;
    const bf16_t* src = P + (rowb + st_t) * PP + h * 128 + st_d;
    u32x2 rq = *(const u32x2*)(src), rf = *(const u32x2*)(src + 2048), rv = *(const u32x2*)(src + 4096);
    for (int c = 0; c < SEQ / 16; ++c) {
        {
            f32x4 q4 = {bflo(rq.x), bfhi(rq.x), bflo(rq.y), bfhi(rq.y)};
            f32x4 f4 = {__expf(bflo(rf.x)), __expf(bfhi(rf.x)), __expf(bflo(rf.y)), __expf(bfhi(rf.y))};
            f32x4 k4 = {1.f - f4[0], 1.f - f4[1], 1.f - f4[2], 1.f - f4[3]};
            f32x4 v4 = {bflo(rv.x), bfhi(rv.x), bflo(rv.y), bfhi(rv.y)};
            *(f32x4*)(sq + st_t * 128 + st_d) = q4; *(f32x4*)(sf + st_t * 128 + st_d) = f4; *(f32x4*)(sk + st_t * 128 + st_d) = k4; *(f32x4*)(sv + st_t * 128 + st_d) = v4;
        }
        __syncthreads();
        if (c + 1 < SEQ / 16) { const bf16_t* s2 = src + (size_t)(c + 1) * 16 * PP; rq = *(const u32x2*)(s2); rf = *(const u32x2*)(s2 + 2048); rv = *(const u32x2*)(s2 + 4096); }
        for (int t = 0; t < 16; ++t) {
            const float vt = sv[t * 128 + v]; float a = 0.f;
#pragma unroll
            for (int i4 = 0; i4 < 8; ++i4) {
                const f32x4 f4 = *(const f32x4*)(sf + t * 128 + dq * 32 + i4 * 4), k4 = *(const f32x4*)(sk + t * 128 + dq * 32 + i4 * 4), q4 = *(const f32x4*)(sq + t * 128 + dq * 32 + i4 * 4);
#pragma unroll
                for (int i = 0; i < 4; ++i) { S[i4 * 4 + i] = f4[i] * S[i4 * 4 + i] + k4[i] * vt; a += q4[i] * S[i4 * 4 + i]; }
            }
            so[(dq * 16 + t) * 128 + v] = a;
        }
        __syncthreads();
        {
            f32x4 o = *(const f32x4*)(so + (0 * 16 + st_t) * 128 + st_d);
            o += *(const f32x4*)(so + (1 * 16 + st_t) * 128 + st_d); o += *(const f32x4*)(so + (2 * 16 + st_t) * 128 + st_d); o += *(const f32x4*)(so + (3 * 16 + st_t) * 128 + st_d);
            float ss = (o[0] * o[0] + o[1] * o[1]) + (o[2] * o[2] + o[3] * o[3]);
            ss += shx<1>(ss); ss += shx<2>(ss); ss += shx<4>(ss); ss += shx<8>(ss); ss += shx<16>(ss);
            const float r = rsqrtf(ss * (1.f / 128.f) + EPS);
            u32x2 w; w.x = cvtpk(o[0] * r * nw[0], o[1] * r * nw[1]); w.y = cvtpk(o[2] * r * nw[2], o[3] * r * nw[3]);
            *(u32x2*)(P + (rowb + c * 16 + st_t) * PP + h * 128 + st_d) = w;
        }
    }
    __syncthreads();
}

#define MFMA16(a, b, c) __builtin_amdgcn_mfma_f32_16x16x16bf16_1k((a), (b), (c), 0, 0, 0)
__device__ __forceinline__ s16x4 pack4(float a, float b, float c, float d) { u32x2 w; w.x = cvtpk(a, b); w.y = cvtpk(c, d); return __builtin_bit_cast(s16x4, w); }
__device__ __forceinline__ void hgrn_unit_mfma(PPtr p, int oi, int b, int h, unsigned char* lds, int tid) {
    constexpr int QS = 136, KTS = 20, NCH = SEQ / 16, PF = 4;
    bf16_t* sQ = (bf16_t*)lds;
    bf16_t* sK = sQ + 2 * 16 * QS;
    bf16_t* sKT = sK + 2 * 16 * QS;
    float* sDec = (float*)(sKT + 2 * 128 * KTS);
    float* sPart = sDec + 2 * 128;
    bf16_t* sTr = (bf16_t*)(sPart + 2 * 128);
    bf16_t* P = (bf16_t*)(p->ws + WS_P);
    const int lane = tid & 63, w = __builtin_amdgcn_readfirstlane(tid >> 6), r = lane & 15, g = lane >> 4;
    const size_t rowb = (size_t)b * SEQ;
    float* ssqh = (float*)(p->ws + WS_SSQH);
    const bf16_t* gld = P + (rowb + (lane >> 2)) * PP + h * 128 + 16 * w + 4 * (lane & 3);
    bf16_t* myTr = sTr + w * (3 * 16 * 20);
    f32x4 St[8];
#pragma unroll
    for (int j = 0; j < 8; ++j) St[j] = (f32x4){0.f, 0.f, 0.f, 0.f};
    u32x2 pq[PF], pl[PF], pv[PF];
#pragma unroll
    for (int k = 0; k < PF; ++k) { const bf16_t* nb = gld + (size_t)k * 16 * PP; pq[k] = *(const u32x2*)nb; pl[k] = *(const u32x2*)(nb + 2048); pv[k] = *(const u32x2*)(nb + 4096); }
#pragma unroll 1
    for (int c4 = 0; c4 < NCH; c4 += PF) {
#pragma unroll
        for (int k = 0; k < PF; ++k) {
            const int c = c4 + k; const int buf = k & 1;
            PSEC_B(7)
            *(u32x2*)(myTr + (0 * 16 + (lane >> 2)) * 20 + 4 * (lane & 3)) = pq[k];
            *(u32x2*)(myTr + (1 * 16 + (lane >> 2)) * 20 + 4 * (lane & 3)) = pl[k];
            *(u32x2*)(myTr + (2 * 16 + (lane >> 2)) * 20 + 4 * (lane & 3)) = pv[k];
            if (c + PF < NCH) { const bf16_t* nb = gld + (size_t)(c + PF) * 16 * PP; pq[k] = *(const u32x2*)nb; pl[k] = *(const u32x2*)(nb + 2048); pv[k] = *(const u32x2*)(nb + 4096); }
            float qv[4], lf[4]; s16x4 vf;
#pragma unroll
            for (int i = 0; i < 4; ++i) {
                qv[i] = __uint_as_float((unsigned)myTr[(0 * 16 + 4 * g + i) * 20 + r] << 16);
                lf[i] = __uint_as_float((unsigned)myTr[(1 * 16 + 4 * g + i) * 20 + r] << 16);
                vf[i] = (short)myTr[(2 * 16 + 4 * g + i) * 20 + r];
            }
            const float p0 = lf[0], p1 = p0 + lf[1], p2 = p1 + lf[2], p3 = p2 + lf[3];
            const float t1 = bperm(lane - 16, p3), t2 = bperm(lane - 32, p3), t3 = bperm(lane - 48, p3);
            const float ex = (g >= 1 ? t1 : 0.f) + (g >= 2 ? t2 : 0.f) + (g >= 3 ? t3 : 0.f);
            const float blast = bperm(48 + r, ex + p3);
            const float bc[4] = {ex + p0, ex + p1, ex + p2, ex + p3};
            float kh[4];
            const float eblast = fast_exp2(LOG2E * blast);
#pragma unroll
            for (int i = 0; i < 4; ++i) {
                const float kk = 1.f - fast_exp2(LOG2E * lf[i]);
                const float eb = fast_exp2(LOG2E * bc[i]);
                const float kt = kk * fast_exp2(-LOG2E * bc[i]);
                sQ[(buf * 16 + 4 * g + i) * QS + 16 * w + r] = (bf16_t)(cvtpk(qv[i] * eb, 0.f) & 0xffffu);
                sK[(buf * 16 + 4 * g + i) * QS + 16 * w + r] = (bf16_t)(cvtpk(kt, 0.f) & 0xffffu);
                kh[i] = kt * eblast;
            }
            *(s16x4*)(sKT + (buf * 128 + 16 * w + r) * KTS + 4 * g) = pack4(kh[0], kh[1], kh[2], kh[3]);
            if (g == 0) sDec[buf * 128 + 16 * w + r] = eblast;
            asm volatile("s_waitcnt lgkmcnt(0)\n\ts_barrier" ::: "memory");
            PSEC_E(7, lds) PSEC_B(8)
            f32x4 a = {0.f, 0.f, 0.f, 0.f};
#pragma unroll
            for (int ks = 0; ks < 4; ++ks) {
                const bf16x8 ka = *(const bf16x8*)(sK + (buf * 16 + r) * QS + 32 * ks + 8 * g);
                const bf16x8 qb = *(const bf16x8*)(sQ + (buf * 16 + r) * QS + 32 * ks + 8 * g);
                a = __builtin_amdgcn_mfma_f32_16x16x32_bf16(ka, qb, a, 0, 0, 0);
            }
#pragma unroll
            for (int i = 0; i < 4; ++i) a[i] = (4 * g + i <= r) ? a[i] : 0.f;
            f32x4 o = MFMA16(vf, pack4(a[0], a[1], a[2], a[3]), ((f32x4){0.f, 0.f, 0.f, 0.f}));
#pragma unroll
            for (int j = 0; j < 8; ++j) {
                const s16x4 qa = *(const s16x4*)(sQ + (buf * 16 + r) * QS + 16 * j + 4 * g);
                o = MFMA16(pack4(St[j][0], St[j][1], St[j][2], St[j][3]), qa, o);
            }
#pragma unroll
            for (int j = 0; j < 8; ++j) {
                const f32x4 d4 = *(const f32x4*)(sDec + buf * 128 + 16 * j + 4 * g);
                const s16x4 ka = *(const s16x4*)(sKT + (buf * 128 + 16 * j + r) * KTS + 4 * g);
                f32x4 sc = St[j]; sc[0] *= d4[0]; sc[1] *= d4[1]; sc[2] *= d4[2]; sc[3] *= d4[3];
                St[j] = MFMA16(ka, vf, sc);
            }
            {
                const size_t grow = rowb + c * 16 + r;
                u32x2 ow; ow.x = cvtpk(o[0], o[1]); ow.y = cvtpk(o[2], o[3]);
                *(u32x2*)(P + grow * PP + h * 128 + 16 * w + 4 * g) = ow;
                float ss = (o[0] * o[0] + o[1] * o[1]) + (o[2] * o[2] + o[3] * o[3]);
                ss += shx<16>(ss); ss = sum_x32(ss);
                if (g == 0) ssqh[(grow * 16 + h) * 8 + w] = ss;
            }
            PSEC_E(8, lds)
        }
    }
    __syncthreads();
}

constexpr int KSTR = 136, VSTR = 144;

__device__ __forceinline__ void attn_unit(PPtr p, int e, int b, int h, int qb, float lam, float oscale, unsigned char* lds, int tid) {
    bf16_t* sK = (bf16_t*)lds;
    bf16_t* sV = sK + 64 * KSTR;
    float* sbias = (float*)(sV + 64 * VSTR);
    bf16_t* P = (bf16_t*)(p->ws + WS_P);
    const int lane = tid & 63, w = __builtin_amdgcn_readfirstlane(tid >> 6), c16 = lane & 15, g = lane >> 4;
    const size_t rowb = (size_t)b * SEQ;
    const int q0 = qb * 128, qw0 = q0 + 16 * w, qpos = qw0 + c16;
    __syncthreads();
    if (tid < 129) {
        int bucket;
        if (tid < 16) bucket = tid;
        else { int lg = 16 + (int)(__logf((float)tid * (1.f / 16.f)) / 2.0794415416798357f * 16.f); bucket = lg < 31 ? lg : 31; }
        sbias[tid] = p->rel_bias[bucket * 8 + h] * LOG2E;
    }
    bf16x8 qf[2][2];
#pragma unroll
    for (int mp = 0; mp < 2; ++mp)
#pragma unroll
        for (int ds = 0; ds < 2; ++ds) qf[mp][ds] = *(const bf16x8*)(P + (rowb + qpos) * PP + 1024 + h * 128 + mp * 64 + ds * 32 + 8 * g);
    f32x4 O[2][8];
#pragma unroll
    for (int mp = 0; mp < 2; ++mp)
#pragma unroll
        for (int vt = 0; vt < 8; ++vt) O[mp][vt] = (f32x4){0.f, 0.f, 0.f, 0.f};
    float mref[2] = {0.f, 0.f}, lsum[2] = {0.f, 0.f};
    const int NT = (q0 + 128) / 64;
    const bf16_t* Kg = P + rowb * PP + 4096 + h * 128; const bf16_t* Vg = P + rowb * PP + 5120 + h * 128;
    const int ld_row0 = tid >> 4, ld_ch = tid & 15;
    u32x4 kr[2], vr[2];
#pragma unroll
    for (int i = 0; i < 2; ++i) { kr[i] = *(const u32x4*)(Kg + (size_t)(ld_row0 + 32 * i) * PP + ld_ch * 8); vr[i] = *(const u32x4*)(Vg + (size_t)(ld_row0 + 32 * i) * PP + ld_ch * 8); }
    for (int t = 0; t < NT; ++t) {
        __syncthreads();
#pragma unroll
        for (int i = 0; i < 2; ++i) { *(u32x4*)(sK + (ld_row0 + 32 * i) * KSTR + ld_ch * 8) = kr[i]; *(u32x4*)(sV + (ld_row0 + 32 * i) * VSTR + ld_ch * 8) = vr[i]; }
        __syncthreads();
        if (t + 1 < NT) {
#pragma unroll
            for (int i = 0; i < 2; ++i) { kr[i] = *(const u32x4*)(Kg + (size_t)((t + 1) * 64 + ld_row0 + 32 * i) * PP + ld_ch * 8); vr[i] = *(const u32x4*)(Vg + (size_t)((t + 1) * 64 + ld_row0 + 32 * i) * PP + ld_ch * 8); }
        }
        const int k0 = t * 64;
        PSEC_B(9)
        if (k0 <= qw0 + 15) {
            const bool far = (qw0 - (k0 + 63)) >= 128;
            const bool first = (t == 0);
            const float bfar = sbias[128];
            bf16x8 pa[2][2];
#pragma unroll
            for (int mp = 0; mp < 2; ++mp) {
                f32x4 sc[4];
                const float cinit = (far ? bfar : 0.f) - mref[mp];
#pragma unroll
                for (int s = 0; s < 4; ++s) {
                    f32x4 a = {cinit, cinit, cinit, cinit};
#pragma unroll
                    for (int ds = 0; ds < 2; ++ds) {
                        const bf16x8 kf = *(const bf16x8*)(sK + (16 * s + c16) * KSTR + mp * 64 + ds * 32 + 8 * g);
                        a = __builtin_amdgcn_mfma_f32_16x16x32_bf16(kf, qf[mp][ds], a, 0, 0, 0);
                    }
                    sc[s] = a;
                }
                if (!far) {
#pragma unroll
                    for (int s = 0; s < 4; ++s)
#pragma unroll
                        for (int j = 0; j < 4; ++j) {
                            const int rel = qpos - (k0 + 16 * s + 4 * g + j);
                            const int idx = rel < 0 ? 0 : (rel > 128 ? 128 : rel);
                            sc[s][j] = (rel >= 0) ? sc[s][j] + sbias[idx] : -1e30f;
                        }
                }
                float mx = fmaxf(fmaxf(fmaxf(sc[0][0], sc[0][1]), fmaxf(sc[0][2], sc[0][3])), fmaxf(fmaxf(sc[1][0], sc[1][1]), fmaxf(sc[1][2], sc[1][3])));
                mx = fmaxf(mx, fmaxf(fmaxf(fmaxf(sc[2][0], sc[2][1]), fmaxf(sc[2][2], sc[2][3])), fmaxf(fmaxf(sc[3][0], sc[3][1]), fmaxf(sc[3][2], sc[3][3]))));
                mx = fmaxf(mx, shx<16>(mx)); mx = max_x32(mx);
                if (first || __any(mx > 8.f)) {
                    const float delta = first ? mx : fmaxf(mx, 0.f);
                    mref[mp] += delta;
#pragma unroll
                    for (int s = 0; s < 4; ++s)
#pragma unroll
                        for (int j = 0; j < 4; ++j) sc[s][j] -= delta;
                    const float al = fast_exp2(-delta);
                    lsum[mp] *= al;
                    if (!first) {
#pragma unroll
                        for (int j = 0; j < 4; ++j) {
                            const float aj = bperm(4 * g + j, al);
#pragma unroll
                            for (int vt = 0; vt < 8; ++vt) O[mp][vt][j] *= aj;
                        }
                    }
                }
                float rs = 0.f;
#pragma unroll
                for (int s = 0; s < 4; ++s)
#pragma unroll
                    for (int j = 0; j < 4; ++j) { const float pv = fast_exp2(sc[s][j]); sc[s][j] = pv; rs += pv; }
                lsum[mp] += rs;
#pragma unroll
                for (int ks = 0; ks < 2; ++ks) {
                    u32x4 pk;
                    pk.x = cvtpk(sc[2 * ks][0], sc[2 * ks][1]); pk.y = cvtpk(sc[2 * ks][2], sc[2 * ks][3]);
                    pk.z = cvtpk(sc[2 * ks + 1][0], sc[2 * ks + 1][1]); pk.w = cvtpk(sc[2 * ks + 1][2], sc[2 * ks + 1][3]);
                    pa[mp][ks] = __builtin_bit_cast(bf16x8, pk);
                }
                asm volatile("" ::: "memory");
            }
            const int tq = c16 >> 2, tp = c16 & 3;
#pragma unroll
            for (int ks = 0; ks < 2; ++ks)
#pragma unroll
                for (int vt = 0; vt < 8; ++vt) {
                    const s16x4 lo = vtr(sV + (32 * ks + 4 * g + tq) * VSTR + 16 * vt + 4 * tp);
                    const s16x4 hi = vtr(sV + (32 * ks + 16 + 4 * g + tq) * VSTR + 16 * vt + 4 * tp);
                    const bf16x8 vf = {lo[0], lo[1], lo[2], lo[3], hi[0], hi[1], hi[2], hi[3]};
                    O[0][vt] = __builtin_amdgcn_mfma_f32_16x16x32_bf16(pa[0][ks], vf, O[0][vt], 0, 0, 0);
                    O[1][vt] = __builtin_amdgcn_mfma_f32_16x16x32_bf16(pa[1][ks], vf, O[1][vt], 0, 0, 0);
                    if (vt & 1) asm volatile("" ::: "memory");
                }
        }
        PSEC_E(9, lds)
    }
#pragma unroll
    for (int mp = 0; mp < 2; ++mp) { lsum[mp] += shx<16>(lsum[mp]); lsum[mp] = sum_x32(lsum[mp]); }
    const float lrun[2] = {lsum[0], lsum[1]};
    const float il0 = 1.f / lrun[0], il1 = lam / lrun[1];
    float sw[8];
#pragma unroll
    for (int vt = 0; vt < 8; ++vt) sw[vt] = p->subln_w[e * 128 + 16 * vt + c16] * oscale;
#pragma unroll
    for (int j = 0; j < 4; ++j) {
        const float a0 = bperm(4 * g + j, il0), a1 = bperm(4 * g + j, il1);
        float o[8]; float ss = 0.f;
#pragma unroll
        for (int vt = 0; vt < 8; ++vt) { o[vt] = O[0][vt][j] * a0 - O[1][vt][j] * a1; ss += o[vt] * o[vt]; }
        ss += shx<1>(ss); ss += shx<2>(ss); ss += shx<4>(ss); ss += shx<8>(ss);
        const float r = rsqrtf(ss * (1.f / 128.f) + EPS);
        bf16_t* op = P + (rowb + qw0 + 4 * g + j) * PP + 1024 + h * 128 + c16;
#pragma unroll
        for (int vt = 0; vt < 8; ++vt) op[16 * vt] = (bf16_t)(cvtpk(o[vt] * r * sw[vt], 0.f) & 0xffffu);
    }
}

#define XB_TMO      128
#define XB_XCNT(j)  (256  + 64 * (j))
#define XB_XSUB(j)  (1280 + 64 * (j))
#define XB_XGEN(j)  (2304 + 64 * (j))
#define XB_TOP      3328
#define XB_TOPGEN   3392
#define XCD_BAR_WORDS 3456
#define XB_SPIN_CAP (1u << 18)

__device__ __forceinline__ unsigned xb_ld(unsigned* p)              { return __hip_atomic_load(p, __ATOMIC_RELAXED, __HIP_MEMORY_SCOPE_AGENT); }
__device__ __forceinline__ unsigned xb_add(unsigned* p, unsigned v) { return __hip_atomic_fetch_add(p, v, __ATOMIC_RELAXED, __HIP_MEMORY_SCOPE_AGENT); }
__device__ __forceinline__ unsigned xb_xcc_id() { return (unsigned)__builtin_amdgcn_s_getreg((3 << 11) | 20) & 0xFu; }
#define XB_SPIN(cond, bar) do { unsigned _sp = 0; while (cond) { __builtin_amdgcn_s_sleep(1); \
    if ((++_sp & 255u) == 0u) { if (xb_ld(&(bar)[XB_TMO])) break; if (_sp > XB_SPIN_CAP) { atomicAdd(&(bar)[XB_TMO], 1u); break; } } } } while (0)

struct XcdBarrier {
    unsigned* bar; unsigned x;
    volatile LAS unsigned* st;
};

__device__ __forceinline__ XcdBarrier xcd_barrier_post(unsigned* bar, volatile LAS unsigned* st, bool leader) {
    XcdBarrier b; b.bar = bar; b.x = xb_xcc_id(); b.st = st;
    if (leader) (void)xb_add(&bar[XB_XCNT(b.x)], 1u);
    return b;
}
__device__ __forceinline__ void xcd_barrier_complete(unsigned* bar, unsigned x, unsigned& nloc, unsigned& nx) {
    const unsigned G = gridDim.x * gridDim.y * gridDim.z;
    unsigned sum, cnt, mine, sp = 0u;
    for (;;) {
        sum = 0u; cnt = 0u; mine = 0u;
#pragma unroll
        for (unsigned j = 0; j < 16; ++j) { const unsigned c = xb_ld(&bar[XB_XCNT(j)]); sum += c; cnt += (c > 0u) ? 1u : 0u; mine = (j == x) ? c : mine; }
        if (sum == G) break;
        __builtin_amdgcn_s_sleep(1);
        if ((++sp & 255u) == 0u) { if (xb_ld(&bar[XB_TMO])) break; if (sp > XB_SPIN_CAP) { atomicAdd(&bar[XB_TMO], 1u); break; } }
    }
    nloc = mine > 0u ? mine : 1u; nx = cnt > 0u ? cnt : 1u;
}

__device__ __forceinline__ void xcd_barrier(const XcdBarrier& b, bool leader) {
    asm volatile("s_waitcnt vmcnt(0)" ::: "memory");
    __syncthreads();
    if (leader) {
        unsigned* bar = b.bar;
        __builtin_amdgcn_s_waitcnt(0);
        unsigned nloc = b.st[0], nx = b.st[1];
        if (nloc == 0u) { xcd_barrier_complete(bar, b.x, nloc, nx); b.st[0] = nloc; b.st[1] = nx; }
        const unsigned old = xb_add(&bar[XB_XSUB(b.x)], 1u);
        const unsigned gen = old / nloc;
        if (old + 1u == (gen + 1u) * nloc) {
            __builtin_amdgcn_fence(__ATOMIC_RELEASE, "agent");
            asm volatile("s_waitcnt vmcnt(0)" ::: "memory");
            const unsigned og = xb_add(&bar[XB_TOP], 1u);
            const unsigned tg = og / nx;
            if (og + 1u == (tg + 1u) * nx) xb_add(&bar[XB_TOPGEN], 1u);
            else XB_SPIN(xb_ld(&bar[XB_TOPGEN]) == tg, bar);
            __builtin_amdgcn_fence(__ATOMIC_ACQUIRE, "agent");
            xb_add(&bar[XB_XGEN(b.x)], 1u);
            asm volatile("s_waitcnt vmcnt(0)" ::: "memory");
        } else {
            XB_SPIN(xb_ld(&bar[XB_XGEN(b.x)]) == gen, bar);
            __builtin_amdgcn_fence(__ATOMIC_ACQUIRE, "agent");
            asm volatile("s_waitcnt vmcnt(0)" ::: "memory");
        }
    }
    __syncthreads();
}

#define p get_params()
__global__ void __launch_bounds__(512, 2) fwd_kernel(Params p_unused) {
    extern __shared__ __attribute__((aligned(16))) unsigned char lds[];
    cg::grid_group grid = cg::this_grid();
    int tid = threadIdx.x, lane = tid & 63; const int wave = __builtin_amdgcn_readfirstlane(tid >> 6);
#define FRESH_LANES() do { lane = (int)__builtin_amdgcn_mbcnt_hi(~0u, __builtin_amdgcn_mbcnt_lo(~0u, 0u)); asm volatile("" : "+v"(lane)); tid = wave * 64 + lane; } while (0)
    const int G = gridDim.x, blk = blockIdx.x;
    volatile LAS unsigned* bar_st = (volatile LAS unsigned*)(lds + LDS_BYTES - 512);
    if (tid < 2) bar_st[tid] = 0u;
#ifdef PROBE_SEC
    if (wave == 0) *(volatile unsigned long long*)(lds + LDS_BYTES - 128) = 0ull;
#endif
    __syncthreads();
    const XcdBarrier xbar = xcd_barrier_post((unsigned*)(get_params()->ws + WS_BAR), bar_st, tid == 0);
#define GRID_SYNC() do { FRESH_LANES(); xcd_barrier(xbar, tid == 0); } while (0)
    __builtin_assume(blk >= 0 && blk < 256 && G >= 1 && G <= 256);
    const int gw = blk * 8 + wave, NGW = G * 8;
    const int vcu = __builtin_amdgcn_readfirstlane((G % 8 == 0) ? (blk % 8) * (G / 8) + blk / 8 : blk);
    bf16_t* P = (bf16_t*)(p->ws + WS_P); bf16_t* U = (bf16_t*)(p->ws + WS_U);
    float* ssq = (float*)(p->ws + WS_SSQ);
    float* scr = (float*)(lds + wave * 8704);
    PG8_LAS unsigned char* ring = (PG8_LAS unsigned char*)lds;

#ifdef PROBE_MASK
    unsigned long long* tstamp = (unsigned long long*)(lds + LDS_BYTES - 256);
    int n_ts = 0;
#define STAMP() do { if (blk == 0 && threadIdx.x == 0) tstamp[n_ts] = __builtin_amdgcn_s_memrealtime(); ++n_ts; } while (0)
#else
#define STAMP() do {} while (0)
#endif
    STAMP();
    for (int r0 = gw; r0 < T_TOK; r0 += 4 * NGW) {
        f32x4 v[4][4];
#pragma unroll
        for (int u = 0; u < 4; ++u) { const int row = min(r0 + u * NGW, T_TOK - 1); const f32x4* xr = (const f32x4*)(p->x + (size_t)row * DM) + lane;
#pragma unroll
            for (int j = 0; j < 4; ++j) v[u][j] = xr[64 * j]; }
#pragma unroll
        for (int u = 0; u < 4; ++u) {
            const int row = r0 + u * NGW;
            float s = 0.f;
#pragma unroll
            for (int j = 0; j < 4; ++j) s += (v[u][j][0] * v[u][j][0] + v[u][j][1] * v[u][j][1]) + (v[u][j][2] * v[u][j][2] + v[u][j][3] * v[u][j][3]);
            s = wave_sum(s);
            if (row < T_TOK) {
                u32x2* up = (u32x2*)(U + (size_t)row * DM) + lane;
#pragma unroll
                for (int j = 0; j < 4; ++j) { u32x2 w; w.x = cvtpk(v[u][j][0], v[u][j][1]); w.y = cvtpk(v[u][j][2], v[u][j][3]); up[64 * j] = w; }
                if (lane < 16) ssq[(size_t)row * 16 + lane] = (lane == 0) ? s : 0.f;
            }
        }
    }
    convert_layer(p, 0, scr, gw, NGW, lane);
    for (int i = blk * 512 + tid; i < 4096; i += G * 512) ((float*)(p->ws + WS_LB))[i] = lb_val(p->hgrn_lb, i & 2047, (i >> 11) ? 3 : 1);
    grid.sync(); STAMP();

#pragma unroll 1
    for (int layer = 0; layer < 4; ++layer) {
        const bool even = (layer & 1) == 0; const int e = layer >> 1;
        FRESH_LANES();
        if (even) {
            dt_items(p, e, gw, NGW, lane);
            pg8::Gemm gm{U, (const bf16_t*)(p->ws + WS_WE_IN), T_TOK, 6144, DM, DM}; pg8::StaticOrder S; S.init(T_TOK, 6144, G, blk);
            pg8::EpiIn E{P, ssq, 0, 0.125f * LOG2E, nullptr, 0};
#ifndef SKIP_IN
            pg8::gemm_phase<pg8::EpiIn, pg8::StaticOrder, true, PG8SP2, 1024, 1024>(ring, gm, S, E, tid);
#endif
        } else {
            pg8::Gemm gm{U, (const bf16_t*)(p->ws + WS_WO_IN), T_TOK, 6144, DM, DM}; pg8::StaticOrder S; S.init(T_TOK, 6144, G, blk);
            pg8::EpiIn E{P, ssq, 1, 1.f, (const float*)(p->ws + WS_LB) + e * 2048, layer};
#ifndef SKIP_IN
            pg8::gemm_phase<pg8::EpiIn, pg8::StaticOrder, true, PG8SP2, 1024, 1024>(ring, gm, S, E, tid);
#endif
        }
        GRID_SYNC(); STAMP();
        FRESH_LANES();
        if (even) {
            const float lam_init = 0.8f - 0.6f * __expf(-0.3f * (float)layer);
            float d1 = p->lq1[e * 64 + lane] * p->lk1[e * 64 + lane], d2 = p->lq2[e * 64 + lane] * p->lk2[e * 64 + lane];
            d1 = wave_sum(d1); d2 = wave_sum(d2);
            const float lam = __expf(d1) - __expf(d2) + lam_init;
            for (int pi = vcu; pi < 1024; pi += G) {
                const int bh = pi >> 3, s = pi & 7;
#ifndef SKIP_ATTN
#pragma unroll 1
                for (int half = 0; half < 2; ++half) { FRESH_LANES(); attn_unit(p, e, bh >> 3, bh & 7, half ? s : 15 - s, lam, 1.f - lam_init, lds, tid); }
#endif
            }
            __syncthreads(); STAMP();
            FRESH_LANES();
#ifndef SKIP_SSD
            for (int ui = vcu; ui < 256; ui += G) ssd_unit_mfma(p, e, ui >> 4, ui & 15, lds, tid);
#endif
        } else {
#ifndef SKIP_HGRN
            for (int ui = blk; ui < 256; ui += G) hgrn_unit_mfma(p, e, ui >> 4, ui & 15, lds, tid);
#endif
        }
        GRID_SYNC(); STAMP();
        FRESH_LANES();
        if (even) {
            pg8::Gemm gm{U, (const bf16_t*)(p->ws + WS_WE_G), T_TOK, 1024, DM, DM}; pg8::StaticOrder S; S.init(T_TOK, 1024, G, blk);
            pg8::EpiGate E{P + 1024, ssq, (const float*)(p->ws + WS_SSD), p->ssd_norm_w + e * 1024, P, nullptr, nullptr};
#ifndef SKIP_GATE
            pg8::gemm_phase<pg8::EpiGate, pg8::StaticOrder, true, PG8SP2, 1024, 1024>(ring, gm, S, E, tid);
#endif
        } else {
            pg8::Gemm gm{U, (const bf16_t*)(p->ws + WS_WO_G), T_TOK, 2048, DM, DM}; pg8::StaticOrder S; S.init(T_TOK, 2048, G, blk);
            pg8::EpiGate E{P, ssq, nullptr, nullptr, nullptr, (const float*)(p->ws + WS_SSQH), p->hgrn_norm_w + e * 128};
#ifndef SKIP_GATE
            pg8::gemm_phase<pg8::EpiGate, pg8::StaticOrder, true, PG8SP2, 1024, 1024>(ring, gm, S, E, tid);
#endif
        }
        GRID_SYNC(); STAMP();
        FRESH_LANES();
        {
            pg8::Gemm gm{P, (const bf16_t*)(p->ws + (even ? WS_WE_OUT : WS_WO_OUT)), T_TOK, 1024, 2048, PP}; pg8::StaticOrder S; S.init(T_TOK, 1024, G, blk);
            pg8::EpiOut E{layer == 0 ? p->x : p->out, p->out, layer < 3 ? U : nullptr, ssq};
#ifndef SKIP_OUT
            pg8::gemm_phase<pg8::EpiOut, pg8::StaticOrder, true, PG8SP2, 2048, 6144>(ring, gm, S, E, tid);
#endif
            FRESH_LANES();
            if (layer < 3) convert_layer(p, layer + 1, scr, gw, NGW, lane);
        }
        GRID_SYNC(); STAMP();
    }
    FRESH_LANES();
    for (int r0 = gw; r0 < T_TOK; r0 += 4 * NGW) {
        float r[4]; f32x4 v[4][4];
#pragma unroll
        for (int u = 0; u < 4; ++u) { const int row = min(r0 + u * NGW, T_TOK - 1); r[u] = row_rs(ssq, row); const f32x4* hp = (const f32x4*)(p->out + (size_t)row * DM) + lane;
#pragma unroll
            for (int j = 0; j < 4; ++j) v[u][j] = hp[64 * j]; }
        const f32x4* wp = (const f32x4*)p->final_norm_w + lane;
        const f32x4 w0 = wp[0], w1 = wp[64], w2 = wp[128], w3 = wp[192];
#pragma unroll
        for (int u = 0; u < 4; ++u) {
            const int row = r0 + u * NGW;
            if (row < T_TOK) {
                f32x4* hp = (f32x4*)(p->out + (size_t)row * DM) + lane;
#pragma unroll
                for (int j = 0; j < 4; ++j) { f32x4 x = v[u][j]; const f32x4 w = (j == 0) ? w0 : (j == 1) ? w1 : (j == 2) ? w2 : w3; const float rr = r[u];
                    x[0] *= rr * w[0]; x[1] *= rr * w[1]; x[2] *= rr * w[2]; x[3] *= rr * w[3]; hp[64 * j] = x; }
            }
        }
    }
#ifdef PROBE_SEC
    if (blk == 0 && wave == 0) {
        const unsigned long long tend = __builtin_amdgcn_s_memrealtime();
        const unsigned long long acc_t = *(volatile unsigned long long*)(lds + LDS_BYTES - 128) * PROBE_MULT;
        while (__builtin_amdgcn_s_memrealtime() - tend < acc_t) __builtin_amdgcn_s_sleep(32);
    }
#endif
#ifdef PROBE_MASK
    if (blk == 0 && threadIdx.x == 0) {
        const unsigned long long tend = __builtin_amdgcn_s_memrealtime();
        unsigned long long acc_t = 0;
        for (int k = 0; k + 1 < n_ts; ++k) if ((PROBE_MASK >> k) & 1u) acc_t += tstamp[k + 1] - tstamp[k];
        acc_t *= PROBE_MULT;
        while (__builtin_amdgcn_s_memrealtime() - tend < acc_t) __builtin_amdgcn_s_sleep(32);
    }
#endif
}

#undef p
extern "C" void kernel_launch(void* const* d_in, const int* in_sizes, int n_in, void* d_out, int out_size, void* d_ws, size_t ws_size, hipStream_t stream) {
    static int grid = 0;
    if (grid == 0) {
        if (n_in != 21 || out_size != T_TOK * DM || ws_size < WS_END) { fprintf(stderr, "kernel_launch: unexpected shapes: n_in %d out %d ws %zu (need %zu)\n", n_in, out_size, ws_size, (size_t)WS_END); grid = -1; return; }
        int dev = 0, cus = 0, per_cu = 0;
        hipGetDevice(&dev); hipDeviceGetAttribute(&cus, hipDeviceAttributeMultiprocessorCount, dev);
        hipFuncSetAttribute((const void*)fwd_kernel, hipFuncAttributeMaxDynamicSharedMemorySize, LDS_BYTES);
        hipOccupancyMaxActiveBlocksPerMultiprocessor(&per_cu, (const void*)fwd_kernel, 512, LDS_BYTES);
        if (per_cu < 1) { fprintf(stderr, "kernel_launch: occupancy query says %d blocks per CU\n", per_cu); per_cu = 1; }
        (void)hipGetLastError();
        grid = cus * per_cu;
        if (grid > 256) grid = 256;
    }
    if (grid < 0) return;
    Params p{};
    const float** f = (const float**)&p;
    for (int i = 0; i < 21; ++i) f[i] = (const float*)d_in[i];
    p.out = (float*)d_out; p.ws = (unsigned char*)d_ws;
    if (hipMemsetAsync((char*)d_ws + WS_BAR, 0, WS_BAR_BYTES, stream) != hipSuccess) { fprintf(stderr, "kernel_launch: memset of barrier words failed\n"); return; }
    void* args[] = {&p};
    hipError_t err = hipLaunchCooperativeKernel((const void*)fwd_kernel, dim3(grid), dim3(512), args, LDS_BYTES, stream);
    if (err != hipSuccess) fprintf(stderr, "kernel_launch: cooperative launch failed: %s (grid %d)\n", hipGetErrorString(err), grid);
}
```

```cpp
#include <hip/hip_runtime.h>
#include <hip/hip_cooperative_groups.h>
#include <cstdio>
#include <cstdint>
#include <cmath>
namespace cg = cooperative_groups;

#ifdef PROBE_SEC
#define PROBE_SECV PROBE_SEC
#define PSEC_B(id) unsigned long long _pt##id = 0ull; if ((id) == PROBE_SEC && blockIdx.x == 0 && __builtin_amdgcn_readfirstlane(tid >> 6) == 0) _pt##id = __builtin_amdgcn_s_memrealtime();
#define PSEC_E(id, ldsbase) if ((id) == PROBE_SEC && blockIdx.x == 0 && __builtin_amdgcn_readfirstlane(tid >> 6) == 0) { volatile unsigned long long* _a = (volatile unsigned long long*)((unsigned char*)(ldsbase) + 147456 - 128); *_a = *_a + (__builtin_amdgcn_s_memrealtime() - _pt##id); }
#else
#define PROBE_SECV (-1)
#define PSEC_B(id)
#define PSEC_E(id, ldsbase)
#endif

#define LAS __attribute__((address_space(3)))
typedef unsigned short bf16_t;
typedef short bf16x8 __attribute__((ext_vector_type(8)));
typedef short s16x4 __attribute__((ext_vector_type(4)));
typedef float f32x4 __attribute__((ext_vector_type(4)));
typedef unsigned u32x4 __attribute__((ext_vector_type(4)));
typedef unsigned u32x2 __attribute__((ext_vector_type(2)));
typedef float f32x2_t __attribute__((ext_vector_type(2)));
typedef __bf16 bf16x2_t __attribute__((ext_vector_type(2)));

constexpr int T_TOK = 32768, DM = 1024, SEQ = 2048, NBATCH = 16, PP = 6144;
constexpr float EPS = 1e-6f;
constexpr float LOG2E = 1.4426950408889634f;

__device__ __forceinline__ unsigned cvtpk(float lo, float hi) { f32x2_t v = {lo, hi}; bf16x2_t b = __builtin_convertvector(v, bf16x2_t); return __builtin_bit_cast(unsigned, b); }
__device__ __forceinline__ float bflo(unsigned w) { return __uint_as_float(w << 16); }
__device__ __forceinline__ float bfhi(unsigned w) { return __uint_as_float(w & 0xffff0000u); }
__device__ __forceinline__ float fast_exp2(float x) { return __builtin_amdgcn_exp2f(x); }
__device__ __forceinline__ float sigmoid_f(float x) { return __builtin_amdgcn_rcpf(1.f + fast_exp2(-LOG2E * x)); }
__device__ __forceinline__ float silu_f(float x) { return x * sigmoid_f(x); }

template <int M> __device__ __forceinline__ float shx(float v) { static_assert(M < 32, "shx: xor mask within a 32-lane half"); return __int_as_float(__builtin_amdgcn_ds_swizzle(__float_as_int(v), 0x1f | (M << 10))); }
__device__ __forceinline__ float sum_x32(float v) { auto rr = __builtin_amdgcn_permlane32_swap(__float_as_uint(v), __float_as_uint(v), false, false); return __uint_as_float(rr[0]) + __uint_as_float(rr[1]); }
__device__ __forceinline__ float max_x32(float v) { auto rr = __builtin_amdgcn_permlane32_swap(__float_as_uint(v), __float_as_uint(v), false, false); return fmaxf(__uint_as_float(rr[0]), __uint_as_float(rr[1])); }
__device__ __forceinline__ float bperm(int srclane, float v) { return __int_as_float(__builtin_amdgcn_ds_bpermute(srclane << 2, __float_as_int(v))); }
__device__ __forceinline__ float wave_sum(float v) { v += shx<1>(v); v += shx<2>(v); v += shx<4>(v); v += shx<8>(v); v += shx<16>(v); return sum_x32(v); }
__device__ __forceinline__ float row_rs(const float* ssq, int row) {
    const f32x4* p = (const f32x4*)(ssq + (size_t)row * 16);
    const f32x4 a = p[0], b = p[1], c = p[2], d = p[3];
    const float s = ((a[0] + a[1]) + (a[2] + a[3])) + ((b[0] + b[1]) + (b[2] + b[3])) + ((c[0] + c[1]) + (c[2] + c[3])) + ((d[0] + d[1]) + (d[2] + d[3]));
    return rsqrtf(s * (1.f / 1024.f) + EPS);
}

__device__ __forceinline__ void row_rs8(const float* ssq, int row0, int fq, float (&rsv)[8]) {
#pragma unroll
    for (int i = 0; i < 8; ++i) {
        const int row = row0 + (i >> 2) * 128 + (i & 3) * 16;
        const f32x4 a = *(const f32x4*)(ssq + (size_t)row * 16 + fq * 4);
        float s = (a[0] + a[1]) + (a[2] + a[3]);
        s += shx<16>(s); s = sum_x32(s);
        rsv[i] = rsqrtf(s * (1.f / 1024.f) + EPS);
    }
    asm volatile("" ::: "memory");
}
__device__ __forceinline__ float lb_val(const float* lbp, int cf, int li) {
    const float a0 = lbp[cf], a1 = lbp[2048 + cf], a2 = lbp[4096 + cf], a3 = lbp[6144 + cf];
    const float m = fmaxf(fmaxf(a0, a1), fmaxf(a2, a3));
    const float e0 = __expf(a0 - m), e1 = __expf(a1 - m), e2 = __expf(a2 - m), e3 = __expf(a3 - m);
    const float s = (e0 + e1) + (e2 + e3);
    const float num = (li == 1) ? e1 : (e1 + e2 + e3);
    return num / s;
}
namespace pg8 {
#define PG8_LAS __attribute__((address_space(3)))
typedef unsigned short bf16_t;
typedef short bf16x8 __attribute__((ext_vector_type(8)));
typedef float f32x4 __attribute__((ext_vector_type(4)));
typedef unsigned u32x4 __attribute__((ext_vector_type(4)));
constexpr int BM = 256, BK = 64, HALF = 128, HTB = HALF * BK * 2  , STAGE_BYTES = 8 * HTB, NXCD = 8, WGM = 8;

__host__ __device__ __forceinline__ int lds_byte(int r, int c) { const int st = (r >> 4) * 2 + (c >> 5), rr = r & 15, cc = c & 31, ob = rr * 64 + cc * 2; return st * 1024 + (ob ^ (((ob >> 9) & 1) << 5)); }
__host__ __device__ __forceinline__ void stage_rc(int b, int& R, int& C) { const int st = b / 1024, sb = b % 1024, swz = sb ^ (((sb >> 9) & 1) << 5); R = (st >> 1) * 16 + swz / 64; C = (st & 1) * 32 + (swz % 64) / 2; }
__host__ __device__ __forceinline__ int perm32(int rho) { const int n = rho >> 4, i = rho & 15; return 8 * (i >> 2) + 4 * n + (i & 3); }

struct Unit { int pm, pn; };
struct Gemm { const bf16_t* A; const bf16_t* Bt; int M, N, K, lda; };

struct StaticOrder {
    int nM, nN, nwg, G, c;
    __host__ __device__ void init(int M, int N, int G_, int c_) { nM = M / BM; nN = N / BM; nwg = nM * nN; G = G_; c = c_; }
    __host__ __device__ bool next(int i, Unit& u) const {
        const long L = (long)i * G + c; if (L >= nwg) return false;
        int wgid = (int)L; { const int q = nwg / NXCD, r = nwg % NXCD, xcd = wgid % NXCD, off = wgid / NXCD; wgid = (xcd < r ? xcd * (q + 1) : r * (q + 1) + (xcd - r) * q) + off; }
        const int nig = WGM * nN, gid = wgid / nig, fm = gid * WGM, gsz = (nM - fm) < WGM ? (nM - fm) : WGM;
        u.pm = fm + ((wgid % nig) % gsz); u.pn = (wgid % nig) / gsz; return true;
    }
    __device__ __forceinline__ void a_ready(const Unit&) const {}
    __device__ __forceinline__ void done(const Unit&) const {}
};

struct EpiIn {
    static constexpr bool PERM = true, AFTER_DRAIN = false; static constexpr int PID = 1;
    bf16_t* P; const float* ssq; int mode; float qscale; const float* lbp; int li;
    __device__ __forceinline__ void operator()(const f32x4 (&acc)[2][2][4][2], const Unit& u, int wr, int wc, int fr, int fq) const {
        const int row0 = u.pm * BM + wr * 64 + fr; const int col0 = u.pn * BM + wc * 32 + 8 * fq;
        int act = 0; float sc = 1.f;
#ifndef TRIVIAL_EPI
        if (mode == 0) { if (u.pn >= 4 && u.pn < 8) sc = qscale; }
        else { act = (u.pn < 8) ? 1 : ((u.pn < 16) ? 2 : 0); }
#endif
        float lb[2][8];
#pragma unroll
        for (int bj = 0; bj < 2; ++bj)
#pragma unroll
            for (int i = 0; i < 8; ++i) lb[bj][i] = 0.f;
        if (act == 2) {
#pragma unroll
            for (int bj = 0; bj < 2; ++bj)
#pragma unroll
                for (int i = 0; i < 8; ++i) lb[bj][i] = lbp[col0 + bj * HALF + i - 2048];
        }
        float rsv[8]; row_rs8(ssq, row0, fq, rsv);
#pragma unroll
        for (int ai = 0; ai < 2; ++ai)
#pragma unroll
            for (int m = 0; m < 4; ++m) {
                const int row = row0 + ai * HALF + m * 16;
                const float r = rsv[ai * 4 + m] * sc;
                bf16_t* rowp = P + (size_t)row * PP + col0;
#pragma unroll
                for (int bj = 0; bj < 2; ++bj) {
                    float v[8];
#pragma unroll
                    for (int i = 0; i < 4; ++i) { v[i] = acc[ai][bj][m][0][i] * r; v[4 + i] = acc[ai][bj][m][1][i] * r; }
                    if (act == 1) {
#pragma unroll
                        for (int i = 0; i < 8; ++i) v[i] = silu_f(v[i]);
                    } else if (act == 2) {
#pragma unroll
                        for (int i = 0; i < 8; ++i) { const float sg = sigmoid_f(v[i]); v[i] = 0.6931471805599453f * __builtin_amdgcn_logf(lb[bj][i] + (1.f - lb[bj][i]) * sg); }
                    }
                    u32x4 w; w.x = cvtpk(v[0], v[1]); w.y = cvtpk(v[2], v[3]); w.z = cvtpk(v[4], v[5]); w.w = cvtpk(v[6], v[7]);
                    *(u32x4*)(rowp + bj * HALF) = w;
                }
                asm volatile("" ::: "memory");
            }
    }
};
struct EpiGate {
    static constexpr bool PERM = true, AFTER_DRAIN = false; static constexpr int PID = 2;
    bf16_t* Y; const float* ssq; const float* ssd; const float* ssdw; bf16_t* YA; const float* ssqh; const float* hnw;
    __device__ __forceinline__ void operator()(const f32x4 (&acc)[2][2][4][2], const Unit& u, int wr, int wc, int fr, int fq) const {
        const int row0 = u.pm * BM + wr * 64 + fr; const int col0 = u.pn * BM + wc * 32 + 8 * fq;
        float rsv[8]; row_rs8(ssq, row0, fq, rsv);
        f32x4 hw0 = {1.f, 1.f, 1.f, 1.f}, hw1 = hw0;
        if (ssqh) { hw0 = *(const f32x4*)(hnw + wc * 32 + 8 * fq); hw1 = *(const f32x4*)(hnw + wc * 32 + 8 * fq + 4); }
#pragma unroll
        for (int ai = 0; ai < 2; ++ai) {
            float rh[4][2];
#pragma unroll
            for (int m = 0; m < 4; ++m) { rh[m][0] = 1.f; rh[m][1] = 1.f; }
            if (ssqh) {
                f32x4 pr[4];
#pragma unroll
                for (int m = 0; m < 4; ++m) pr[m] = *(const f32x4*)(ssqh + ((size_t)(row0 + ai * HALF + m * 16) * 16 + 2 * u.pn + (fq >> 1)) * 8 + (fq & 1) * 4);
#pragma unroll
                for (int m = 0; m < 4; ++m) {
                    float sq = (pr[m][0] + pr[m][1]) + (pr[m][2] + pr[m][3]);
                    sq += shx<16>(sq);
                    const auto rr = __builtin_amdgcn_permlane32_swap(__float_as_uint(sq), __float_as_uint(sq), false, false);
                    rh[m][0] = rsqrtf(__uint_as_float(rr[0]) * (1.f / 128.f) + EPS); rh[m][1] = rsqrtf(__uint_as_float(rr[1]) * (1.f / 128.f) + EPS);
                }
                asm volatile("" ::: "memory");
            }
            u32x4 ov[4][2];
#pragma unroll
            for (int m = 0; m < 4; ++m)
#pragma unroll
                for (int bj = 0; bj < 2; ++bj) ov[m][bj] = *(const u32x4*)(Y + (size_t)(row0 + ai * HALF + m * 16) * PP + col0 + bj * HALF);
#pragma unroll
            for (int m = 0; m < 4; ++m) {
                const float r = rsv[ai * 4 + m];
                bf16_t* rowp = Y + (size_t)(row0 + ai * HALF + m * 16) * PP + col0;
#pragma unroll
                for (int bj = 0; bj < 2; ++bj) {
                    const u32x4 o = ov[m][bj];
                    float v[8];
#pragma unroll
                    for (int i = 0; i < 4; ++i) { v[i] = silu_f(acc[ai][bj][m][0][i] * r) * (rh[m][bj] * hw0[i]); v[4 + i] = silu_f(acc[ai][bj][m][1][i] * r) * (rh[m][bj] * hw1[i]); }
                    u32x4 w;
                    w.x = cvtpk(v[0] * bflo(o.x), v[1] * bfhi(o.x)); w.y = cvtpk(v[2] * bflo(o.y), v[3] * bfhi(o.y));
                    w.z = cvtpk(v[4] * bflo(o.z), v[5] * bfhi(o.z)); w.w = cvtpk(v[6] * bflo(o.w), v[7] * bfhi(o.w));
                    *(u32x4*)(rowp + bj * HALF) = w;
                }
            }
            asm volatile("" ::: "memory");
        }
        if (ssd) {
            float rsd[8]; row_rs8(ssd, row0, fq, rsd);
#pragma unroll
            for (int bj = 0; bj < 2; ++bj) {
                const f32x4 w0 = *(const f32x4*)(ssdw + col0 + bj * HALF), w1 = *(const f32x4*)(ssdw + col0 + bj * HALF + 4);
                u32x4 yv[8];
#pragma unroll
                for (int i = 0; i < 8; ++i) yv[i] = *(const u32x4*)(YA + (size_t)(row0 + (i >> 2) * HALF + (i & 3) * 16) * PP + col0 + bj * HALF);
#pragma unroll
                for (int i = 0; i < 8; ++i) {
                    const float rr = rsd[i]; u32x4 y = yv[i];
                    y.x = cvtpk(bflo(y.x) * rr * w0[0], bfhi(y.x) * rr * w0[1]); y.y = cvtpk(bflo(y.y) * rr * w0[2], bfhi(y.y) * rr * w0[3]);
                    y.z = cvtpk(bflo(y.z) * rr * w1[0], bfhi(y.z) * rr * w1[1]); y.w = cvtpk(bflo(y.w) * rr * w1[2], bfhi(y.w) * rr * w1[3]);
                    *(u32x4*)(YA + (size_t)(row0 + (i >> 2) * HALF + (i & 3) * 16) * PP + col0 + bj * HALF) = y;
                }
                asm volatile("" ::: "memory");
            }
        }
    }
};
struct EpiOut {
    static constexpr bool PERM = false, AFTER_DRAIN = false; static constexpr int PID = 3;
    const float* hin; float* hout; bf16_t* U; float* ssq;
    __device__ __forceinline__ void operator()(const f32x4 (&acc)[2][2][4][2], const Unit& u, int wr, int wc, int fr, int fq) const {
        const int row0 = u.pm * BM + wr * 64 + fr; const int col0 = u.pn * BM + wc * 32 + 4 * fq;
#pragma unroll
        for (int ai = 0; ai < 2; ++ai)
#pragma unroll
            for (int m = 0; m < 4; ++m) {
                const int row = row0 + ai * HALF + m * 16;
                const size_t off = (size_t)row * DM + col0;
                float s = 0.f;
#pragma unroll
                for (int bj = 0; bj < 2; ++bj)
#pragma unroll
                    for (int n = 0; n < 2; ++n) {
                        const f32x4 hv = *(const f32x4*)(hin + off + bj * HALF + n * 16) + acc[ai][bj][m][n];
                        *(f32x4*)(hout + off + bj * HALF + n * 16) = hv;
                        if (U) { u32x2 w; w.x = cvtpk(hv[0], hv[1]); w.y = cvtpk(hv[2], hv[3]); *(u32x2*)(U + off + bj * HALF + n * 16) = w; }
                        s += (hv[0] * hv[0] + hv[1] * hv[1]) + (hv[2] * hv[2] + hv[3] * hv[3]);
                    }
                s += shx<16>(s); s = sum_x32(s);
                if (fq == 0) ssq[(size_t)row * 16 + u.pn * 4 + wc] = s;
                if (m == 3) asm volatile("" ::: "memory");
            }
    }
};
template <class Epi, class Sched, bool ALIGN_EPI, bool SP2, int KK, int LDA>
__device__ __forceinline__ void gemm_phase(PG8_LAS unsigned char* lds, const Gemm g, const Sched& S, const Epi& E, int tid_arg) {
    int tid = tid_arg; asm volatile("" : "+v"(tid));
    const int wid = __builtin_amdgcn_readfirstlane(tid >> 6), lane = tid & 63, wr = wid >> 2, wc = wid & 3, fr = lane & 15, fq = lane >> 4;
    constexpr int K = KK, nt = K / BK;
    unsigned voffA[2], voffB[2];
#pragma unroll
    for (int i = 0; i < 2; ++i) { int R, C; stage_rc(tid * 16 + i * 8192, R, C); const int Rb = Epi::PERM ? ((R & ~31) + perm32(R & 31)) : R;
        voffA[i] = (unsigned)(R * LDA + C) * 2u; voffB[i] = (unsigned)(Rb * K + C) * 2u; }
    constexpr size_t kstep = (size_t)(BK * 2);
    constexpr size_t hstepA = (size_t)HALF * LDA * 2, hstepB = (size_t)HALF * K * 2;
    constexpr size_t tstepA = 2 * hstepA, tstepB = 2 * hstepB;
    const unsigned ldsw = (unsigned)wid * 1024u;
    const int aoff = lds_byte(wr * 64 + fr, fq * 8), boff = lds_byte(wc * 32 + fr, fq * 8);
#define PG8_SA(b, h) (((b) * 2 + (h)) * HTB)
#define PG8_SB(b, h) ((4 + (b) * 2 + (h)) * HTB)
#define PG8_STAGE(bufoff, gbase, voff) do { _Pragma("unroll") for (int _i = 0; _i < 2; ++_i) \
        __builtin_amdgcn_global_load_lds((const unsigned*)((const char*)(gbase) + (voff)[_i]), (PG8_LAS unsigned*)(lds + (bufoff) + ldsw + _i * 8192), 16, 0, 0); } while (0)
#define PG8_LDA(dst, b, h) do { _Pragma("unroll") for (int m = 0; m < 4; ++m) _Pragma("unroll") for (int k = 0; k < 2; ++k) dst[m][k] = *(const PG8_LAS bf16x8*)(lds + PG8_SA(b, h) + aoff + m * 2048 + k * 1024); } while (0)
#define PG8_LDB(dst, b, h) do { _Pragma("unroll") for (int n = 0; n < 2; ++n) _Pragma("unroll") for (int k = 0; k < 2; ++k) dst[n][k] = *(const PG8_LAS bf16x8*)(lds + PG8_SB(b, h) + boff + n * 2048 + k * 1024); } while (0)
#define PG8_MMA(ai, bj, At, Bt) do { __builtin_amdgcn_s_setprio(1); _Pragma("unroll") for (int m = 0; m < 4; ++m) _Pragma("unroll") for (int n = 0; n < 2; ++n) _Pragma("unroll") for (int k = 0; k < 2; ++k) \
        acc[ai][bj][m][n] = __builtin_amdgcn_mfma_f32_16x16x32_bf16(Bt[n][k], At[m][k], acc[ai][bj][m][n], 0, 0, 0); __builtin_amdgcn_s_setprio(0); } while (0)
#define PG8_WAIT_V(n) asm volatile("s_waitcnt vmcnt(" #n ")" ::: "memory")
#define PG8_WAIT_L(n) asm volatile("s_waitcnt lgkmcnt(" #n ")" ::: "memory")
#define PG8_BAR __builtin_amdgcn_s_barrier()
#define PG8_SCHED __builtin_amdgcn_sched_barrier(0)
    Unit cur, nxt; int ui = 0;
    if (!S.next(0, cur)) return;
    f32x4 acc[2][2][4][2];
#pragma unroll
    for (int a = 0; a < 2; ++a)
#pragma unroll
        for (int b = 0; b < 2; ++b)
#pragma unroll
            for (int m = 0; m < 4; ++m)
#pragma unroll
                for (int n = 0; n < 2; ++n) acc[a][b][m][n] = (f32x4){0.f, 0.f, 0.f, 0.f};
    bf16x8 At[4][2], B0[2][2], B1[2][2];
    const char* cA = (const char*)g.A + (size_t)cur.pm * tstepA; const char* cB = (const char*)g.Bt + (size_t)cur.pn * tstepB;
    S.a_ready(cur);
    if constexpr (SP2) {
        PG8_STAGE(PG8_SB(0, 0), cB, voffB); PG8_STAGE(PG8_SB(0, 1), cB + hstepB, voffB); PG8_STAGE(PG8_SA(0, 0), cA, voffA); PG8_STAGE(PG8_SA(0, 1), cA + hstepA, voffA);
        if (wr == 1) PG8_BAR;
        PG8_WAIT_V(2); PG8_BAR;
        PG8_STAGE(PG8_SB(1, 0), cB + kstep, voffB); PG8_STAGE(PG8_SA(1, 0), cA + kstep, voffA); PG8_STAGE(PG8_SB(1, 1), cB + hstepB + kstep, voffB);
        PG8_WAIT_V(6); PG8_BAR;
    } else {
        PG8_STAGE(PG8_SB(0, 0), cB, voffB); PG8_STAGE(PG8_SA(0, 0), cA, voffA); PG8_STAGE(PG8_SB(0, 1), cB + hstepB, voffB); PG8_STAGE(PG8_SA(0, 1), cA + hstepA, voffA);
        if (wr == 1) PG8_BAR;
        PG8_WAIT_V(4); PG8_BAR;
        PG8_STAGE(PG8_SB(1, 0), cB + kstep, voffB); PG8_STAGE(PG8_SA(1, 0), cA + kstep, voffA); PG8_STAGE(PG8_SB(1, 1), cB + hstepB + kstep, voffB);
        PG8_WAIT_V(6); PG8_BAR;
    }
    for (;;) {
        const bool has_next = S.next(ui + 1, nxt);
        const char* nA = has_next ? (const char*)g.A + (size_t)nxt.pm * tstepA : cA; const char* nB = has_next ? (const char*)g.Bt + (size_t)nxt.pn * tstepB : cB;
        for (int t = 0; t < nt; t += 2) {
            const bool last = (t == nt - 2);
            const char* a1 = cA + (size_t)(t + 1) * kstep;
            const char* a2 = last ? nA : cA + (size_t)(t + 2) * kstep; const char* b2 = last ? nB : cB + (size_t)(t + 2) * kstep;
            const char* a3 = a2 + kstep; const char* b3 = b2 + kstep;
            if (last && has_next) S.a_ready(nxt);
            if constexpr (SP2) {
            PG8_LDB(B0, 0, 0); PG8_LDB(B1, 0, 1); PG8_SCHED; PG8_LDA(At, 0, 0); PG8_STAGE(PG8_SA(1, 1), a1 + hstepA, voffA);
            PG8_WAIT_V(8); PG8_WAIT_L(0); PG8_BAR; PG8_MMA(0, 0, At, B0); PG8_MMA(0, 1, At, B1); PG8_BAR; PG8_SCHED;
            PG8_LDA(At, 0, 1); PG8_STAGE(PG8_SB(0, 0), b2, voffB); PG8_STAGE(PG8_SB(0, 1), b2 + hstepB, voffB); PG8_STAGE(PG8_SA(0, 0), a2, voffA);
            PG8_WAIT_V(8); PG8_WAIT_L(0); PG8_BAR; PG8_MMA(1, 0, At, B0); PG8_MMA(1, 1, At, B1); PG8_BAR; PG8_SCHED;
            PG8_LDB(B0, 1, 0); PG8_LDB(B1, 1, 1); PG8_SCHED; PG8_LDA(At, 1, 0); PG8_STAGE(PG8_SA(0, 1), a2 + hstepA, voffA);
            PG8_WAIT_V(8); PG8_WAIT_L(0); PG8_BAR; PG8_MMA(0, 0, At, B0); PG8_MMA(0, 1, At, B1); PG8_BAR; PG8_SCHED;
            PG8_LDA(At, 1, 1); PG8_STAGE(PG8_SB(1, 0), b3, voffB); PG8_STAGE(PG8_SB(1, 1), b3 + hstepB, voffB); PG8_STAGE(PG8_SA(1, 0), a3, voffA);
            PG8_WAIT_V(8); PG8_WAIT_L(0); PG8_BAR; PG8_MMA(1, 0, At, B0); PG8_MMA(1, 1, At, B1); PG8_BAR; PG8_SCHED;
            } else {
            PG8_LDB(B0, 0, 0); PG8_SCHED; PG8_LDA(At, 0, 0); PG8_STAGE(PG8_SA(1, 1), a1 + hstepA, voffA);
            PG8_WAIT_L(8); PG8_BAR; PG8_WAIT_L(0); PG8_MMA(0, 0, At, B0); PG8_BAR; PG8_SCHED;
            PG8_LDB(B1, 0, 1); PG8_STAGE(PG8_SB(0, 0), b2, voffB);
            PG8_BAR; PG8_WAIT_L(0); PG8_MMA(0, 1, At, B1); PG8_BAR;
            PG8_LDA(At, 0, 1); PG8_STAGE(PG8_SA(0, 0), a2, voffA);
            PG8_BAR; PG8_WAIT_L(0); PG8_MMA(1, 0, At, B0); PG8_BAR; PG8_SCHED;
            PG8_STAGE(PG8_SB(0, 1), b2 + hstepB, voffB);
            PG8_WAIT_V(6); PG8_BAR; PG8_MMA(1, 1, At, B1); PG8_BAR;
            PG8_LDB(B0, 1, 0); PG8_SCHED; PG8_LDA(At, 1, 0); PG8_STAGE(PG8_SA(0, 1), a2 + hstepA, voffA);
            PG8_WAIT_L(8); PG8_BAR; PG8_WAIT_L(0); PG8_MMA(0, 0, At, B0); PG8_BAR; PG8_SCHED;
            PG8_LDB(B1, 1, 1); PG8_STAGE(PG8_SB(1, 0), b3, voffB);
            PG8_BAR; PG8_WAIT_L(0); PG8_MMA(0, 1, At, B1); PG8_BAR;
            PG8_LDA(At, 1, 1); PG8_STAGE(PG8_SA(1, 0), a3, voffA);
            PG8_BAR; PG8_WAIT_L(0); PG8_MMA(1, 0, At, B0); PG8_BAR; PG8_SCHED;
            PG8_STAGE(PG8_SB(1, 1), b3 + hstepB, voffB);
            PG8_WAIT_V(6); PG8_BAR; PG8_MMA(1, 1, At, B1); PG8_BAR;
            }
        }
        if constexpr (ALIGN_EPI) { if (wr == 0) PG8_BAR; }
        if constexpr (!Epi::AFTER_DRAIN) { unsigned long long _ptE = 0ull; if (Epi::PID == PROBE_SECV && blockIdx.x == 0 && wid == 0) _ptE = __builtin_amdgcn_s_memrealtime(); E(acc, cur, wr, wc, fr, fq); if (Epi::PID == PROBE_SECV && blockIdx.x == 0 && wid == 0) { volatile unsigned long long* _a = (volatile unsigned long long*)((unsigned char*)lds + 147456 - 128); *_a = *_a + (__builtin_amdgcn_s_memrealtime() - _ptE); } S.done(cur); }
        if (!has_next) break;
#pragma unroll
        for (int a = 0; a < 2; ++a)
#pragma unroll
            for (int b = 0; b < 2; ++b)
#pragma unroll
                for (int m = 0; m < 4; ++m)
#pragma unroll
                    for (int n = 0; n < 2; ++n) acc[a][b][m][n] = (f32x4){0.f, 0.f, 0.f, 0.f};
        cur = nxt; cA = nA; cB = nB; ++ui;
        if constexpr (ALIGN_EPI) { if (wr == 1) PG8_BAR; }
    }
    PG8_WAIT_V(0);
    if constexpr (!ALIGN_EPI) { if (wr == 0) PG8_BAR; }
    PG8_BAR;
    if constexpr (Epi::AFTER_DRAIN) { E.fused(acc, cur, wr, wc, fr, fq, lds, wid, lane); S.done(cur); }
#undef PG8_SA
#undef PG8_SB
#undef PG8_STAGE
#undef PG8_LDA
#undef PG8_LDB
#undef PG8_MMA
#undef PG8_WAIT_V
#undef PG8_WAIT_L
#undef PG8_BAR
#undef PG8_SCHED
}
}

constexpr size_t MiB = 1u << 20;
constexpr size_t WS_P = 0;
constexpr size_t WS_U = 384 * MiB;
constexpr size_t WS_WE_IN = 448 * MiB, WS_WE_G = 460 * MiB, WS_WE_OUT = 462 * MiB, WS_WE_DT = 466 * MiB;
constexpr size_t WS_WO_IN = 468 * MiB, WS_WO_G = 480 * MiB, WS_WO_OUT = 484 * MiB;
constexpr size_t WS_DT = 488 * MiB;
constexpr size_t WS_SSQ = 490 * MiB;
constexpr size_t WS_SSD = 492 * MiB;
constexpr size_t WS_BAR = 494 * MiB;
constexpr size_t WS_BAR_BYTES = 65536;
constexpr size_t WS_LB = 494 * MiB + 65536;
constexpr size_t WS_SSQH = 495 * MiB;
constexpr size_t WS_END = 511 * MiB;
constexpr int LDS_BYTES = 147456;
#ifndef PG8SP2
#define PG8SP2 true
#endif

struct Params {
    const float *x, *norm_w, *final_norm_w, *rel_bias, *even_w_in, *even_w_out, *conv_w, *conv_b, *dt_bias, *A_log, *D_skip, *ssd_norm_w,
        *lq1, *lk1, *lq2, *lk2, *subln_w, *odd_w_in, *odd_w_out, *hgrn_lb, *hgrn_norm_w;
    float* out; unsigned char* ws;
};

typedef const __attribute__((address_space(4))) Params* PPtr;
__device__ __forceinline__ PPtr get_params() { const __attribute__((address_space(4))) void* k = (const __attribute__((address_space(4))) void*)__builtin_amdgcn_kernarg_segment_ptr(); asm volatile("" : "+s"(k)); return (PPtr)k; }
struct Seg { const float* W; int ldw, col0, ncols, K; bf16_t* WT; int row0; const float* scale; };
__device__ __forceinline__ void convert_seg(const Seg s, float* scr, int gw, int NGW, int lane) {
    const int nblk = (s.ncols + 31) / 32, nitems = (s.K / 64) * nblk;
    for (int it = gw; it < nitems; it += NGW) {
        const int kb = it / nblk, nb = it % nblk, k0 = 64 * kb, n0 = 32 * nb;
        const int nc = lane & 31; const bool okc = (n0 + nc) < s.ncols;
        float wv[32];
#pragma unroll
        for (int i = 0; i < 32; ++i) { const int kk = 2 * i + (lane >> 5); wv[i] = okc ? s.W[(size_t)(k0 + kk) * s.ldw + s.col0 + n0 + nc] : 0.f; }
        if (s.scale) {
#pragma unroll
            for (int i = 0; i < 32; ++i) wv[i] *= s.scale[k0 + 2 * i + (lane >> 5)];
        }
#pragma unroll
        for (int i = 0; i < 32; ++i) scr[(2 * i + (lane >> 5)) * 33 + nc] = wv[i];
        __builtin_amdgcn_fence(__ATOMIC_RELEASE, "workgroup"); __builtin_amdgcn_wave_barrier();
        const int c = lane & 7;
#pragma unroll
        for (int j = 0; j < 4; ++j) {
            const int n = (lane >> 3) + 8 * j; const float* sp = scr + (8 * c) * 33 + n;
            u32x4 o; o.x = cvtpk(sp[0 * 33], sp[1 * 33]); o.y = cvtpk(sp[2 * 33], sp[3 * 33]); o.z = cvtpk(sp[4 * 33], sp[5 * 33]); o.w = cvtpk(sp[6 * 33], sp[7 * 33]);
            if (n0 + n < s.ncols) *(u32x4*)(s.WT + (size_t)(s.row0 + n0 + n) * s.K + k0 + 8 * c) = o;
        }
        __builtin_amdgcn_fence(__ATOMIC_RELEASE, "workgroup"); __builtin_amdgcn_wave_barrier();
    }
}
__device__ __forceinline__ void convert_layer(PPtr p, int layer, float* scr, int gw, int NGW, int lane) {
    const float* nw = p->norm_w + (size_t)layer * DM;
    if ((layer & 1) == 0) {
        const int e = layer >> 1;
        const float* Wi = p->even_w_in + (size_t)e * DM * 7184; const float* Wo = p->even_w_out + (size_t)e * 2048 * DM;
        bf16_t* WIN = (bf16_t*)(p->ws + WS_WE_IN);
        convert_seg(Seg{Wi, 7184, 0, 1024, DM, WIN, 0, nw}, scr, gw, NGW, lane);
        convert_seg(Seg{Wi, 7184, 3088, 1024, DM, WIN, 1024, nw}, scr, gw, NGW, lane);
        convert_seg(Seg{Wi, 7184, 1024, 2048, DM, WIN, 2048, nw}, scr, gw, NGW, lane);
        convert_seg(Seg{Wi, 7184, 4112, 2048, DM, WIN, 4096, nw}, scr, gw, NGW, lane);
        convert_seg(Seg{Wi, 7184, 6160, 1024, DM, (bf16_t*)(p->ws + WS_WE_G), 0, nw}, scr, gw, NGW, lane);
        convert_seg(Seg{Wi, 7184, 3072, 16, DM, (bf16_t*)(p->ws + WS_WE_DT), 0, nw}, scr, gw, NGW, lane);
        convert_seg(Seg{Wo, DM, 0, 1024, 2048, (bf16_t*)(p->ws + WS_WE_OUT), 0, nullptr}, scr, gw, NGW, lane);
    } else {
        const int o = layer >> 1;
        const float* Wi = p->odd_w_in + (size_t)o * DM * 8192; const float* Wo = p->odd_w_out + (size_t)o * 2048 * DM;
        convert_seg(Seg{Wi, 8192, 0, 6144, DM, (bf16_t*)(p->ws + WS_WO_IN), 0, nw}, scr, gw, NGW, lane);
        convert_seg(Seg{Wi, 8192, 6144, 2048, DM, (bf16_t*)(p->ws + WS_WO_G), 0, nw}, scr, gw, NGW, lane);
        convert_seg(Seg{Wo, DM, 0, 1024, 2048, (bf16_t*)(p->ws + WS_WO_OUT), 0, nullptr}, scr, gw, NGW, lane);
    }
}

__device__ __forceinline__ void dt_items(PPtr p, int e, int gw, int NGW, int lane) {
    const bf16_t* U = (const bf16_t*)(p->ws + WS_U); const bf16_t* Wdt = (const bf16_t*)(p->ws + WS_WE_DT);
    const float* ssq = (const float*)(p->ws + WS_SSQ); float* dt = (float*)(p->ws + WS_DT);
    const int fr = lane & 15, fq = lane >> 4;
    for (int item = gw; item < T_TOK / 16; item += NGW) {
        const int row0 = item * 16;
        f32x4 acc = {0.f, 0.f, 0.f, 0.f};
        const bf16x8* ap = (const bf16x8*)(U + (size_t)(row0 + fr) * DM + fq * 8);
        const bf16x8* bp = (const bf16x8*)(Wdt + (size_t)fr * DM + fq * 8);
#pragma unroll 8
        for (int s = 0; s < 32; ++s) acc = __builtin_amdgcn_mfma_f32_16x16x32_bf16(ap[s * 4], bp[s * 4], acc, 0, 0, 0);
        const float bias = p->dt_bias[e * 16 + fr];
#pragma unroll
        for (int i = 0; i < 4; ++i) {
            const int row = row0 + 4 * fq + i;
            const float v = acc[i] * row_rs(ssq, row) + bias;
            dt[(size_t)row * 16 + fr] = (v > 20.f) ? v : log1pf(__expf(v));
        }
    }
}

typedef short v4i16_t __attribute__((ext_vector_type(4)));
__device__ __forceinline__ s16x4 vtr(const bf16_t* ptr) { return __builtin_bit_cast(s16x4, __builtin_amdgcn_ds_read_tr16_b64_v4i16((LAS v4i16_t*)ptr)); }
__device__ __forceinline__ void ssd_unit(PPtr p, int e, int b, int h, unsigned char* lds, int tid) {
    float* sx = (float*)lds;
    float* sB = sx + 16 * 64;
    float* sC = sB + 16 * 128;
    float* sy = sC + 16 * 128;
    float* sdt = sy + 16 * 64;
    float* sda = sdt + 16;
    bf16_t* P = (bf16_t*)(p->ws + WS_P);
    const float* dt = (const float*)(p->ws + WS_DT); float* ssd = (float*)(p->ws + WS_SSD);
    const float* cw = p->conv_w + (size_t)e * 4 * 2048; const float* cb = p->conv_b + (size_t)e * 2048;
    const float Ah = -__expf(p->A_log[e * 16 + h]), Dh = p->D_skip[e * 16 + h];
    const int g = h >> 2, pp = tid >> 3, nq = tid & 7;
    const size_t rowb = (size_t)b * SEQ;
    float st[16];
#pragma unroll
    for (int i = 0; i < 16; ++i) st[i] = 0.f;
    for (int c = 0; c < SEQ / 16; ++c) {
        const int t0 = c * 16;
        for (int it = tid; it < 1280; it += 512) {
            const int t = it / 80, q4 = it % 80;
            int ch; float* dst;
            if (q4 < 16) { ch = h * 64 + q4 * 4; dst = sx + t * 64 + q4 * 4; }
            else if (q4 < 48) { ch = 1024 + g * 128 + (q4 - 16) * 4; dst = sB + t * 128 + (q4 - 16) * 4; }
            else { ch = 1536 + g * 128 + (q4 - 48) * 4; dst = sC + t * 128 + (q4 - 48) * 4; }
            f32x4 a = *(const f32x4*)(cb + ch);
#pragma unroll
            for (int j = 0; j < 4; ++j) {
                const int tt = t0 + t - 3 + j;
                if (tt >= 0) {
                    const u32x2 raw = *(const u32x2*)(P + (rowb + tt) * PP + 2048 + ch);
                    const f32x4 w = *(const f32x4*)(cw + j * 2048 + ch);
                    a[0] += w[0] * bflo(raw.x); a[1] += w[1] * bfhi(raw.x); a[2] += w[2] * bflo(raw.y); a[3] += w[3] * bfhi(raw.y);
                }
            }
            f32x4 o; o[0] = silu_f(a[0]); o[1] = silu_f(a[1]); o[2] = silu_f(a[2]); o[3] = silu_f(a[3]);
            *(f32x4*)dst = o;
        }
        if (tid < 16) { const float d = dt[(rowb + t0 + tid) * 16 + h]; sdt[tid] = d; sda[tid] = __expf(d * Ah); }
        __syncthreads();
        for (int t = 0; t < 16; ++t) {
            const float xv = sx[t * 64 + pp]; const float X = xv * sdt[t], da = sda[t];
            float y = 0.f;
#pragma unroll
            for (int i4 = 0; i4 < 4; ++i4) {
                const f32x4 bv = *(const f32x4*)(sB + t * 128 + nq * 16 + i4 * 4), cv = *(const f32x4*)(sC + t * 128 + nq * 16 + i4 * 4);
#pragma unroll
                for (int i = 0; i < 4; ++i) { st[i4 * 4 + i] = da * st[i4 * 4 + i] + X * bv[i]; y += cv[i] * st[i4 * 4 + i]; }
            }
            y += shx<1>(y); y += shx<2>(y); y += shx<4>(y);
            if (nq == 0) sy[t * 64 + pp] = y + Dh * xv;
        }
        __syncthreads();
        {
            const int t = tid >> 5, p2 = (tid & 31) * 2;
            bf16_t* zp = P + (rowb + t0 + t) * PP + h * 64 + p2;
            const unsigned zw = *(const unsigned*)zp;
            const float g0 = sy[t * 64 + p2] * silu_f(bflo(zw)), g1 = sy[t * 64 + p2 + 1] * silu_f(bfhi(zw));
            float ss = g0 * g0 + g1 * g1;
            ss += shx<1>(ss); ss += shx<2>(ss); ss += shx<4>(ss); ss += shx<8>(ss); ss += shx<16>(ss);
            *(unsigned*)zp = cvtpk(g0, g1);
            if ((tid & 31) == 0) ssd[(rowb + t0 + t) * 16 + h] = ss;
        }
    }
    __syncthreads();
}

__device__ __forceinline__ bf16x8 scale_frag(s16x4 lo, s16x4 hi, const f32x4 w0, const f32x4 w1) {
    u32x4 o;
    o.x = cvtpk(__uint_as_float((unsigned)(unsigned short)lo[0] << 16) * w0[0], __uint_as_float((unsigned)(unsigned short)lo[1] << 16) * w0[1]);
    o.y = cvtpk(__uint_as_float((unsigned)(unsigned short)lo[2] << 16) * w0[2], __uint_as_float((unsigned)(unsigned short)lo[3] << 16) * w0[3]);
    o.z = cvtpk(__uint_as_float((unsigned)(unsigned short)hi[0] << 16) * w1[0], __uint_as_float((unsigned)(unsigned short)hi[1] << 16) * w1[1]);
    o.w = cvtpk(__uint_as_float((unsigned)(unsigned short)hi[2] << 16) * w1[2], __uint_as_float((unsigned)(unsigned short)hi[3] << 16) * w1[3]);
    return __builtin_bit_cast(bf16x8, o);
}
template <int NR> __device__ __forceinline__ void ssd_stage_rows(const bf16_t* P, size_t rowb, int t0, int lrow0, int ch, bf16_t* dst, int dstr, const float* cw, const float* cb) {
    float wt[4][8], bias[8];
#pragma unroll
    for (int j = 0; j < 4; ++j) { const f32x4 a = *(const f32x4*)(cw + j * 2048 + ch), bq = *(const f32x4*)(cw + j * 2048 + ch + 4);
        wt[j][0] = a[0]; wt[j][1] = a[1]; wt[j][2] = a[2]; wt[j][3] = a[3]; wt[j][4] = bq[0]; wt[j][5] = bq[1]; wt[j][6] = bq[2]; wt[j][7] = bq[3]; }
    { const f32x4 a = *(const f32x4*)(cb + ch), bq = *(const f32x4*)(cb + ch + 4); bias[0] = a[0]; bias[1] = a[1]; bias[2] = a[2]; bias[3] = a[3]; bias[4] = bq[0]; bias[5] = bq[1]; bias[6] = bq[2]; bias[7] = bq[3]; }
    const int r0 = t0 + lrow0;
    u32x4 raw[NR + 3];
#pragma unroll
    for (int k = 0; k < NR + 3; ++k) {
        const int tt = r0 - 3 + k;
        raw[k] = (tt >= 0) ? *(const u32x4*)(P + (rowb + tt) * PP + 2048 + ch) : (u32x4){0u, 0u, 0u, 0u};
    }
#pragma unroll
    for (int k = 0; k < NR; ++k) {
        float acc[8];
#pragma unroll
        for (int q = 0; q < 8; ++q) acc[q] = bias[q];
#pragma unroll
        for (int j = 0; j < 4; ++j) {
            const u32x4 rw = raw[k + j];
            acc[0] += wt[j][0] * bflo(rw.x); acc[1] += wt[j][1] * bfhi(rw.x); acc[2] += wt[j][2] * bflo(rw.y); acc[3] += wt[j][3] * bfhi(rw.y);
            acc[4] += wt[j][4] * bflo(rw.z); acc[5] += wt[j][5] * bfhi(rw.z); acc[6] += wt[j][6] * bflo(rw.w); acc[7] += wt[j][7] * bfhi(rw.w);
        }
        u32x4 o; o.x = cvtpk(silu_f(acc[0]), silu_f(acc[1])); o.y = cvtpk(silu_f(acc[2]), silu_f(acc[3])); o.z = cvtpk(silu_f(acc[4]), silu_f(acc[5])); o.w = cvtpk(silu_f(acc[6]), silu_f(acc[7]));
        *(u32x4*)(dst + (lrow0 + k) * dstr) = o;
    }
}
__device__ __forceinline__ void ssd_unit_mfma(PPtr p, int e, int b, int h, unsigned char* lds, int tid) {
    constexpr int CS = 136, BS = 144, XS = 72, SS = 136;
    bf16_t* sC = (bf16_t*)lds;
    bf16_t* sB = sC + 128 * CS;
    bf16_t* sX = sB + 128 * BS;
    bf16_t* sSt = sX + 128 * XS;
    float* sAcs = (float*)(sSt + 2 * 64 * SS);
    float* sDt = sAcs + 128;
    float* sW = sDt + 128;
    float* sDec = sW + 128;
    bf16_t* P = (bf16_t*)(p->ws + WS_P);
    const float* dt = (const float*)(p->ws + WS_DT); float* ssd = (float*)(p->ws + WS_SSD);
    const float* cw = p->conv_w + (size_t)e * 4 * 2048; const float* cb = p->conv_b + (size_t)e * 2048;
    const float Ah = -__expf(p->A_log[e * 16 + h]), Dh = p->D_skip[e * 16 + h];
    const int lane = tid & 63, w = __builtin_amdgcn_readfirstlane(tid >> 6), c16 = lane & 15, g = lane >> 4, tq = c16 >> 2, tp = c16 & 3;
    const int grp = h >> 2;
    const size_t rowb = (size_t)b * SEQ;
    f32x4 stacc[4];
#pragma unroll
    for (int pt = 0; pt < 4; ++pt) stacc[pt] = (f32x4){0.f, 0.f, 0.f, 0.f};
    for (int i = tid; i < 64 * SS / 2; i += 512) ((unsigned*)sSt)[i] = 0u;
    for (int c = 0; c < SEQ / 128; ++c) {
        const int cur = c & 1, nxt = cur ^ 1;
        const int t0 = c * 128;
        PSEC_B(4)
        {
            { const int it = tid; const int cg8 = it % 40, seg = it / 40;
              int ch; bf16_t* dst; int dstr;
              if (cg8 < 8) { ch = h * 64 + cg8 * 8; dst = sX + cg8 * 8; dstr = XS; }
              else if (cg8 < 24) { ch = 1024 + grp * 128 + (cg8 - 8) * 8; dst = sB + (cg8 - 8) * 8; dstr = BS; }
              else { ch = 1536 + grp * 128 + (cg8 - 24) * 8; dst = sC + (cg8 - 24) * 8; dstr = CS; }
              ssd_stage_rows<8>(P, rowb, t0, seg * 8, ch, dst, dstr, cw, cb); }
            { const int it = 512 + (tid >> 2); const int cg8 = it % 40, seg = it / 40;
              int ch; bf16_t* dst; int dstr;
              if (cg8 < 8) { ch = h * 64 + cg8 * 8; dst = sX + cg8 * 8; dstr = XS; }
              else if (cg8 < 24) { ch = 1024 + grp * 128 + (cg8 - 8) * 8; dst = sB + (cg8 - 8) * 8; dstr = BS; }
              else { ch = 1536 + grp * 128 + (cg8 - 24) * 8; dst = sC + (cg8 - 24) * 8; dstr = CS; }
              ssd_stage_rows<2>(P, rowb, t0, seg * 8 + 2 * (tid & 3), ch, dst, dstr, cw, cb); }
        }
        if (w == 0) {
            const float d0 = dt[(rowb + t0 + 2 * lane) * 16 + h], d1 = dt[(rowb + t0 + 2 * lane + 1) * 16 + h];
            const float a0 = d0 * Ah, a1 = d1 * Ah;
            float sc = a0 + a1;
#pragma unroll
            for (int o = 1; o < 64; o <<= 1) { const float t = bperm(lane - o, sc); if (lane >= o) sc += t; }
            const float acs1 = sc, acs0 = sc - a1;
            const float alast = bperm(63, sc);
            sAcs[2 * lane] = acs0; sAcs[2 * lane + 1] = acs1; sDt[2 * lane] = d0; sDt[2 * lane + 1] = d1;
            sW[2 * lane] = d0 * __expf(alast - acs0); sW[2 * lane + 1] = d1 * __expf(alast - acs1);
            sDec[2 * lane] = __expf(acs0); sDec[2 * lane + 1] = __expf(acs1);
        }
        __syncthreads();
        PSEC_E(4, lds) PSEC_B(5)
        {
            const int lrow = 16 * w + c16;
            bf16_t* zrow = P + (rowb + t0 + lrow) * PP + h * 64 + 4 * g;
            u32x2 zr[4];
#pragma unroll
            for (int pt = 0; pt < 4; ++pt) zr[pt] = *(const u32x2*)(zrow + 16 * pt);
            bf16x8 cf[4];
#pragma unroll
            for (int ks = 0; ks < 4; ++ks) cf[ks] = *(const bf16x8*)(sC + lrow * CS + 32 * ks + 8 * g);
            f32x4 acc[4];
#pragma unroll
            for (int pt = 0; pt < 4; ++pt) {
                f32x4 a = {0.f, 0.f, 0.f, 0.f};
#pragma unroll
                for (int ks = 0; ks < 4; ++ks) {
                    const bf16x8 sf = *(const bf16x8*)(sSt + (cur * 64 + 16 * pt + c16) * SS + 32 * ks + 8 * g);
                    a = __builtin_amdgcn_mfma_f32_16x16x32_bf16(sf, cf[ks], a, 0, 0, 0);
                }
                acc[pt] = a;
            }
            {
                const float dl = sDec[lrow];
#pragma unroll
                for (int pt = 0; pt < 4; ++pt) { acc[pt][0] *= dl; acc[pt][1] *= dl; acc[pt][2] *= dl; acc[pt][3] *= dl; }
            }
            const float al = sAcs[lrow];
#pragma unroll
            for (int kp = 0; kp < 4; ++kp) {
                if (2 * kp <= w) {
                    u32x4 pk = {0u, 0u, 0u, 0u};
#pragma unroll
                    for (int hf = 0; hf < 2; ++hf) {
                        const int st = 2 * kp + hf;
                        if (st <= w) {
                            f32x4 a = {0.f, 0.f, 0.f, 0.f};
#pragma unroll
                            for (int ks = 0; ks < 4; ++ks) {
                                const bf16x8 bf = *(const bf16x8*)(sB + (16 * st + c16) * BS + 32 * ks + 8 * g);
                                a = __builtin_amdgcn_mfma_f32_16x16x32_bf16(bf, cf[ks], a, 0, 0, 0);
                            }
                            const f32x4 as = *(const f32x4*)(sAcs + 16 * st + 4 * g), ds = *(const f32x4*)(sDt + 16 * st + 4 * g);
                            float v[4];
#pragma unroll
                            for (int j = 0; j < 4; ++j) {
                                const int srow = 16 * st + 4 * g + j;
                                v[j] = (srow <= lrow) ? a[j] * __expf(al - as[j]) * ds[j] : 0.f;
                            }
                            if (hf == 0) { pk.x = cvtpk(v[0], v[1]); pk.y = cvtpk(v[2], v[3]); } else { pk.z = cvtpk(v[0], v[1]); pk.w = cvtpk(v[2], v[3]); }
                        }
                    }
                    const bf16x8 pa = __builtin_bit_cast(bf16x8, pk);
#pragma unroll
                    for (int pt = 0; pt < 4; ++pt) {
                        const s16x4 lo = vtr(sX + (32 * kp + 4 * g + tq) * XS + 16 * pt + 4 * tp);
                        const s16x4 hi = vtr(sX + (32 * kp + 16 + 4 * g + tq) * XS + 16 * pt + 4 * tp);
                        const bf16x8 xf = {lo[0], lo[1], lo[2], lo[3], hi[0], hi[1], hi[2], hi[3]};
                        acc[pt] = __builtin_amdgcn_mfma_f32_16x16x32_bf16(xf, pa, acc[pt], 0, 0, 0);
                    }
                }
            }
            {
                float ss = 0.f;
#pragma unroll
                for (int pt = 0; pt < 4; ++pt) {
                    const u32x2 xw = *(const u32x2*)(sX + lrow * XS + 16 * pt + 4 * g);
                    const float y0 = (acc[pt][0] + Dh * bflo(xw.x)) * silu_f(bflo(zr[pt].x)), y1 = (acc[pt][1] + Dh * bfhi(xw.x)) * silu_f(bfhi(zr[pt].x));
                    const float y2 = (acc[pt][2] + Dh * bflo(xw.y)) * silu_f(bflo(zr[pt].y)), y3 = (acc[pt][3] + Dh * bfhi(xw.y)) * silu_f(bfhi(zr[pt].y));
                    ss += (y0 * y0 + y1 * y1) + (y2 * y2 + y3 * y3);
                    u32x2 yw; yw.x = cvtpk(y0, y1); yw.y = cvtpk(y2, y3);
                    *(u32x2*)(zrow + 16 * pt) = yw;
                }
                ss += shx<16>(ss); ss = sum_x32(ss);
                if (g == 0) ssd[(rowb + t0 + lrow) * 16 + h] = ss;
            }
        }
        PSEC_E(5, lds) PSEC_B(6)
        {
            const float dlast = sDec[127];
#pragma unroll
            for (int pt = 0; pt < 4; ++pt) { stacc[pt][0] *= dlast; stacc[pt][1] *= dlast; stacc[pt][2] *= dlast; stacc[pt][3] *= dlast; }
#pragma unroll
            for (int ks = 0; ks < 4; ++ks) {
                const s16x4 blo = vtr(sB + (32 * ks + 8 * g + tq) * BS + 16 * w + 4 * tp);
                const s16x4 bhi = vtr(sB + (32 * ks + 8 * g + 4 + tq) * BS + 16 * w + 4 * tp);
                const bf16x8 bfr = {blo[0], blo[1], blo[2], blo[3], bhi[0], bhi[1], bhi[2], bhi[3]};
                const f32x4 w0 = *(const f32x4*)(sW + 32 * ks + 8 * g), w1 = *(const f32x4*)(sW + 32 * ks + 8 * g + 4);
#pragma unroll
                for (int pt = 0; pt < 4; ++pt) {
                    const s16x4 xlo = vtr(sX + (32 * ks + 8 * g + tq) * XS + 16 * pt + 4 * tp);
                    const s16x4 xhi = vtr(sX + (32 * ks + 8 * g + 4 + tq) * XS + 16 * pt + 4 * tp);
                    stacc[pt] = __builtin_amdgcn_mfma_f32_16x16x32_bf16(bfr, scale_frag(xlo, xhi, w0, w1), stacc[pt], 0, 0, 0);
                }
            }
#pragma unroll
            for (int pt = 0; pt < 4; ++pt) {
                u32x2 sw2; sw2.x = cvtpk(stacc[pt][0], stacc[pt][1]); sw2.y = cvtpk(stacc[pt][2], stacc[pt][3]);
                *(u32x2*)(sSt + (nxt * 64 + 16 * pt + c16) * SS + 16 * w + 4 * g) = sw2;
            }
        }
        __syncthreads();
        PSEC_E(6, lds)
    }
}

__device__ __forceinline__ void hgrn_unit(PPtr p, int oi, int b, int h, unsigned char* lds, int tid) {
    float* sq = (float*)lds;
    float* sf = sq + 2048; float* sk = sf + 2048; float* sv = sk + 2048;
    float* so = sv + 2048;
    bf16_t* P = (bf16_t*)(p->ws + WS_P);
    const size_t rowb = (size_t)b * SEQ;
    const int v = tid & 127, dq = tid >> 7;
    const int st_t = tid >> 5, st_d = (tid & 31) * 4;
    const f32x4 nw = *(const f32x4*)(p->hgrn_norm_w + oi * 128 + st_d);
    float S[32];
#pragma unroll
    for (int i = 0; i < 32; ++i) S[i] = 0.f;
    const bf16_t* src = P + (rowb + st_t) * PP + h * 128 + st_d;
    u32x2 rq = *(const u32x2*)(src), rf = *(const u32x2*)(src + 2048), rv = *(const u32x2*)(src + 4096);
    for (int c = 0; c < SEQ / 16; ++c) {
        {
            f32x4 q4 = {bflo(rq.x), bfhi(rq.x), bflo(rq.y), bfhi(rq.y)};
            f32x4 f4 = {__expf(bflo(rf.x)), __expf(bfhi(rf.x)), __expf(bflo(rf.y)), __expf(bfhi(rf.y))};
            f32x4 k4 = {1.f - f4[0], 1.f - f4[1], 1.f - f4[2], 1.f - f4[3]};
            f32x4 v4 = {bflo(rv.x), bfhi(rv.x), bflo(rv.y), bfhi(rv.y)};
            *(f32x4*)(sq + st_t * 128 + st_d) = q4; *(f32x4*)(sf + st_t * 128 + st_d) = f4; *(f32x4*)(sk + st_t * 128 + st_d) = k4; *(f32x4*)(sv + st_t * 128 + st_d) = v4;
        }
        __syncthreads();
        if (c + 1 < SEQ / 16) { const bf16_t* s2 = src + (size_t)(c + 1) * 16 * PP; rq = *(const u32x2*)(s2); rf = *(const u32x2*)(s2 + 2048); rv = *(const u32x2*)(s2 + 4096); }
        for (int t = 0; t < 16; ++t) {
            const float vt = sv[t * 128 + v]; float a = 0.f;
#pragma unroll
            for (int i4 = 0; i4 < 8; ++i4) {
                const f32x4 f4 = *(const f32x4*)(sf + t * 128 + dq * 32 + i4 * 4), k4 = *(const f32x4*)(sk + t * 128 + dq * 32 + i4 * 4), q4 = *(const f32x4*)(sq + t * 128 + dq * 32 + i4 * 4);
#pragma unroll
                for (int i = 0; i < 4; ++i) { S[i4 * 4 + i] = f4[i] * S[i4 * 4 + i] + k4[i] * vt; a += q4[i] * S[i4 * 4 + i]; }
            }
            so[(dq * 16 + t) * 128 + v] = a;
        }
        __syncthreads();
        {
            f32x4 o = *(const f32x4*)(so + (0 * 16 + st_t) * 128 + st_d);
            o += *(const f32x4*)(so + (1 * 16 + st_t) * 128 + st_d); o += *(const f32x4*)(so + (2 * 16 + st_t) * 128 + st_d); o += *(const f32x4*)(so + (3 * 16 + st_t) * 128 + st_d);
            float ss = (o[0] * o[0] + o[1] * o[1]) + (o[2] * o[2] + o[3] * o[3]);
            ss += shx<1>(ss); ss += shx<2>(ss); ss += shx<4>(ss); ss += shx<8>(ss); ss += shx<16>(ss);
            const float r = rsqrtf(ss * (1.f / 128.f) + EPS);
            u32x2 w; w.x = cvtpk(o[0] * r * nw[0], o[1] * r * nw[1]); w.y = cvtpk(o[2] * r * nw[2], o[3] * r * nw[3]);
            *(u32x2*)(P + (rowb + c * 16 + st_t) * PP + h * 128 + st_d) = w;
        }
    }
    __syncthreads();
}

#define MFMA16(a, b, c) __builtin_amdgcn_mfma_f32_16x16x16bf16_1k((a), (b), (c), 0, 0, 0)
__device__ __forceinline__ s16x4 pack4(float a, float b, float c, float d) { u32x2 w; w.x = cvtpk(a, b); w.y = cvtpk(c, d); return __builtin_bit_cast(s16x4, w); }
__device__ __forceinline__ void hgrn_unit_mfma(PPtr p, int oi, int b, int h, unsigned char* lds, int tid) {
    constexpr int QS = 136, KTS = 20, NCH = SEQ / 16, PF = 4;
    bf16_t* sQ = (bf16_t*)lds;
    bf16_t* sK = sQ + 2 * 16 * QS;
    bf16_t* sKT = sK + 2 * 16 * QS;
    float* sDec = (float*)(sKT + 2 * 128 * KTS);
    float* sPart = sDec + 2 * 128;
    bf16_t* sTr = (bf16_t*)(sPart + 2 * 128);
    bf16_t* P = (bf16_t*)(p->ws + WS_P);
    const int lane = tid & 63, w = __builtin_amdgcn_readfirstlane(tid >> 6), r = lane & 15, g = lane >> 4;
    const size_t rowb = (size_t)b * SEQ;
    float* ssqh = (float*)(p->ws + WS_SSQH);
    const bf16_t* gld = P + (rowb + (lane >> 2)) * PP + h * 128 + 16 * w + 4 * (lane & 3);
    bf16_t* myTr = sTr + w * (3 * 16 * 20);
    f32x4 St[8];
#pragma unroll
    for (int j = 0; j < 8; ++j) St[j] = (f32x4){0.f, 0.f, 0.f, 0.f};
    u32x2 pq[PF], pl[PF], pv[PF];
#pragma unroll
    for (int k = 0; k < PF; ++k) { const bf16_t* nb = gld + (size_t)k * 16 * PP; pq[k] = *(const u32x2*)nb; pl[k] = *(const u32x2*)(nb + 2048); pv[k] = *(const u32x2*)(nb + 4096); }
#pragma unroll 1
    for (int c4 = 0; c4 < NCH; c4 += PF) {
#pragma unroll
        for (int k = 0; k < PF; ++k) {
            const int c = c4 + k; const int buf = k & 1;
            PSEC_B(7)
            *(u32x2*)(myTr + (0 * 16 + (lane >> 2)) * 20 + 4 * (lane & 3)) = pq[k];
            *(u32x2*)(myTr + (1 * 16 + (lane >> 2)) * 20 + 4 * (lane & 3)) = pl[k];
            *(u32x2*)(myTr + (2 * 16 + (lane >> 2)) * 20 + 4 * (lane & 3)) = pv[k];
            if (c + PF < NCH) { const bf16_t* nb = gld + (size_t)(c + PF) * 16 * PP; pq[k] = *(const u32x2*)nb; pl[k] = *(const u32x2*)(nb + 2048); pv[k] = *(const u32x2*)(nb + 4096); }
            float qv[4], lf[4]; s16x4 vf;
#pragma unroll
            for (int i = 0; i < 4; ++i) {
                qv[i] = __uint_as_float((unsigned)myTr[(0 * 16 + 4 * g + i) * 20 + r] << 16);
                lf[i] = __uint_as_float((unsigned)myTr[(1 * 16 + 4 * g + i) * 20 + r] << 16);
                vf[i] = (short)myTr[(2 * 16 + 4 * g + i) * 20 + r];
            }
            const float p0 = lf[0], p1 = p0 + lf[1], p2 = p1 + lf[2], p3 = p2 + lf[3];
            const float t1 = bperm(lane - 16, p3), t2 = bperm(lane - 32, p3), t3 = bperm(lane - 48, p3);
            const float ex = (g >= 1 ? t1 : 0.f) + (g >= 2 ? t2 : 0.f) + (g >= 3 ? t3 : 0.f);
            const float blast = bperm(48 + r, ex + p3);
            const float bc[4] = {ex + p0, ex + p1, ex + p2, ex + p3};
            float kh[4];
            const float eblast = fast_exp2(LOG2E * blast);
#pragma unroll
            for (int i = 0; i < 4; ++i) {
                const float kk = 1.f - fast_exp2(LOG2E * lf[i]);
                const float eb = fast_exp2(LOG2E * bc[i]);
                const float kt = kk * fast_exp2(-LOG2E * bc[i]);
                sQ[(buf * 16 + 4 * g + i) * QS + 16 * w + r] = (bf16_t)(cvtpk(qv[i] * eb, 0.f) & 0xffffu);
                sK[(buf * 16 + 4 * g + i) * QS + 16 * w + r] = (bf16_t)(cvtpk(kt, 0.f) & 0xffffu);
                kh[i] = kt * eblast;
            }
            *(s16x4*)(sKT + (buf * 128 + 16 * w + r) * KTS + 4 * g) = pack4(kh[0], kh[1], kh[2], kh[3]);
            if (g == 0) sDec[buf * 128 + 16 * w + r] = eblast;
            asm volatile("s_waitcnt lgkmcnt(0)\n\ts_barrier" ::: "memory");
            PSEC_E(7, lds) PSEC_B(8)
            f32x4 a = {0.f, 0.f, 0.f, 0.f};
#pragma unroll
            for (int ks = 0; ks < 4; ++ks) {
                const bf16x8 ka = *(const bf16x8*)(sK + (buf * 16 + r) * QS + 32 * ks + 8 * g);
                const bf16x8 qb = *(const bf16x8*)(sQ + (buf * 16 + r) * QS + 32 * ks + 8 * g);
                a = __builtin_amdgcn_mfma_f32_16x16x32_bf16(ka, qb, a, 0, 0, 0);
            }
#pragma unroll
            for (int i = 0; i < 4; ++i) a[i] = (4 * g + i <= r) ? a[i] : 0.f;
            f32x4 o = MFMA16(vf, pack4(a[0], a[1], a[2], a[3]), ((f32x4){0.f, 0.f, 0.f, 0.f}));
#pragma unroll
            for (int j = 0; j < 8; ++j) {
                const s16x4 qa = *(const s16x4*)(sQ + (buf * 16 + r) * QS + 16 * j + 4 * g);
                o = MFMA16(pack4(St[j][0], St[j][1], St[j][2], St[j][3]), qa, o);
            }
#pragma unroll
            for (int j = 0; j < 8; ++j) {
                const f32x4 d4 = *(const f32x4*)(sDec + buf * 128 + 16 * j + 4 * g);
                const s16x4 ka = *(const s16x4*)(sKT + (buf * 128 + 16 * j + r) * KTS + 4 * g);
                f32x4 sc = St[j]; sc[0] *= d4[0]; sc[1] *= d4[1]; sc[2] *= d4[2]; sc[3] *= d4[3];
                St[j] = MFMA16(ka, vf, sc);
            }
            {
                const size_t grow = rowb + c * 16 + r;
                u32x2 ow; ow.x = cvtpk(o[0], o[1]); ow.y = cvtpk(o[2], o[3]);
                *(u32x2*)(P + grow * PP + h * 128 + 16 * w + 4 * g) = ow;
                float ss = (o[0] * o[0] + o[1] * o[1]) + (o[2] * o[2] + o[3] * o[3]);
                ss += shx<16>(ss); ss = sum_x32(ss);
                if (g == 0) ssqh[(grow * 16 + h) * 8 + w] = ss;
            }
            PSEC_E(8, lds)
        }
    }
    __syncthreads();
}

constexpr int KSTR = 136, VSTR = 144;

__device__ __forceinline__ void attn_unit(PPtr p, int e, int b, int h, int qb, float lam, float oscale, unsigned char* lds, int tid) {
    bf16_t* sK = (bf16_t*)lds;
    bf16_t* sV = sK + 64 * KSTR;
    float* sbias = (float*)(sV + 64 * VSTR);
    bf16_t* P = (bf16_t*)(p->ws + WS_P);
    const int lane = tid & 63, w = __builtin_amdgcn_readfirstlane(tid >> 6), c16 = lane & 15, g = lane >> 4;
    const size_t rowb = (size_t)b * SEQ;
    const int q0 = qb * 128, qw0 = q0 + 16 * w, qpos = qw0 + c16;
    __syncthreads();
    if (tid < 129) {
        int bucket;
        if (tid < 16) bucket = tid;
        else { int lg = 16 + (int)(__logf((float)tid * (1.f / 16.f)) / 2.0794415416798357f * 16.f); bucket = lg < 31 ? lg : 31; }
        sbias[tid] = p->rel_bias[bucket * 8 + h] * LOG2E;
    }
    bf16x8 qf[2][2];
#pragma unroll
    for (int mp = 0; mp < 2; ++mp)
#pragma unroll
        for (int ds = 0; ds < 2; ++ds) qf[mp][ds] = *(const bf16x8*)(P + (rowb + qpos) * PP + 1024 + h * 128 + mp * 64 + ds * 32 + 8 * g);
    f32x4 O[2][8];
#pragma unroll
    for (int mp = 0; mp < 2; ++mp)
#pragma unroll
        for (int vt = 0; vt < 8; ++vt) O[mp][vt] = (f32x4){0.f, 0.f, 0.f, 0.f};
    float mref[2] = {0.f, 0.f}, lsum[2] = {0.f, 0.f};
    const int NT = (q0 + 128) / 64;
    const bf16_t* Kg = P + rowb * PP + 4096 + h * 128; const bf16_t* Vg = P + rowb * PP + 5120 + h * 128;
    const int ld_row0 = tid >> 4, ld_ch = tid & 15;
    u32x4 kr[2], vr[2];
#pragma unroll
    for (int i = 0; i < 2; ++i) { kr[i] = *(const u32x4*)(Kg + (size_t)(ld_row0 + 32 * i) * PP + ld_ch * 8); vr[i] = *(const u32x4*)(Vg + (size_t)(ld_row0 + 32 * i) * PP + ld_ch * 8); }
    for (int t = 0; t < NT; ++t) {
        __syncthreads();
#pragma unroll
        for (int i = 0; i < 2; ++i) { *(u32x4*)(sK + (ld_row0 + 32 * i) * KSTR + ld_ch * 8) = kr[i]; *(u32x4*)(sV + (ld_row0 + 32 * i) * VSTR + ld_ch * 8) = vr[i]; }
        __syncthreads();
        if (t + 1 < NT) {
#pragma unroll
            for (int i = 0; i < 2; ++i) { kr[i] = *(const u32x4*)(Kg + (size_t)((t + 1) * 64 + ld_row0 + 32 * i) * PP + ld_ch * 8); vr[i] = *(const u32x4*)(Vg + (size_t)((t + 1) * 64 + ld_row0 + 32 * i) * PP + ld_ch * 8); }
        }
        const int k0 = t * 64;
        PSEC_B(9)
        if (k0 <= qw0 + 15) {
            const bool far = (qw0 - (k0 + 63)) >= 128;
            const bool first = (t == 0);
            const float bfar = sbias[128];
            bf16x8 pa[2][2];
#pragma unroll
            for (int mp = 0; mp < 2; ++mp) {
                f32x4 sc[4];
                const float cinit = (far ? bfar : 0.f) - mref[mp];
#pragma unroll
                for (int s = 0; s < 4; ++s) {
                    f32x4 a = {cinit, cinit, cinit, cinit};
#pragma unroll
                    for (int ds = 0; ds < 2; ++ds) {
                        const bf16x8 kf = *(const bf16x8*)(sK + (16 * s + c16) * KSTR + mp * 64 + ds * 32 + 8 * g);
                        a = __builtin_amdgcn_mfma_f32_16x16x32_bf16(kf, qf[mp][ds], a, 0, 0, 0);
                    }
                    sc[s] = a;
                }
                if (!far) {
#pragma unroll
                    for (int s = 0; s < 4; ++s)
#pragma unroll
                        for (int j = 0; j < 4; ++j) {
                            const int rel = qpos - (k0 + 16 * s + 4 * g + j);
                            const int idx = rel < 0 ? 0 : (rel > 128 ? 128 : rel);
                            sc[s][j] = (rel >= 0) ? sc[s][j] + sbias[idx] : -1e30f;
                        }
                }
                float mx = fmaxf(fmaxf(fmaxf(sc[0][0], sc[0][1]), fmaxf(sc[0][2], sc[0][3])), fmaxf(fmaxf(sc[1][0], sc[1][1]), fmaxf(sc[1][2], sc[1][3])));
                mx = fmaxf(mx, fmaxf(fmaxf(fmaxf(sc[2][0], sc[2][1]), fmaxf(sc[2][2], sc[2][3])), fmaxf(fmaxf(sc[3][0], sc[3][1]), fmaxf(sc[3][2], sc[3][3]))));
                mx = fmaxf(mx, shx<16>(mx)); mx = max_x32(mx);
                if (first || __any(mx > 8.f)) {
                    const float delta = first ? mx : fmaxf(mx, 0.f);
                    mref[mp] += delta;
#pragma unroll
                    for (int s = 0; s < 4; ++s)
#pragma unroll
                        for (int j = 0; j < 4; ++j) sc[s][j] -= delta;
                    const float al = fast_exp2(-delta);
                    lsum[mp] *= al;
                    if (!first) {
#pragma unroll
                        for (int j = 0; j < 4; ++j) {
                            const float aj = bperm(4 * g + j, al);
#pragma unroll
                            for (int vt = 0; vt < 8; ++vt) O[mp][vt][j] *= aj;
                        }
                    }
                }
                float rs = 0.f;
#pragma unroll
                for (int s = 0; s < 4; ++s)
#pragma unroll
                    for (int j = 0; j < 4; ++j) { const float pv = fast_exp2(sc[s][j]); sc[s][j] = pv; rs += pv; }
                lsum[mp] += rs;
#pragma unroll
                for (int ks = 0; ks < 2; ++ks) {
                    u32x4 pk;
                    pk.x = cvtpk(sc[2 * ks][0], sc[2 * ks][1]); pk.y = cvtpk(sc[2 * ks][2], sc[2 * ks][3]);
                    pk.z = cvtpk(sc[2 * ks + 1][0], sc[2 * ks + 1][1]); pk.w = cvtpk(sc[2 * ks + 1][2], sc[2 * ks + 1][3]);
                    pa[mp][ks] = __builtin_bit_cast(bf16x8, pk);
                }
                asm volatile("" ::: "memory");
            }
            const int tq = c16 >> 2, tp = c16 & 3;
#pragma unroll
            for (int ks = 0; ks < 2; ++ks)
#pragma unroll
                for (int vt = 0; vt < 8; ++vt) {
                    const s16x4 lo = vtr(sV + (32 * ks + 4 * g + tq) * VSTR + 16 * vt + 4 * tp);
                    const s16x4 hi = vtr(sV + (32 * ks + 16 + 4 * g + tq) * VSTR + 16 * vt + 4 * tp);
                    const bf16x8 vf = {lo[0], lo[1], lo[2], lo[3], hi[0], hi[1], hi[2], hi[3]};
                    O[0][vt] = __builtin_amdgcn_mfma_f32_16x16x32_bf16(pa[0][ks], vf, O[0][vt], 0, 0, 0);
                    O[1][vt] = __builtin_amdgcn_mfma_f32_16x16x32_bf16(pa[1][ks], vf, O[1][vt], 0, 0, 0);
                    if (vt & 1) asm volatile("" ::: "memory");
                }
        }
        PSEC_E(9, lds)
    }
#pragma unroll
    for (int mp = 0; mp < 2; ++mp) { lsum[mp] += shx<16>(lsum[mp]); lsum[mp] = sum_x32(lsum[mp]); }
    const float lrun[2] = {lsum[0], lsum[1]};
    const float il0 = 1.f / lrun[0], il1 = lam / lrun[1];
    float sw[8];
#pragma unroll
    for (int vt = 0; vt < 8; ++vt) sw[vt] = p->subln_w[e * 128 + 16 * vt + c16] * oscale;
#pragma unroll
    for (int j = 0; j < 4; ++j) {
        const float a0 = bperm(4 * g + j, il0), a1 = bperm(4 * g + j, il1);
        float o[8]; float ss = 0.f;
#pragma unroll
        for (int vt = 0; vt < 8; ++vt) { o[vt] = O[0][vt][j] * a0 - O[1][vt][j] * a1; ss += o[vt] * o[vt]; }
        ss += shx<1>(ss); ss += shx<2>(ss); ss += shx<4>(ss); ss += shx<8>(ss);
        const float r = rsqrtf(ss * (1.f / 128.f) + EPS);
        bf16_t* op = P + (rowb + qw0 + 4 * g + j) * PP + 1024 + h * 128 + c16;
#pragma unroll
        for (int vt = 0; vt < 8; ++vt) op[16 * vt] = (bf16_t)(cvtpk(o[vt] * r * sw[vt], 0.f) & 0xffffu);
    }
}

#define XB_TMO      128
#define XB_XCNT(j)  (256  + 64 * (j))
#define XB_XSUB(j)  (1280 + 64 * (j))
#define XB_XGEN(j)  (2304 + 64 * (j))
#define XB_TOP      3328
#define XB_TOPGEN   3392
#define XCD_BAR_WORDS 3456
#define XB_SPIN_CAP (1u << 18)

__device__ __forceinline__ unsigned xb_ld(unsigned* p)              { return __hip_atomic_load(p, __ATOMIC_RELAXED, __HIP_MEMORY_SCOPE_AGENT); }
__device__ __forceinline__ unsigned xb_add(unsigned* p, unsigned v) { return __hip_atomic_fetch_add(p, v, __ATOMIC_RELAXED, __HIP_MEMORY_SCOPE_AGENT); }
__device__ __forceinline__ unsigned xb_xcc_id() { return (unsigned)__builtin_amdgcn_s_getreg((3 << 11) | 20) & 0xFu; }
#define XB_SPIN(cond, bar) do { unsigned _sp = 0; while (cond) { __builtin_amdgcn_s_sleep(1); \
    if ((++_sp & 255u) == 0u) { if (xb_ld(&(bar)[XB_TMO])) break; if (_sp > XB_SPIN_CAP) { atomicAdd(&(bar)[XB_TMO], 1u); break; } } } } while (0)

struct XcdBarrier {
    unsigned* bar; unsigned x;
    volatile LAS unsigned* st;
};

__device__ __forceinline__ XcdBarrier xcd_barrier_post(unsigned* bar, volatile LAS unsigned* st, bool leader) {
    XcdBarrier b; b.bar = bar; b.x = xb_xcc_id(); b.st = st;
    if (leader) (void)xb_add(&bar[XB_XCNT(b.x)], 1u);
    return b;
}
__device__ __forceinline__ void xcd_barrier_complete(unsigned* bar, unsigned x, unsigned& nloc, unsigned& nx) {
    const unsigned G = gridDim.x * gridDim.y * gridDim.z;
    unsigned sum, cnt, mine, sp = 0u;
    for (;;) {
        sum = 0u; cnt = 0u; mine = 0u;
#pragma unroll
        for (unsigned j = 0; j < 16; ++j) { const unsigned c = xb_ld(&bar[XB_XCNT(j)]); sum += c; cnt += (c > 0u) ? 1u : 0u; mine = (j == x) ? c : mine; }
        if (sum == G) break;
        __builtin_amdgcn_s_sleep(1);
        if ((++sp & 255u) == 0u) { if (xb_ld(&bar[XB_TMO])) break; if (sp > XB_SPIN_CAP) { atomicAdd(&bar[XB_TMO], 1u); break; } }
    }
    nloc = mine > 0u ? mine : 1u; nx = cnt > 0u ? cnt : 1u;
}

__device__ __forceinline__ void xcd_barrier(const XcdBarrier& b, bool leader) {
    asm volatile("s_waitcnt vmcnt(0)" ::: "memory");
    __syncthreads();
    if (leader) {
        unsigned* bar = b.bar;
        __builtin_amdgcn_s_waitcnt(0);
        unsigned nloc = b.st[0], nx = b.st[1];
        if (nloc == 0u) { xcd_barrier_complete(bar, b.x, nloc, nx); b.st[0] = nloc; b.st[1] = nx; }
        const unsigned old = xb_add(&bar[XB_XSUB(b.x)], 1u);
        const unsigned gen = old / nloc;
        if (old + 1u == (gen + 1u) * nloc) {
            __builtin_amdgcn_fence(__ATOMIC_RELEASE, "agent");
            asm volatile("s_waitcnt vmcnt(0)" ::: "memory");
            const unsigned og = xb_add(&bar[XB_TOP], 1u);
            const unsigned tg = og / nx;
            if (og + 1u == (tg + 1u) * nx) xb_add(&bar[XB_TOPGEN], 1u);
            else XB_SPIN(xb_ld(&bar[XB_TOPGEN]) == tg, bar);
            __builtin_amdgcn_fence(__ATOMIC_ACQUIRE, "agent");
            xb_add(&bar[XB_XGEN(b.x)], 1u);
            asm volatile("s_waitcnt vmcnt(0)" ::: "memory");
        } else {
            XB_SPIN(xb_ld(&bar[XB_XGEN(b.x)]) == gen, bar);
            __builtin_amdgcn_fence(__ATOMIC_ACQUIRE, "agent");
            asm volatile("s_waitcnt vmcnt(0)" ::: "memory");
        }
    }
    __syncthreads();
}

#define p get_params()
__global__ void __launch_bounds__(512, 2) fwd_kernel(Params p_unused) {
    extern __shared__ __attribute__((aligned(16))) unsigned char lds[];
    cg::grid_group grid = cg::this_grid();
    int tid = threadIdx.x, lane = tid & 63; const int wave = __builtin_amdgcn_readfirstlane(tid >> 6);
#define FRESH_LANES() do { lane = (int)__builtin_amdgcn_mbcnt_hi(~0u, __builtin_amdgcn_mbcnt_lo(~0u, 0u)); asm volatile("" : "+v"(lane)); tid = wave * 64 + lane; } while (0)
    const int G = gridDim.x, blk = blockIdx.x;
    volatile LAS unsigned* bar_st = (volatile LAS unsigned*)(lds + LDS_BYTES - 512);
    if (tid < 2) bar_st[tid] = 0u;
#ifdef PROBE_SEC
    if (wave == 0) *(volatile unsigned long long*)(lds + LDS_BYTES - 128) = 0ull;
#endif
    __syncthreads();
    const XcdBarrier xbar = xcd_barrier_post((unsigned*)(get_params()->ws + WS_BAR), bar_st, tid == 0);
#define GRID_SYNC() do { FRESH_LANES(); xcd_barrier(xbar, tid == 0); } while (0)
    __builtin_assume(blk >= 0 && blk < 256 && G >= 1 && G <= 256);
    const int gw = blk * 8 + wave, NGW = G * 8;
    const int vcu = __builtin_amdgcn_readfirstlane((G % 8 == 0) ? (blk % 8) * (G / 8) + blk / 8 : blk);
    bf16_t* P = (bf16_t*)(p->ws + WS_P); bf16_t* U = (bf16_t*)(p->ws + WS_U);
    float* ssq = (float*)(p->ws + WS_SSQ);
    float* scr = (float*)(lds + wave * 8704);
    PG8_LAS unsigned char* ring = (PG8_LAS unsigned char*)lds;

#ifdef PROBE_MASK
    unsigned long long* tstamp = (unsigned long long*)(lds + LDS_BYTES - 256);
    int n_ts = 0;
#define STAMP() do { if (blk == 0 && threadIdx.x == 0) tstamp[n_ts] = __builtin_amdgcn_s_memrealtime(); ++n_ts; } while (0)
#else
#define STAMP() do {} while (0)
#endif
    STAMP();
    for (int r0 = gw; r0 < T_TOK; r0 += 4 * NGW) {
        f32x4 v[4][4];
#pragma unroll
        for (int u = 0; u < 4; ++u) { const int row = min(r0 + u * NGW, T_TOK - 1); const f32x4* xr = (const f32x4*)(p->x + (size_t)row * DM) + lane;
#pragma unroll
            for (int j = 0; j < 4; ++j) v[u][j] = xr[64 * j]; }
#pragma unroll
        for (int u = 0; u < 4; ++u) {
            const int row = r0 + u * NGW;
            float s = 0.f;
#pragma unroll
            for (int j = 0; j < 4; ++j) s += (v[u][j][0] * v[u][j][0] + v[u][j][1] * v[u][j][1]) + (v[u][j][2] * v[u][j][2] + v[u][j][3] * v[u][j][3]);
            s = wave_sum(s);
            if (row < T_TOK) {
                u32x2* up = (u32x2*)(U + (size_t)row * DM) + lane;
#pragma unroll
                for (int j = 0; j < 4; ++j) { u32x2 w; w.x = cvtpk(v[u][j][0], v[u][j][1]); w.y = cvtpk(v[u][j][2], v[u][j][3]); up[64 * j] = w; }
                if (lane < 16) ssq[(size_t)row * 16 + lane] = (lane == 0) ? s : 0.f;
            }
        }
    }
    convert_layer(p, 0, scr, gw, NGW, lane);
    for (int i = blk * 512 + tid; i < 4096; i += G * 512) ((float*)(p->ws + WS_LB))[i] = lb_val(p->hgrn_lb, i & 2047, (i >> 11) ? 3 : 1);
    grid.sync(); STAMP();

#pragma unroll 1
    for (int layer = 0; layer < 4; ++layer) {
        const bool even = (layer & 1) == 0; const int e = layer >> 1;
        FRESH_LANES();
        if (even) {
            dt_items(p, e, gw, NGW, lane);
            pg8::Gemm gm{U, (const bf16_t*)(p->ws + WS_WE_IN), T_TOK, 6144, DM, DM}; pg8::StaticOrder S; S.init(T_TOK, 6144, G, blk);
            pg8::EpiIn E{P, ssq, 0, 0.125f * LOG2E, nullptr, 0};
#ifndef SKIP_IN
            pg8::gemm_phase<pg8::EpiIn, pg8::StaticOrder, true, PG8SP2, 1024, 1024>(ring, gm, S, E, tid);
#endif
        } else {
            pg8::Gemm gm{U, (const bf16_t*)(p->ws + WS_WO_IN), T_TOK, 6144, DM, DM}; pg8::StaticOrder S; S.init(T_TOK, 6144, G, blk);
            pg8::EpiIn E{P, ssq, 1, 1.f, (const float*)(p->ws + WS_LB) + e * 2048, layer};
#ifndef SKIP_IN
            pg8::gemm_phase<pg8::EpiIn, pg8::StaticOrder, true, PG8SP2, 1024, 1024>(ring, gm, S, E, tid);
#endif
        }
        GRID_SYNC(); STAMP();
        FRESH_LANES();
        if (even) {
            const float lam_init = 0.8f - 0.6f * __expf(-0.3f * (float)layer);
            float d1 = p->lq1[e * 64 + lane] * p->lk1[e * 64 + lane], d2 = p->lq2[e * 64 + lane] * p->lk2[e * 64 + lane];
            d1 = wave_sum(d1); d2 = wave_sum(d2);
            const float lam = __expf(d1) - __expf(d2) + lam_init;
            for (int pi = vcu; pi < 1024; pi += G) {
                const int bh = pi >> 3, s = pi & 7;
#ifndef SKIP_ATTN
#pragma unroll 1
                for (int half = 0; half < 2; ++half) { FRESH_LANES(); attn_unit(p, e, bh >> 3, bh & 7, half ? s : 15 - s, lam, 1.f - lam_init, lds, tid); }
#endif
            }
            __syncthreads(); STAMP();
            FRESH_LANES();
#ifndef SKIP_SSD
            for (int ui = vcu; ui < 256; ui += G) ssd_unit_mfma(p, e, ui >> 4, ui & 15, lds, tid);
#endif
        } else {
#ifndef SKIP_HGRN
            for (int ui = blk; ui < 256; ui += G) hgrn_unit_mfma(p, e, ui >> 4, ui & 15, lds, tid);
#endif
        }
        GRID_SYNC(); STAMP();
        FRESH_LANES();
        if (even) {
            pg8::Gemm gm{U, (const bf16_t*)(p->ws + WS_WE_G), T_TOK, 1024, DM, DM}; pg8::StaticOrder S; S.init(T_TOK, 1024, G, blk);
            pg8::EpiGate E{P + 1024, ssq, (const float*)(p->ws + WS_SSD), p->ssd_norm_w + e * 1024, P, nullptr, nullptr};
#ifndef SKIP_GATE
            pg8::gemm_phase<pg8::EpiGate, pg8::StaticOrder, true, PG8SP2, 1024, 1024>(ring, gm, S, E, tid);
#endif
        } else {
            pg8::Gemm gm{U, (const bf16_t*)(p->ws + WS_WO_G), T_TOK, 2048, DM, DM}; pg8::StaticOrder S; S.init(T_TOK, 2048, G, blk);
            pg8::EpiGate E{P, ssq, nullptr, nullptr, nullptr, (const float*)(p->ws + WS_SSQH), p->hgrn_norm_w + e * 128};
#ifndef SKIP_GATE
            pg8::gemm_phase<pg8::EpiGate, pg8::StaticOrder, true, PG8SP2, 1024, 1024>(ring, gm, S, E, tid);
#endif
        }
        GRID_SYNC(); STAMP();
        FRESH_LANES();
        {
            pg8::Gemm gm{P, (const bf16_t*)(p->ws + (even ? WS_WE_OUT : WS_WO_OUT)), T_TOK, 1024, 2048, PP}; pg8::StaticOrder S; S.init(T_TOK, 1024, G, blk);
            pg8::EpiOut E{layer == 0 ? p->x : p->out, p->out, layer < 3 ? U : nullptr, ssq};
#ifndef SKIP_OUT
            pg8::gemm_phase<pg8::EpiOut, pg8::StaticOrder, true, PG8SP2, 2048, 6144>(ring, gm, S, E, tid);
#endif
            FRESH_LANES();
            if (layer < 3) convert_layer(p, layer + 1, scr, gw, NGW, lane);
        }
        GRID_SYNC(); STAMP();
    }
    FRESH_LANES();
    for (int r0 = gw; r0 < T_TOK; r0 += 4 * NGW) {
        float r[4]; f32x4 v[4][4];
#pragma unroll
        for (int u = 0; u < 4; ++u) { const int row = min(r0 + u * NGW, T_TOK - 1); r[u] = row_rs(ssq, row); const f32x4* hp = (const f32x4*)(p->out + (size_t)row * DM) + lane;
#pragma unroll
            for (int j = 0; j < 4; ++j) v[u][j] = hp[64 * j]; }
        const f32x4* wp = (const f32x4*)p->final_norm_w + lane;
        const f32x4 w0 = wp[0], w1 = wp[64], w2 = wp[128], w3 = wp[192];
#pragma unroll
        for (int u = 0; u < 4; ++u) {
            const int row = r0 + u * NGW;
            if (row < T_TOK) {
                f32x4* hp = (f32x4*)(p->out + (size_t)row * DM) + lane;
#pragma unroll
                for (int j = 0; j < 4; ++j) { f32x4 x = v[u][j]; const f32x4 w = (j == 0) ? w0 : (j == 1) ? w1 : (j == 2) ? w2 : w3; const float rr = r[u];
                    x[0] *= rr * w[0]; x[1] *= rr * w[1]; x[2] *= rr * w[2]; x[3] *= rr * w[3]; hp[64 * j] = x; }
            }
        }
    }
#ifdef PROBE_SEC
    if (blk == 0 && wave == 0) {
        const unsigned long long tend = __builtin_amdgcn_s_memrealtime();
        const unsigned long long acc_t = *(volatile unsigned long long*)(lds + LDS_BYTES - 128) * PROBE_MULT;
        while (__builtin_amdgcn_s_memrealtime() - tend < acc_t) __builtin_amdgcn_s_sleep(32);
    }
#endif
#ifdef PROBE_MASK
    if (blk == 0 && threadIdx.x == 0) {
        const unsigned long long tend = __builtin_amdgcn_s_memrealtime();
        unsigned long long acc_t = 0;
        for (int k = 0; k + 1 < n_ts; ++k) if ((PROBE_MASK >> k) & 1u) acc_t += tstamp[k + 1] - tstamp[k];
        acc_t *= PROBE_MULT;
        while (__builtin_amdgcn_s_memrealtime() - tend < acc_t) __builtin_amdgcn_s_sleep(32);
    }
#endif
}

#undef p
extern "C" void kernel_launch(void* const* d_in, const int* in_sizes, int n_in, void* d_out, int out_size, void* d_ws, size_t ws_size, hipStream_t stream) {
    static int grid = 0;
    if (grid == 0) {
        if (n_in != 21 || out_size != T_TOK * DM || ws_size < WS_END) { fprintf(stderr, "kernel_launch: unexpected shapes: n_in %d out %d ws %zu (need %zu)\n", n_in, out_size, ws_size, (size_t)WS_END); grid = -1; return; }
        int dev = 0, cus = 0, per_cu = 0;
        hipGetDevice(&dev); hipDeviceGetAttribute(&cus, hipDeviceAttributeMultiprocessorCount, dev);
        hipFuncSetAttribute((const void*)fwd_kernel, hipFuncAttributeMaxDynamicSharedMemorySize, LDS_BYTES);
        hipOccupancyMaxActiveBlocksPerMultiprocessor(&per_cu, (const void*)fwd_kernel, 512, LDS_BYTES);
        if (per_cu < 1) { fprintf(stderr, "kernel_launch: occupancy query says %d blocks per CU\n", per_cu); per_cu = 1; }
        (void)hipGetLastError();
        grid = cus * per_cu;
        if (grid > 256) grid = 256;
    }
    if (grid < 0) return;
    Params p{};
    const float** f = (const float**)&p;
    for (int i = 0; i < 21; ++i) f[i] = (const float*)d_in[i];
    p.out = (float*)d_out; p.ws = (unsigned char*)d_ws;
    if (hipMemsetAsync((char*)d_ws + WS_BAR, 0, WS_BAR_BYTES, stream) != hipSuccess) { fprintf(stderr, "kernel_launch: memset of barrier words failed\n"); return; }
    void* args[] = {&p};
    hipError_t err = hipLaunchCooperativeKernel((const void*)fwd_kernel, dim3(grid), dim3(512), args, LDS_BYTES, stream);
    if (err != hipSuccess) fprintf(stderr, "kernel_launch: cooperative launch failed: %s (grid %d)\n", hipGetErrorString(err), grid);
}
```
